# Optimizing an MI355X kernel written in HIP

```python
import jax
import jax.numpy as jnp
from jax import lax
import numpy as np

D_MODEL = 1024
BATCH = 8
SEQ = 4096
DEPTH = 2

GRID_W = 64
CTX_LEN = 256
POOL_WINDOWS = (2, 4, 8, 16)
POOL_GROUP = D_MODEL // 8
POOL_WIDTH = POOL_GROUP * len(POOL_WINDOWS)
CONV_WIDTH = D_MODEL - POOL_WIDTH
CONV_K = 31
MLSTM_HEADS = 4
MLSTM_INNER = 2 * D_MODEL
MLSTM_HEAD_DIM = MLSTM_INNER // MLSTM_HEADS
MLSTM_CONV_K = 3
MLSTM_CHUNK = 64
FFN_HIDDEN = ((8 * D_MODEL + 3 * 256 - 1) // (3 * 256)) * 256
N_EVEN = (DEPTH + 1) // 2
N_ODD = DEPTH // 2
DEEPNORM_ALPHA = (2.0 * DEPTH) ** 0.25
DEEPNORM_BETA = (8.0 * DEPTH) ** -0.25
LN_EPS = 1e-5

kernel_name = "hybrid_pool_conv_mlstm_dit_block"


def layer_norm(x, g, b):
    xf = x.astype(jnp.float32)
    mu = jnp.mean(xf, axis=-1, keepdims=True)
    var = jnp.mean(jnp.square(xf - mu), axis=-1, keepdims=True)
    return ((xf - mu) * lax.rsqrt(var + LN_EPS) * g + b).astype(x.dtype)


def post_norm(x, branch, g, b):
    return layer_norm(DEEPNORM_ALPHA * x + branch, g, b)


def modulate(x, shift, scale):
    return x * (1 + scale) + shift


def swiglu(u, w_in, w_out):
    a, g = jnp.split(u @ w_in, 2, axis=-1)
    return (jax.nn.silu(a) * g) @ w_out


def depthwise_conv1d(x, w, b):
    K = w.shape[0]
    y = lax.conv_general_dilated(x, w[:, None, :], window_strides=(1,),
                                 padding=[(K // 2, K - 1 - K // 2)],
                                 dimension_numbers=('NWC', 'WIO', 'NWC'),
                                 feature_group_count=x.shape[-1])
    return y + b


def box_mean(x, w, axis):
    L = x.shape[axis]
    pad = [(0, 0)] * x.ndim
    pad[axis] = (1, 0)
    cs = jnp.pad(jnp.cumsum(x, axis=axis), pad)
    t = jnp.arange(L)
    lo = jnp.clip(t - w // 2, 0, L)
    hi = jnp.clip(t + w - w // 2, 0, L)
    s = jnp.take(cs, hi, axis=axis) - jnp.take(cs, lo, axis=axis)
    shape = [1] * x.ndim
    shape[axis] = L
    return s / (hi - lo).astype(jnp.float32).reshape(shape)


def pool_conv_mixer(u, rows, w_in, pool_w, pool_b, pool_scale, conv_w, conv_b, norm_g, norm_b, w_out):
    B, L, _ = u.shape
    p = u @ w_in
    a = p[..., :POOL_WIDTH]
    val = p[..., POOL_WIDTH:POOL_WIDTH + CONV_WIDTH]
    gate = p[..., POOL_WIDTH + CONV_WIDTH:]
    diffs = []
    for gi, w in enumerate(POOL_WINDOWS):
        seg = a[..., gi * POOL_GROUP:(gi + 1) * POOL_GROUP].astype(jnp.float32)
        if rows is None:
            pooled = box_mean(seg, w, 1)
        else:
            g2 = seg.reshape(B, rows, GRID_W, POOL_GROUP)
            pooled = box_mean(box_mean(g2, w, 1), w, 2).reshape(B, L, POOL_GROUP)
        diffs.append((pooled - seg).astype(u.dtype))
    d = jnp.stack(diffs, axis=2)
    y_a = (jnp.einsum('blgc,gcd->blgd', d, pool_w).reshape(B, L, POOL_WIDTH) + pool_b) * pool_scale
    glu = val * jax.nn.sigmoid(gate)
    y_b = jax.nn.silu(layer_norm(depthwise_conv1d(glu, conv_w, conv_b), norm_g, norm_b))
    return jnp.concatenate([y_a, y_b], axis=-1) @ w_out


def mlstm_zero_state(B):
    H, DH = MLSTM_HEADS, MLSTM_HEAD_DIM
    return (jnp.zeros((B, H, DH, DH), jnp.float32), jnp.zeros((B, H, DH), jnp.float32),
            jnp.zeros((B, H), jnp.float32))


def mlstm_features(xm, conv_w, conv_b, wq, wk, wv, w_gate, b_gate):
    B, L, E = xm.shape
    H, DH = MLSTM_HEADS, MLSTM_HEAD_DIM
    xc = jax.nn.silu(depthwise_conv1d(xm, conv_w, conv_b))
    xch = xc.reshape(B, L, H, DH)
    q = jnp.einsum('blhd,hde->blhe', xch, wq)
    k = jnp.einsum('blhd,hde->blhe', xch, wk)
    v = jnp.einsum('blhd,hde->blhe', xm.reshape(B, L, H, DH), wv)
    g = (jnp.einsum('ble,zeg->zblg', q.reshape(B, L, E), w_gate[:, 0])
         + jnp.einsum('ble,zeg->zblg', k.reshape(B, L, E), w_gate[:, 1])
         + jnp.einsum('ble,zeg->zblg', v.reshape(B, L, E), w_gate[:, 2])).astype(jnp.float32)
    g = g + b_gate[:, None, None, :].astype(jnp.float32)
    ig = g[..., :H]
    lf = jax.nn.log_sigmoid(g[..., H:])
    return xc, q, k, v, ig, lf


def mlstm_chunk_scan(k, v, ig, lf, state, q=None):
    B, L, H, _ = k.shape
    T = MLSTM_CHUNK
    nc = L // T

    def chunks(a):
        a = a.reshape((B, nc, T, H) + a.shape[3:])
        return jnp.moveaxis(jnp.moveaxis(a, 1, 0), 3, 2)

    def update(carry, kc, vc, ic, fc):
        C, n, m = carry
        b = jnp.cumsum(fc, axis=-1)
        b_last = b[..., -1]
        w_end = b_last[..., None] - b + ic
        m_new = jnp.maximum(b_last + m, jnp.max(w_end, axis=-1))
        decay = jnp.exp(b_last + m - m_new)
        kw = kc * jnp.exp(w_end - m_new[..., None])[..., None]
        C_new = decay[..., None, None] * C + jnp.einsum('bhtk,bhtv->bhkv', kw, vc)
        n_new = decay[..., None] * n + jnp.sum(kw, axis=2)
        return (C_new, n_new, m_new), b

    if q is None:
        def step_state(carry, xs):
            new, _ = update(carry, *xs)
            return new, None
        final, _ = lax.scan(step_state, state, (chunks(k), chunks(v), chunks(ig), chunks(lf)))
        return None, final

    causal = jnp.tril(jnp.ones((T, T), dtype=bool))

    def step(carry, xs):
        qc, kc, vc, ic, fc = xs
        C, n, m = carry
        new, b = update(carry, kc, vc, ic, fc)
        dmat = jnp.where(causal, b[..., :, None] - b[..., None, :] + ic[..., None, :], -jnp.inf)
        inter = b + m[..., None]
        m_t = jnp.maximum(inter, jnp.max(dmat, axis=-1))
        s = jnp.einsum('bhtk,bhsk->bhts', qc, kc) * jnp.exp(dmat - m_t[..., None])
        iw = jnp.exp(inter - m_t)
        num = iw[..., None] * jnp.einsum('bhtk,bhkv->bhtv', qc, C) + jnp.einsum('bhts,bhsv->bhtv', s, vc)
        den = iw * jnp.einsum('bhtk,bhk->bht', qc, n) + jnp.sum(s, axis=-1)
        h = num / jnp.maximum(jnp.abs(den), jnp.exp(-m_t))[..., None]
        return new, h

    final, hs = lax.scan(step, state, (chunks(q), chunks(k), chunks(v), chunks(ig), chunks(lf)))
    hs = jnp.moveaxis(jnp.moveaxis(hs, 0, 1), 2, 3).reshape(B, L, H, -1)
    return hs, final


def _flip(a, d):
    return jnp.flip(a, axis=1) if d == 1 else a


def mlstm_bidir(q, k, v, ig, lf, init_states, with_output):
    kf = k.astype(jnp.float32) * (MLSTM_HEAD_DIM ** -0.5)
    vf = v.astype(jnp.float32)
    qf = q.astype(jnp.float32) if with_output else None
    hs, finals = [], []
    for d in range(2):
        h, st = mlstm_chunk_scan(_flip(kf, d), _flip(vf, d), _flip(ig[d], d), _flip(lf[d], d),
                                 init_states[d], _flip(qf, d) if with_output else None)
        finals.append(st)
        if with_output:
            hs.append(_flip(h, d))
    h_sum = hs[0] + hs[1] if with_output else None
    return h_sum, (finals[0], finals[1])


def mlstm_output(h, xc, z, norm_g, skip, w_out):
    B, L = h.shape[:2]
    mu = jnp.mean(h, axis=-1, keepdims=True)
    var = jnp.mean(jnp.square(h - mu), axis=-1, keepdims=True)
    hn = ((h - mu) * lax.rsqrt(var + LN_EPS)).reshape(B, L, MLSTM_INNER) * norm_g
    y = (hn.astype(xc.dtype) + skip * xc) * jax.nn.silu(z)
    return y @ w_out


def mlstm_mixer(u, uc, w_in, conv_w, conv_b, wq, wk, wv, w_gate, b_gate, norm_g, skip, w_out, ctx_out):
    E = MLSTM_INNER
    feat = (conv_w, conv_b, wq, wk, wv, w_gate, b_gate)
    zero = mlstm_zero_state(u.shape[0])
    if ctx_out:
        xm_c, z_c = jnp.split(uc @ w_in, 2, axis=-1)
    else:
        xm_c = uc @ w_in[:, :E]
    xc_c, q_c, k_c, v_c, ig_c, lf_c = mlstm_features(xm_c, *feat)
    h_c, ctx_states = mlstm_bidir(q_c, k_c, v_c, ig_c, lf_c, (zero, zero), ctx_out)
    xm, z = jnp.split(u @ w_in, 2, axis=-1)
    xc, q, k, v, ig, lf = mlstm_features(xm, *feat)
    h_l, _ = mlstm_bidir(q, k, v, ig, lf, ctx_states, True)
    y = mlstm_output(h_l, xc, z, norm_g, skip, w_out)
    y_c = mlstm_output(h_c, xc_c, z_c, norm_g, skip, w_out) if ctx_out else None
    return y, y_c


def setup_inputs(seed: int = 0) -> dict:
    key = jax.random.key(seed)
    ks = jax.random.split(key, 32)
    D, E, H, DH, F = D_MODEL, MLSTM_INNER, MLSTM_HEADS, MLSTM_HEAD_DIM, FFN_HIDDEN

    def nrm(k, shape, s):
        return jax.random.normal(k, shape, jnp.float32) * s

    f_bias = jnp.broadcast_to(jnp.linspace(3.0, 6.0, H, dtype=jnp.float32), (N_ODD, 2, H))
    ml_b_gate = jnp.concatenate([nrm(ks[22], (N_ODD, 2, H), 0.1),
                                 f_bias + nrm(ks[23], (N_ODD, 2, H), 0.1)], axis=-1)
    return {
        'x': nrm(ks[0], (BATCH, SEQ, D), 1.0),
        'c': nrm(ks[1], (BATCH, D), 1.0),
        'ctx': nrm(ks[2], (BATCH, CTX_LEN, D), 1.0),
        'c_ctx': nrm(ks[3], (D,), 1.0),
        'mod_w': nrm(ks[4], (DEPTH, D, 6 * D), 0.3 * D ** -0.5),
        'mod_b': nrm(ks[5], (DEPTH, 6 * D), 0.02),
        'ln_g': 1.0 + nrm(ks[6], (DEPTH, 2, D), 0.05),
        'ln_b': nrm(ks[7], (DEPTH, 2, D), 0.02),
        'ab_w_in': nrm(ks[8], (N_EVEN, D, POOL_WIDTH + 2 * CONV_WIDTH), D ** -0.5),
        'ab_pool_w': nrm(ks[9], (N_EVEN, len(POOL_WINDOWS), POOL_GROUP, POOL_GROUP), POOL_GROUP ** -0.5),
        'ab_pool_b': nrm(ks[10], (N_EVEN, POOL_WIDTH), 0.02),
        'ab_pool_scale': 1.0 + nrm(ks[11], (N_EVEN, POOL_WIDTH), 0.1),
        'ab_conv_w': nrm(ks[12], (N_EVEN, CONV_K, CONV_WIDTH), CONV_K ** -0.5),
        'ab_conv_b': nrm(ks[13], (N_EVEN, CONV_WIDTH), 0.02),
        'ab_norm_g': 1.0 + nrm(ks[14], (N_EVEN, CONV_WIDTH), 0.05),
        'ab_norm_b': nrm(ks[15], (N_EVEN, CONV_WIDTH), 0.02),
        'ab_w_out': nrm(ks[16], (N_EVEN, POOL_WIDTH + CONV_WIDTH, D), DEEPNORM_BETA * (POOL_WIDTH + CONV_WIDTH) ** -0.5),
        'ml_w_in': nrm(ks[17], (N_ODD, D, 2 * E), D ** -0.5),
        'ml_conv_w': nrm(ks[18], (N_ODD, MLSTM_CONV_K, E), MLSTM_CONV_K ** -0.5),
        'ml_conv_b': nrm(ks[19], (N_ODD, E), 0.02),
        'ml_wq': nrm(ks[20], (N_ODD, H, DH, DH), DH ** -0.5),
        'ml_wk': nrm(ks[21], (N_ODD, H, DH, DH), DH ** -0.5),
        'ml_wv': nrm(ks[24], (N_ODD, H, DH, DH), DH ** -0.5),
        'ml_w_gate': nrm(ks[25], (N_ODD, 2, 3, E, 2 * H), 0.1 * (3 * E) ** -0.5),
        'ml_b_gate': ml_b_gate,
        'ml_norm_g': 1.0 + nrm(ks[26], (N_ODD, E), 0.05),
        'ml_skip': 1.0 + nrm(ks[27], (N_ODD, E), 0.05),
        'ml_w_out': nrm(ks[28], (N_ODD, E, D), DEEPNORM_BETA * E ** -0.5),
        'ffn_w_in': nrm(ks[29], (DEPTH, D, 2 * F), D ** -0.5),
        'ffn_w_out': nrm(ks[30], (DEPTH, F, D), DEEPNORM_BETA * F ** -0.5),
    }


def reference(x, c, ctx, c_ctx, mod_w, mod_b, ln_g, ln_b,
              ab_w_in, ab_pool_w, ab_pool_b, ab_pool_scale, ab_conv_w, ab_conv_b, ab_norm_g, ab_norm_b, ab_w_out,
              ml_w_in, ml_conv_w, ml_conv_b, ml_wq, ml_wk, ml_wv, ml_w_gate, ml_b_gate, ml_norm_g, ml_skip, ml_w_out,
              ffn_w_in, ffn_w_out):
    rows = x.shape[1] // GRID_W
    silu_c = jax.nn.silu(c)
    silu_cc = jax.nn.silu(c_ctx)
    h, hc = x, ctx
    for l in range(DEPTH):
        last = l == DEPTH - 1
        even = l % 2 == 0
        j = l // 2
        mods = (silu_c @ mod_w[l] + mod_b[l])[:, None, :]
        sh_m, sc_m, g_m, sh_f, sc_f, g_f = jnp.split(mods, 6, axis=-1)
        ctx_mixer_needed = (not last) or (not even)
        if ctx_mixer_needed:
            n_cols = 6 * D_MODEL if not last else 2 * D_MODEL
            cmods = jnp.split(silu_cc @ mod_w[l][:, :n_cols] + mod_b[l][:n_cols], n_cols // D_MODEL)
            uc = modulate(hc, cmods[0], cmods[1])
        u = modulate(h, sh_m, sc_m)
        if even:
            ab = (ab_w_in[j], ab_pool_w[j], ab_pool_b[j], ab_pool_scale[j], ab_conv_w[j], ab_conv_b[j],
                  ab_norm_g[j], ab_norm_b[j], ab_w_out[j])
            y = pool_conv_mixer(u, rows, *ab)
            y_c = pool_conv_mixer(uc, None, *ab) if not last else None
        else:
            y, y_c = mlstm_mixer(u, uc, ml_w_in[j], ml_conv_w[j], ml_conv_b[j], ml_wq[j], ml_wk[j], ml_wv[j],
                                 ml_w_gate[j], ml_b_gate[j], ml_norm_g[j], ml_skip[j], ml_w_out[j],
                                 ctx_out=not last)
        h = post_norm(h, g_m * y, ln_g[l, 0], ln_b[l, 0])
        h = post_norm(h, g_f * swiglu(modulate(h, sh_f, sc_f), ffn_w_in[l], ffn_w_out[l]), ln_g[l, 1], ln_b[l, 1])
        if not last:
            hc = post_norm(hc, cmods[2] * y_c, ln_g[l, 0], ln_b[l, 0])
            hc = post_norm(hc, cmods[5] * swiglu(modulate(hc, cmods[3], cmods[4]), ffn_w_in[l], ffn_w_out[l]),
                           ln_g[l, 1], ln_b[l, 1])
    return h
```

```cpp
#include <hip/hip_runtime.h>
#include <hip/hip_cooperative_groups.h>
#include <cstdio>
namespace cg = cooperative_groups;

#define LAS __attribute__((address_space(3)))
#define DI __device__ __forceinline__
typedef unsigned short bf16_t;
typedef short bf16x8 __attribute__((ext_vector_type(8)));
typedef float f32x4 __attribute__((ext_vector_type(4)));
typedef unsigned u32x4 __attribute__((ext_vector_type(4)));
typedef unsigned u32x2 __attribute__((ext_vector_type(2)));
typedef _Float16 f16x8 __attribute__((ext_vector_type(8)));

constexpr int DM = 1024, NB = 8, SEQ = 4096, CTXL = 256, NR = 34816, HR = 17408, HLAT = 16384;
constexpr int FF = 2816, EIN = 2048, DH = 512;
constexpr float ALPHA = 1.41421356237f, LNEPS = 1e-5f, KSCALE = 0.04419417382f;
constexpr size_t MiB = 1048576;
constexpr size_t O_HB = 0, O_W = 68 * MiB;
constexpr size_t W_ABIN = O_W, W_POOL = W_ABIN + 3145728, W_ABOUT = W_POOL + 524288, W_FFNIN = W_ABOUT + 2097152  ,
                 W_FFNOUT = W_FFNIN + 2 * 11534336  , W_MLIN = W_FFNOUT + 2 * 5767168, W_Q = W_MLIN + 8388608, W_K = W_Q + 2097152,
                 W_V = W_K + 2097152, W_MLOUT = W_V + 2097152, W_AQK = W_MLOUT + 4194304, W_AV = W_AQK + 65536, W_MODS = W_AV + 65536,
                 W_END = W_MODS + 442368;
static_assert(W_END <= 128 * MiB, "weights region");
constexpr size_t RS = 68 * MiB;
constexpr size_t S_UB = 0, S_R1 = RS, S_R2 = 2 * RS, S_R3 = 3 * RS, S_R4 = 4 * RS, S_R5 = 5 * RS, S_R6 = 6 * RS, S_MISC = 7 * RS;
constexpr size_t S_GATES = S_MISC, S_BAR = S_MISC + 4 * MiB;
constexpr size_t WS_NEED = S_BAR + 4096;

constexpr int LDS_BYTES = 160 * 1024;

struct Params {
    const float* in[30];
    unsigned char* out;
    unsigned char* ws;
};

DI unsigned cvt_pk_bf16(float lo, float hi) { unsigned r; asm volatile("v_cvt_pk_bf16_f32 %0, %1, %2" : "=v"(r) : "v"(lo), "v"(hi)); return r; }
DI int opaque_tid() { int t = threadIdx.x; asm volatile("" : "+v"(t)); return t; }
#define TIDX opaque_tid()
DI float bf2f(unsigned short b) { return __uint_as_float(((unsigned)b) << 16); }
DI float bflo(unsigned w) { return __uint_as_float(w << 16); }
DI float bfhi(unsigned w) { return __uint_as_float(w & 0xffff0000u); }
DI float sigmoidf_(float x) { return 1.0f / (1.0f + __expf(-x)); }
DI float siluf_(float x) { return x / (1.0f + __expf(-x)); }
DI float wave_sum(float v) {
#pragma unroll
    for (int o = 32; o >= 1; o >>= 1) v += __shfl_xor(v, o);
    return v;
}
DI float wave_max(float v) {
#pragma unroll
    for (int o = 32; o >= 1; o >>= 1) v = fmaxf(v, __shfl_xor(v, o));
    return v;
}
DI int row_bm(int R) { const int hf = R >= HR ? 1 : 0; const int r = R - hf * HR; return r < HLAT ? hf * 4 + (r >> 12) : 8; }
DI const float* row_src(const Params& p, int R) {
    const int hf = R >= HR ? 1 : 0; const int r = R - hf * HR;
    if (r < HLAT) return p.in[0] + ((size_t)(hf * 4 + (r >> 12)) * SEQ + (r & 4095)) * DM;
    const int rc = r - HLAT; return p.in[2] + ((size_t)(hf * 4 + (rc >> 8)) * CTXL + (rc & 255)) * DM;
}

DI void grid_bar(unsigned* ctr, unsigned& gen) {
    __threadfence();
    __syncthreads();
    gen += 1;
    if (threadIdx.x == 0) {
        __hip_atomic_fetch_add(ctr, 1u, __ATOMIC_RELEASE, __HIP_MEMORY_SCOPE_AGENT);
        const unsigned target = gen * gridDim.x;
        while (__hip_atomic_load(ctr, __ATOMIC_RELAXED, __HIP_MEMORY_SCOPE_AGENT) < target) __builtin_amdgcn_s_sleep(4);
    }
    __syncthreads();
    __threadfence();
    __builtin_amdgcn_fence(__ATOMIC_ACQUIRE, "agent");
}

constexpr int BM = 256, BK = 64, HALF = 128, HTB = HALF * BK * 2;
DI int lds_byte(int r, int c) { const int st = (r >> 4) * 2 + (c >> 5), rr = r & 15, cc = c & 31, ob = rr * 64 + cc * 2; return st * 1024 + (ob ^ (((ob >> 9) & 1) << 5)); }
DI void stage_rc(int b, int& R, int& C) { const int st = b / 1024, sb = b % 1024, swz = sb ^ (((sb >> 9) & 1) << 5); R = (st >> 1) * 16 + swz / 64; C = (st & 1) * 32 + (swz % 64) / 2; }
DI int perm32(int rho) { const int n = rho >> 4, i = rho & 15; return 8 * (i >> 2) + 4 * n + (i & 3); }

struct Unit { const char* a; const char* b; int pm, pn, sub; };
struct GemmCfg { unsigned a_rs, a_cs, b_rs, b_cs; int nt; };
struct Sch {
    int nM, nN, nsub, G, c;
    const char* A0; const char* B0;
    size_t a_tile, b_tile, a_sub, b_sub; int a_mod, b_mod;
    DI bool next(int i, Unit& u) const {
        const long L = (long)i * G + c; const int per = nM * nN, nwg = per * nsub; if (L >= nwg) return false;
        int wgid = (int)L; { const int q = nwg / 8, r = nwg % 8, xcd = wgid % 8, off = wgid / 8; wgid = (xcd < r ? xcd * (q + 1) : r * (q + 1) + (xcd - r) * q) + off; }
        const int sub = wgid / per; wgid -= sub * per;
        const int nig = 8 * nN, gid = wgid / nig, fm = gid * 8, gsz = (nM - fm) < 8 ? (nM - fm) : 8;
        u.pm = fm + ((wgid % nig) % gsz); u.pn = (wgid % nig) / gsz; u.sub = sub;
        u.a = A0 + (size_t)u.pm * a_tile + (size_t)(a_mod ? sub % a_mod : sub) * a_sub;
        u.b = B0 + (size_t)u.pn * b_tile + (size_t)(b_mod ? sub % b_mod : sub) * b_sub;
        return true;
    }
};

template <class Epi>
DI void gemm_phase(LAS unsigned char* lds, const GemmCfg g, const Sch& S, const Epi& E) {
    const int tid = TIDX, wid = __builtin_amdgcn_readfirstlane(tid >> 6), lane = tid & 63, wr = wid >> 2, wc = wid & 3, fr = lane & 15, fq = lane >> 4;
    const int nt = g.nt;
    unsigned voffA[2], voffB[2];
#pragma unroll
    for (int i = 0; i < 2; ++i) { int R, C; stage_rc(tid * 16 + i * 8192, R, C); const int Rb = (R & ~31) + perm32(R & 31);
        voffA[i] = (unsigned)R * g.a_rs + (unsigned)(C >> 3) * g.a_cs; voffB[i] = (unsigned)Rb * g.b_rs + (unsigned)(C >> 3) * g.b_cs; }
    const size_t kstepA = (size_t)8 * g.a_cs, kstepB = (size_t)8 * g.b_cs, hstepA = (size_t)HALF * g.a_rs, hstepB = (size_t)HALF * g.b_rs;
    const unsigned ldsw = (unsigned)wid * 1024u;
    const int aoff = lds_byte(wr * 64 + fr, fq * 8), boff = lds_byte(wc * 32 + fr, fq * 8);
#define G_SA(b, h) (((b) * 2 + (h)) * HTB)
#define G_SB(b, h) ((4 + (b) * 2 + (h)) * HTB)
#define G_STAGE(bufoff, gbase, voff) do { _Pragma("unroll") for (int _i = 0; _i < 2; ++_i) \
        __builtin_amdgcn_global_load_lds((const unsigned*)((const char*)(gbase) + (voff)[_i]), (LAS unsigned*)(lds + (bufoff) + ldsw + _i * 8192), 16, 0, 0); } while (0)
#define G_LDA(dst, b, h) do { _Pragma("unroll") for (int m = 0; m < 4; ++m) _Pragma("unroll") for (int k = 0; k < 2; ++k) dst[m][k] = *(const LAS bf16x8*)(lds + G_SA(b, h) + aoff + m * 2048 + k * 1024); } while (0)
#define G_LDB(dst, b, h) do { _Pragma("unroll") for (int n = 0; n < 2; ++n) _Pragma("unroll") for (int k = 0; k < 2; ++k) dst[n][k] = *(const LAS bf16x8*)(lds + G_SB(b, h) + boff + n * 2048 + k * 1024); } while (0)
#define G_MMA(ai, bj, At, Bt) do { __builtin_amdgcn_s_setprio(1); _Pragma("unroll") for (int m = 0; m < 4; ++m) _Pragma("unroll") for (int n = 0; n < 2; ++n) _Pragma("unroll") for (int k = 0; k < 2; ++k) \
        acc[ai][bj][m][n] = __builtin_amdgcn_mfma_f32_16x16x32_bf16(Bt[n][k], At[m][k], acc[ai][bj][m][n], 0, 0, 0); __builtin_amdgcn_s_setprio(0); } while (0)
#define G_WAIT_V(n) asm volatile("s_waitcnt vmcnt(" #n ")" ::: "memory")
#define G_WAIT_L(n) asm volatile("s_waitcnt lgkmcnt(" #n ")" ::: "memory")
#define G_BAR __builtin_amdgcn_s_barrier()
#define G_SCHED __builtin_amdgcn_sched_barrier(0)
    Unit cur, nxt; int ui = 0;
    if (!S.next(0, cur)) return;
    f32x4 acc[2][2][4][2];
#pragma unroll
    for (int a = 0; a < 2; ++a)
#pragma unroll
        for (int b = 0; b < 2; ++b)
#pragma unroll
            for (int m = 0; m < 4; ++m)
#pragma unroll
                for (int n = 0; n < 2; ++n) acc[a][b][m][n] = (f32x4){0.f, 0.f, 0.f, 0.f};
    bf16x8 At[4][2], B0[2][2], B1[2][2];
    const char* cA = cur.a; const char* cB = cur.b;
    G_STAGE(G_SB(0, 0), cB, voffB); G_STAGE(G_SA(0, 0), cA, voffA); G_STAGE(G_SB(0, 1), cB + hstepB, voffB); G_STAGE(G_SA(0, 1), cA + hstepA, voffA);
    if (wr == 1) G_BAR;
    G_WAIT_V(4); G_BAR;
    G_STAGE(G_SB(1, 0), cB + kstepB, voffB); G_STAGE(G_SA(1, 0), cA + kstepA, voffA); G_STAGE(G_SB(1, 1), cB + hstepB + kstepB, voffB);
    G_WAIT_V(6); G_BAR;
    for (;;) {
        const bool has_next = S.next(ui + 1, nxt);
        const char* nA = has_next ? nxt.a : cA; const char* nB = has_next ? nxt.b : cB;
        for (int t = 0; t < nt; t += 2) {
            const bool last = (t == nt - 2);
            const char* a1 = cA + (size_t)(t + 1) * kstepA;
            const char* a2 = last ? nA : cA + (size_t)(t + 2) * kstepA; const char* b2 = last ? nB : cB + (size_t)(t + 2) * kstepB;
            const char* a3 = a2 + kstepA; const char* b3 = b2 + kstepB;
            G_LDB(B0, 0, 0); G_SCHED; G_LDA(At, 0, 0); G_STAGE(G_SA(1, 1), a1 + hstepA, voffA);
            G_WAIT_L(8); G_BAR; G_WAIT_L(0); G_MMA(0, 0, At, B0); G_BAR; G_SCHED;
            G_LDB(B1, 0, 1); G_STAGE(G_SB(0, 0), b2, voffB);
            G_BAR; G_WAIT_L(0); G_MMA(0, 1, At, B1); G_BAR;
            G_LDA(At, 0, 1); G_STAGE(G_SA(0, 0), a2, voffA);
            G_BAR; G_WAIT_L(0); G_MMA(1, 0, At, B0); G_BAR; G_SCHED;
            G_STAGE(G_SB(0, 1), b2 + hstepB, voffB);
            G_WAIT_V(6); G_BAR; G_MMA(1, 1, At, B1); G_BAR;
            G_LDB(B0, 1, 0); G_SCHED; G_LDA(At, 1, 0); G_STAGE(G_SA(0, 1), a2 + hstepA, voffA);
            G_WAIT_L(8); G_BAR; G_WAIT_L(0); G_MMA(0, 0, At, B0); G_BAR; G_SCHED;
            G_LDB(B1, 1, 1); G_STAGE(G_SB(1, 0), b3, voffB);
            G_BAR; G_WAIT_L(0); G_MMA(0, 1, At, B1); G_BAR;
            G_LDA(At, 1, 1); G_STAGE(G_SA(1, 0), a3, voffA);
            G_BAR; G_WAIT_L(0); G_MMA(1, 0, At, B0); G_BAR; G_SCHED;
            G_STAGE(G_SB(1, 1), b3 + hstepB, voffB);
            G_WAIT_V(6); G_BAR; G_MMA(1, 1, At, B1); G_BAR;
        }
        E(acc, cur, wr, wc, fr, fq);
        if (!has_next) break;
#pragma unroll
        for (int a = 0; a < 2; ++a)
#pragma unroll
            for (int b = 0; b < 2; ++b)
#pragma unroll
                for (int m = 0; m < 4; ++m)
#pragma unroll
                    for (int n = 0; n < 2; ++n) acc[a][b][m][n] = (f32x4){0.f, 0.f, 0.f, 0.f};
        cur = nxt; cA = nA; cB = nB; ++ui;
    }
    G_WAIT_V(0);
    if (wr == 0) G_BAR;
    G_BAR;
#undef G_SA
#undef G_SB
#undef G_STAGE
#undef G_LDA
#undef G_LDB
#undef G_MMA
}

#define EPI_ARGS const f32x4 (&acc)[2][2][4][2], const Unit& u, int wr, int wc, int fr, int fq
DI u32x4 pack8(const f32x4 v0, const f32x4 v1) { u32x4 w; w.x = cvt_pk_bf16(v0[0], v0[1]); w.y = cvt_pk_bf16(v0[2], v0[3]); w.z = cvt_pk_bf16(v1[0], v1[1]); w.w = cvt_pk_bf16(v1[2], v1[3]); return w; }

struct EpiAbIn {
    bf16_t* aslab; bf16_t* glu;
    DI void operator()(EPI_ARGS) const {
        const int row0 = u.pm * BM + wr * 64 + fr;
#pragma unroll
        for (int ai = 0; ai < 2; ++ai)
#pragma unroll
            for (int m = 0; m < 4; ++m) { const int R = row0 + ai * HALF + m * 16;
                if (u.pn < 2) {
#pragma unroll
                    for (int bj = 0; bj < 2; ++bj) { const int col = u.pn * BM + bj * HALF + wc * 32 + 8 * fq;
                        *(u32x4*)(aslab + ((size_t)(col >> 3) * NR + R) * 8) = pack8(acc[ai][bj][m][0], acc[ai][bj][m][1]); }
                } else {
                    f32x4 g0, g1;
#pragma unroll
                    for (int j = 0; j < 4; ++j) { g0[j] = acc[ai][0][m][0][j] * sigmoidf_(acc[ai][1][m][0][j]); g1[j] = acc[ai][0][m][1][j] * sigmoidf_(acc[ai][1][m][1][j]); }
                    *(u32x4*)(glu + (size_t)R * 512 + (u.pn - 2) * 128 + wc * 32 + 8 * fq) = pack8(g0, g1);
                } }
    }
};
struct EpiPool {
    bf16_t* ycat; const float* pb; const float* ps;
    DI void operator()(EPI_ARGS) const {
        const int row0 = u.pm * BM + wr * 64 + fr;
#pragma unroll
        for (int bj = 0; bj < 2; ++bj) { const int col = u.pn * BM + bj * HALF + wc * 32 + 8 * fq;
            const f32x4 b0 = *(const f32x4*)(pb + col), b1 = *(const f32x4*)(pb + col + 4), s0 = *(const f32x4*)(ps + col), s1 = *(const f32x4*)(ps + col + 4);
#pragma unroll
            for (int ai = 0; ai < 2; ++ai)
#pragma unroll
                for (int m = 0; m < 4; ++m) { const int R = row0 + ai * HALF + m * 16;
                    *(u32x4*)(ycat + (size_t)R * 1024 + col) = pack8((acc[ai][bj][m][0] + b0) * s0, (acc[ai][bj][m][1] + b1) * s1); } }
    }
};
struct EpiRes {
    const _Float16* src; _Float16* dst; const float* gate; int row_sub;
    DI void operator()(EPI_ARGS) const {
        const int row0 = u.sub * row_sub + u.pm * BM + wr * 64 + fr;
#pragma unroll
        for (int ai = 0; ai < 2; ++ai)
#pragma unroll
            for (int m = 0; m < 4; ++m) { const int R = row0 + ai * HALF + m * 16; const float* gp = gate + (size_t)row_bm(R) * 6144;
#pragma unroll
                for (int bj = 0; bj < 2; ++bj) { const int col = u.pn * BM + bj * HALF + wc * 32 + 8 * fq;
                    const f32x4 g0 = *(const f32x4*)(gp + col), g1 = *(const f32x4*)(gp + col + 4);
                    const f16x8 hv = *(const f16x8*)(src + (size_t)R * 1024 + col); f16x8 o;
#pragma unroll
                    for (int j = 0; j < 4; ++j) { o[j] = (_Float16)(ALPHA * (float)hv[j] + g0[j] * acc[ai][bj][m][0][j]); o[4 + j] = (_Float16)(ALPHA * (float)hv[4 + j] + g1[j] * acc[ai][bj][m][1][j]); }
                    *(f16x8*)(dst + (size_t)R * 1024 + col) = o; } }
    }
};
struct EpiFfnIn {
    bf16_t* hid; int row_sub;
    DI void operator()(EPI_ARGS) const {
        const int row0 = u.sub * row_sub + u.pm * BM + wr * 64 + fr;
#pragma unroll
        for (int ai = 0; ai < 2; ++ai)
#pragma unroll
            for (int m = 0; m < 4; ++m) { const int R = row0 + ai * HALF + m * 16; f32x4 g0, g1;
#pragma unroll
                for (int j = 0; j < 4; ++j) { g0[j] = siluf_(acc[ai][0][m][0][j]) * acc[ai][1][m][0][j]; g1[j] = siluf_(acc[ai][0][m][1][j]) * acc[ai][1][m][1][j]; }
                *(u32x4*)(hid + (size_t)R * FF + u.pn * 128 + wc * 32 + 8 * fq) = pack8(g0, g1); }
    }
};
struct EpiPlain {
    bf16_t* out; int ld;
    DI void operator()(EPI_ARGS) const {
        const int row0 = u.pm * BM + wr * 64 + fr;
#pragma unroll
        for (int ai = 0; ai < 2; ++ai)
#pragma unroll
            for (int m = 0; m < 4; ++m) { const int R = row0 + ai * HALF + m * 16;
#pragma unroll
                for (int bj = 0; bj < 2; ++bj) { const int col = u.pn * BM + bj * HALF + wc * 32 + 8 * fq;
                    *(u32x4*)(out + (size_t)R * ld + col) = pack8(acc[ai][bj][m][0], acc[ai][bj][m][1]); } }
    }
};
struct EpiQK {
    bf16_t* q; bf16_t* k;
    DI void operator()(EPI_ARGS) const {
        const int which = u.sub >> 2, h = u.sub & 3; bf16_t* dst = which ? k : q; const float sc = which ? KSCALE : 1.0f;
        const int row0 = u.pm * BM + wr * 64 + fr;
#pragma unroll
        for (int ai = 0; ai < 2; ++ai)
#pragma unroll
            for (int m = 0; m < 4; ++m) { const int r = row0 + ai * HALF + m * 16; bf16_t* rp = dst + (((size_t)(r >> 6) * 4 + h) * 64 + (r & 63)) * 512;
#pragma unroll
                for (int bj = 0; bj < 2; ++bj) { const int col = u.pn * BM + bj * HALF + wc * 32 + 8 * fq;
                    *(u32x4*)(rp + col) = pack8(acc[ai][bj][m][0] * sc, acc[ai][bj][m][1] * sc); } }
    }
};
struct EpiVT {
    bf16_t* vt;
    DI void operator()(EPI_ARGS) const {
        const int h = u.sub; const int row0 = u.pm * BM + wr * 64 + fr;
#pragma unroll
        for (int ai = 0; ai < 2; ++ai)
#pragma unroll
            for (int m = 0; m < 4; ++m) { const int dv = row0 + ai * HALF + m * 16;
#pragma unroll
                for (int bj = 0; bj < 2; ++bj) { const int r = u.pn * BM + bj * HALF + wc * 32 + 8 * fq;
                    *(u32x4*)(vt + (((size_t)(r >> 6) * 4 + h) * 512 + dv) * 64 + (r & 63)) = pack8(acc[ai][bj][m][0], acc[ai][bj][m][1]); } }
    }
};

struct TJob { const float* src; bf16_t* dst; int K, N, sld, dld, map, ntile; };
DI int srccol(int map, int n) {
    if (map == 1) { if (n < 512) return n; const int j = (n - 512) >> 8, w = (n - 512) & 255; return w < 128 ? 512 + 128 * j + w : 1024 + 128 * j + (w - 128); }
    if (map == 2) { const int j = n >> 8, w = n & 255; return w < 128 ? 128 * j + w : FF + 128 * j + (w - 128); }
    return n;
}
constexpr int NJOB = 24;
DI TJob get_job(const Params& p, int j) {
    TJob t; bf16_t* W = (bf16_t*)p.out; t.map = 0;
    if (j == 0) { t.src = p.in[8]; t.dst = (bf16_t*)(p.out + W_ABIN); t.K = 1024; t.N = 1536; t.sld = 1536; t.dld = 1024; t.map = 1; }
    else if (j == 1) { t.src = p.in[16]; t.dst = (bf16_t*)(p.out + W_ABOUT); t.K = 1024; t.N = 1024; t.sld = 1024; t.dld = 1024; }
    else if (j < 4) { const int l = j - 2; t.src = p.in[28] + (size_t)l * 1024 * 5632; t.dst = (bf16_t*)(p.out + W_FFNIN + (size_t)l * 11534336); t.K = 1024; t.N = 5632; t.sld = 5632; t.dld = 1024; t.map = 2; }
    else if (j < 6) { const int l = j - 4; t.src = p.in[29] + (size_t)l * FF * 1024; t.dst = (bf16_t*)(p.out + W_FFNOUT + (size_t)l * 5767168); t.K = FF; t.N = 1024; t.sld = 1024; t.dld = FF; }
    else if (j == 6) { t.src = p.in[17]; t.dst = (bf16_t*)(p.out + W_MLIN); t.K = 1024; t.N = 4096; t.sld = 4096; t.dld = 1024; }
    else if (j < 19) { const int w = (j - 7) >> 2, h = (j - 7) & 3; t.src = p.in[w == 0 ? 20 : (w == 1 ? 21 : 22)] + (size_t)h * 512 * 512; t.dst = (bf16_t*)(p.out + W_Q + (size_t)w * 2097152) + (size_t)h * 512 * 512; t.K = 512; t.N = 512; t.sld = 512; t.dld = 512; }
    else if (j == 19) { t.src = p.in[27]; t.dst = (bf16_t*)(p.out + W_MLOUT); t.K = 2048; t.N = 1024; t.sld = 1024; t.dld = 2048; }
    else { const int g = j - 20; t.src = p.in[9] + (size_t)g * 128 * 128; t.dst = (bf16_t*)(p.out + W_POOL) + (size_t)g * 128 * 512 + g * 128; t.K = 128; t.N = 128; t.sld = 128; t.dld = 512; }
    (void)W; t.ntile = (t.K / 64) * (t.N / 64); return t;
}
__device__ void phase_prep(const Params& p, LAS unsigned char* lds) {
    const int tid = TIDX, G = 256;
    LAS float* tile = (LAS float*)lds;
    int base = 0;
    for (int j = 0; j < NJOB; ++j) {
        const TJob t = get_job(p, j); const int nkt = t.K / 64;
        for (int ti = blockIdx.x - base; ti < t.ntile; ti += G) { if (ti < 0) continue;
            const int kt = ti % nkt, nt_ = ti / nkt, k0 = kt * 64, n0 = nt_ * 64, sc0 = srccol(t.map, n0);
            const int i = tid >> 6, jj = tid & 63;
#pragma unroll
            for (int rr = 0; rr < 8; ++rr) tile[(i * 8 + rr) * 65 + jj] = t.src[(size_t)(k0 + i * 8 + rr) * t.sld + sc0 + jj];
            __syncthreads();
#pragma unroll
            for (int rr = 0; rr < 8; ++rr) { const int n = i * 8 + rr; t.dst[(size_t)(n0 + n) * t.dld + k0 + jj] = (bf16_t)(cvt_pk_bf16(tile[jj * 65 + n], 0.f) & 0xffffu); }
            __syncthreads();
        }
        base += t.ntile; while (base >= G) base -= G;
    }
    { bf16_t* wp = (bf16_t*)(p.out + W_POOL);
      for (int i = blockIdx.x * 512 + tid; i < 512 * 512; i += G * 512) { const int n = i >> 9, k = i & 511; if ((n >> 7) != (k >> 7)) wp[i] = 0; } }
    { LAS float* sc = (LAS float*)lds;
      LAS float* red = (LAS float*)(lds + 9 * 1024 * 4);
      __syncthreads();
      for (int i = tid; i < 9 * 1024; i += 512) { const float v = i < 8192 ? p.in[1][i] : p.in[3][i - 8192]; sc[i] = siluf_(v); }
      __syncthreads();
      float* mods = (float*)(p.out + W_MODS);
      for (int job = blockIdx.x; job < 96; job += G) {
          const int l = job / 48, nb = job % 48, col = nb * 128 + (tid & 127), kq = tid >> 7;
          const float* w = p.in[4] + (size_t)l * 1024 * 6144 + col;
          float a[9];
#pragma unroll
          for (int b = 0; b < 9; ++b) a[b] = 0.f;
          for (int k = kq * 256; k < kq * 256 + 256; ++k) { const float wv = w[(size_t)k * 6144];
#pragma unroll
              for (int b = 0; b < 9; ++b) a[b] += sc[b * 1024 + k] * wv; }
#pragma unroll
          for (int b = 0; b < 9; ++b) red[(kq * 9 + b) * 128 + (tid & 127)] = a[b];
          __syncthreads();
          for (int i = tid; i < 9 * 128; i += 512) { const int b = i >> 7, c = i & 127;
              mods[((size_t)l * 9 + b) * 6144 + nb * 128 + c] = red[(0 * 9 + b) * 128 + c] + red[(1 * 9 + b) * 128 + c] + red[(2 * 9 + b) * 128 + c] + red[(3 * 9 + b) * 128 + c] + p.in[5][(size_t)l * 6144 + nb * 128 + c]; }
          __syncthreads();
      } }
    { const int wave = (blockIdx.x * 512 + tid) >> 6, lane = tid & 63, nw = G * 8;
      bf16_t* aqk = (bf16_t*)(p.out + W_AQK); bf16_t* av = (bf16_t*)(p.out + W_AV);
      for (int job = wave; job < 4096; job += nw) {
          const int isv = job >> 11, hc = job & 2047, h = hc >> 9, c = hc & 511;
          float a[16];
#pragma unroll
          for (int g = 0; g < 16; ++g) a[g] = 0.f;
          const int npass = isv ? 1 : 2;
          for (int ps = 0; ps < npass; ++ps) {
              const int which = isv ? 2 : ps;
              const float* wrow = p.in[which == 0 ? 20 : (which == 1 ? 21 : 22)] + ((size_t)h * 512 + c) * 512 + lane * 8;
#pragma unroll
              for (int e = 0; e < 8; ++e) { const float wv = wrow[e]; const int ef = h * 512 + lane * 8 + e;
#pragma unroll
                  for (int z = 0; z < 2; ++z) { const float* gp = p.in[23] + (((size_t)z * 3 + which) * 2048 + ef) * 8;
#pragma unroll
                      for (int jx = 0; jx < 8; ++jx) a[z * 8 + jx] += wv * gp[jx]; } }
          }
#pragma unroll
          for (int g = 0; g < 16; ++g) { const float s = wave_sum(a[g]); if (lane == g) (isv ? av : aqk)[(size_t)g * 2048 + hc] = (bf16_t)(cvt_pk_bf16(s, 0.f) & 0xffffu); }
      } }
}

__device__ void phase_embed(const Params& p) {
    const int tid_ = TIDX; const int wave = (blockIdx.x * 512 + tid_) >> 6, lane = tid_ & 63, nw = 2048;
    const float* mods = (const float*)(p.out + W_MODS); _Float16* hb = (_Float16*)(p.out + O_HB); bf16_t* ub = (bf16_t*)(p.ws + S_UB);
    for (int R = wave; R < NR; R += nw) {
        const float* src = row_src(p, R); const float* mp = mods + (size_t)row_bm(R) * 6144;
#pragma unroll
        for (int i = 0; i < 2; ++i) { const int c = lane * 8 + i * 512;
            const f32x4 x0 = *(const f32x4*)(src + c), x1 = *(const f32x4*)(src + c + 4);
            const f32x4 sh0 = *(const f32x4*)(mp + c), sh1 = *(const f32x4*)(mp + c + 4), sc0 = *(const f32x4*)(mp + 1024 + c), sc1 = *(const f32x4*)(mp + 1024 + c + 4);
            f16x8 hv;
#pragma unroll
            for (int j = 0; j < 4; ++j) { hv[j] = (_Float16)x0[j]; hv[4 + j] = (_Float16)x1[j]; }
            *(f16x8*)(hb + (size_t)R * 1024 + c) = hv;
            *(u32x4*)(ub + (size_t)R * 1024 + c) = pack8(x0 * (sc0 + 1.0f) + sh0, x1 * (sc1 + 1.0f) + sh1); }
    }
}
__device__ void phase_ln(const Params& p, const _Float16* tsrc, int l, int which, int mod_l, int mod_idx, int mode) {
    const int tid_ = TIDX; const int wave = (blockIdx.x * 512 + tid_) >> 6, lane = tid_ & 63, nw = 2048;
    const float* mods = (const float*)(p.out + W_MODS) + (size_t)(mod_l < 0 ? 0 : mod_l) * 9 * 6144; _Float16* hb = (_Float16*)(p.out + O_HB); bf16_t* ub = (bf16_t*)(p.ws + S_UB);
    const float* lg = p.in[6] + ((size_t)l * 2 + which) * 1024; const float* lb = p.in[7] + ((size_t)l * 2 + which) * 1024;
    for (int R = wave; R < NR; R += nw) {
        const int hf = R >= HR ? 1 : 0, r = R - hf * HR; if (mode != 0 && r >= HLAT) continue;
        const f16x8 t0 = *(const f16x8*)(tsrc + (size_t)R * 1024 + lane * 8), t1 = *(const f16x8*)(tsrc + (size_t)R * 1024 + 512 + lane * 8);
        float x[16]; float s = 0.f;
#pragma unroll
        for (int j = 0; j < 8; ++j) { x[j] = (float)t0[j]; x[8 + j] = (float)t1[j]; s += x[j] + x[8 + j]; }
        const float mu = wave_sum(s) * (1.0f / 1024.0f); float q = 0.f;
#pragma unroll
        for (int j = 0; j < 16; ++j) { x[j] -= mu; q += x[j] * x[j]; }
        const float rstd = rsqrtf(wave_sum(q) * (1.0f / 1024.0f) + LNEPS);
        const float* mp = mods + (size_t)row_bm(R) * 6144;
#pragma unroll
        for (int i = 0; i < 2; ++i) { const int c = lane * 8 + i * 512;
            const f32x4 g0 = *(const f32x4*)(lg + c), g1 = *(const f32x4*)(lg + c + 4), b0 = *(const f32x4*)(lb + c), b1 = *(const f32x4*)(lb + c + 4);
            f32x4 h0, h1;
#pragma unroll
            for (int j = 0; j < 4; ++j) { h0[j] = x[i * 8 + j] * rstd * g0[j] + b0[j]; h1[j] = x[i * 8 + 4 + j] * rstd * g1[j] + b1[j]; }
            if (mode == 2) {
                float* o = (float*)p.out + ((size_t)(hf * 4 + (r >> 12)) * SEQ + (r & 4095)) * DM + c;
                *(f32x4*)o = h0; *(f32x4*)(o + 4) = h1;
            } else {
                f16x8 hv;
#pragma unroll
                for (int j = 0; j < 4; ++j) { hv[j] = (_Float16)h0[j]; hv[4 + j] = (_Float16)h1[j]; }
                *(f16x8*)(hb + (size_t)R * 1024 + c) = hv;
                const f32x4 sh0 = *(const f32x4*)(mp + mod_idx * 1024 + c), sh1 = *(const f32x4*)(mp + mod_idx * 1024 + c + 4);
                const f32x4 sc0 = *(const f32x4*)(mp + (mod_idx + 1) * 1024 + c), sc1 = *(const f32x4*)(mp + (mod_idx + 1) * 1024 + c + 4);
                *(u32x4*)(ub + (size_t)R * 1024 + c) = pack8(h0 * (sc0 + 1.0f) + sh0, h1 * (sc1 + 1.0f) + sh1);
            } }
    }
}

template <int W>
DI void box64(const float (&v)[64], LAS float* dst, int stride) {
#pragma unroll
    for (int t = 0; t < 64; ++t) { const int lo = t - W / 2 < 0 ? 0 : t - W / 2, hi = t + W - W / 2 > 64 ? 64 : t + W - W / 2; float s = 0.f;
#pragma unroll
        for (int j = lo; j < hi; ++j) s += v[j];
        dst[t * stride] = s * (1.0f / (float)(hi - lo)); }
}
template <int W>
DI void pool_lat_item(bf16_t* slab  , LAS float* buf) {
    const int tid = TIDX;
#pragma unroll
    for (int i = 0; i < 8; ++i) { const int t = tid + i * 512; const u32x4 w = *(const u32x4*)(slab + (size_t)t * 8); LAS float* d = buf + t * 8 + (t >> 6) * 8;
        *(LAS f32x4*)d = (f32x4){bflo(w.x), bfhi(w.x), bflo(w.y), bfhi(w.y)}; *(LAS f32x4*)(d + 4) = (f32x4){bflo(w.z), bfhi(w.z), bflo(w.w), bfhi(w.w)}; }
    __syncthreads();
    { const int c = tid >> 3, ch = tid & 7; float v[64];
#pragma unroll
      for (int r = 0; r < 64; ++r) v[r] = buf[r * 520 + c * 8 + ch];
      box64<W>(v, buf + c * 8 + ch, 520); }
    __syncthreads();
    { const int r = tid >> 3, ch = tid & 7; float v[64];
#pragma unroll
      for (int c = 0; c < 64; ++c) v[c] = buf[r * 520 + c * 8 + ch];
      box64<W>(v, buf + r * 520 + ch, 8); }
    __syncthreads();
#pragma unroll
    for (int i = 0; i < 8; ++i) { const int t = tid + i * 512; const u32x4 w = *(const u32x4*)(slab + (size_t)t * 8); const LAS float* d = buf + t * 8 + (t >> 6) * 8;
        const f32x4 p0 = *(const LAS f32x4*)d, p1 = *(const LAS f32x4*)(d + 4);
        const f32x4 s0 = (f32x4){bflo(w.x), bfhi(w.x), bflo(w.y), bfhi(w.y)}, s1 = (f32x4){bflo(w.z), bfhi(w.z), bflo(w.w), bfhi(w.w)};
        *(u32x4*)(slab + (size_t)t * 8) = pack8(p0 - s0, p1 - s1); }
    __syncthreads();
}
__device__ void phase_poolconv(const Params& p, LAS unsigned char* lds) {
    const int tid = TIDX, G = 256;
    bf16_t* aslab = (bf16_t*)(p.ws + S_R1); const bf16_t* glu = (const bf16_t*)(p.ws + S_R1 + 34 * MiB); bf16_t* ycat = (bf16_t*)(p.ws + S_R2);
    const int NPL = 512, NCV = 1088, NPC = 512;
    for (int it = blockIdx.x; it < NPL + NCV + NPC; it += G) {
        if (it < NPL) {
            const int b = it >> 6, sl = it & 63; const int R0 = (b >> 2) * HR + (b & 3) * SEQ;
            bf16_t* slab = aslab + ((size_t)sl * NR + R0) * 8; LAS float* buf = (LAS float*)lds;
            const int gi = sl >> 4;
            if (gi == 0) pool_lat_item<2>(slab, buf); else if (gi == 1) pool_lat_item<4>(slab, buf); else if (gi == 2) pool_lat_item<8>(slab, buf); else pool_lat_item<16>(slab, buf);
        } else if (it < NPL + NCV) {
            const int ci = it - NPL; int R0, len, t0;
            if (ci < 1024) { const int b = ci >> 7; R0 = (b >> 2) * HR + (b & 3) * SEQ; len = SEQ; t0 = (ci & 127) * 32; }
            else { const int cj = ci - 1024, b = cj >> 3; R0 = (b >> 2) * HR + HLAT + (b & 3) * CTXL; len = CTXL; t0 = (cj & 7) * 32; }
            LAS unsigned* gin = (LAS unsigned*)lds;
            LAS float* cout = (LAS float*)(lds + 62 * 1024);
            for (int i = tid; i < 62 * 64; i += 512) { const int rr = i >> 6, cc = i & 63, t = t0 - 15 + rr;
                u32x4 w = (u32x4){0u, 0u, 0u, 0u}; if (t >= 0 && t < len) w = *(const u32x4*)(glu + (size_t)(R0 + t) * 512 + cc * 8);
                *(LAS u32x4*)(gin + rr * 256 + cc * 4) = w; }
            __syncthreads();
            { const float* cw = p.in[12] + tid; float w[31];
#pragma unroll
              for (int j = 0; j < 31; ++j) w[j] = cw[j * 512];
              float a[32]; const float cb0 = p.in[13][tid];
#pragma unroll
              for (int t = 0; t < 32; ++t) a[t] = cb0;
              const LAS unsigned short* gs = (const LAS unsigned short*)gin + tid;
#pragma unroll
              for (int rr = 0; rr < 62; ++rr) { const float x = bf2f(gs[rr * 512]);
#pragma unroll
                  for (int t = 0; t < 32; ++t) { const int j = rr - t; if (j >= 0 && j < 31) a[t] += w[j] * x; } }
#pragma unroll
              for (int t = 0; t < 32; ++t) cout[t * 512 + tid] = a[t]; }
            __syncthreads();
            { const int wv = tid >> 6, lane = tid & 63;
              for (int tt = 0; tt < 4; ++tt) { const int t = wv * 4 + tt; const LAS float* rp = cout + t * 512 + lane * 8;
                  const f32x4 v0 = *(const LAS f32x4*)rp, v1 = *(const LAS f32x4*)(rp + 4);
                  float s = (v0[0] + v0[1]) + (v0[2] + v0[3]) + (v1[0] + v1[1]) + (v1[2] + v1[3]);
                  const float mu = wave_sum(s) * (1.0f / 512.0f); const f32x4 d0 = v0 - mu, d1 = v1 - mu;
                  float q = d0[0] * d0[0] + d0[1] * d0[1] + d0[2] * d0[2] + d0[3] * d0[3] + d1[0] * d1[0] + d1[1] * d1[1] + d1[2] * d1[2] + d1[3] * d1[3];
                  const float rstd = rsqrtf(wave_sum(q) * (1.0f / 512.0f) + LNEPS);
                  const float* ng = p.in[14] + lane * 8; const float* nb = p.in[15] + lane * 8; f32x4 y0, y1;
#pragma unroll
                  for (int j = 0; j < 4; ++j) { y0[j] = siluf_(d0[j] * rstd * ng[j] + nb[j]); y1[j] = siluf_(d1[j] * rstd * ng[4 + j] + nb[4 + j]); }
                  *(u32x4*)(ycat + (size_t)(R0 + t0 + t) * 1024 + 512 + lane * 8) = pack8(y0, y1); } }
            __syncthreads();
        } else {
            const int pi = it - NPL - NCV, b = pi >> 6, sl = pi & 63; const int R0 = (b >> 2) * HR + HLAT + (b & 3) * CTXL; const int W = 2 << (sl >> 4);
            bf16_t* slab = aslab + ((size_t)sl * NR + R0) * 8; LAS float* buf = (LAS float*)lds;
            if (tid < 256) { const u32x4 w = *(const u32x4*)(slab + (size_t)tid * 8);
                *(LAS f32x4*)(buf + tid * 8) = (f32x4){bflo(w.x), bfhi(w.x), bflo(w.y), bfhi(w.y)}; *(LAS f32x4*)(buf + tid * 8 + 4) = (f32x4){bflo(w.z), bfhi(w.z), bflo(w.w), bfhi(w.w)}; }
            __syncthreads();
            f32x4 d = (f32x4){0.f, 0.f, 0.f, 0.f}; const int t = tid >> 1, hc = (tid & 1) * 4;
            { const int lo = t - W / 2 < 0 ? 0 : t - W / 2, hi = t + W - W / 2 > 256 ? 256 : t + W - W / 2; f32x4 s = (f32x4){0.f, 0.f, 0.f, 0.f};
              for (int j = lo; j < hi; ++j) s += *(const LAS f32x4*)(buf + j * 8 + hc);
              d = s * (1.0f / (float)(hi - lo)) - *(const LAS f32x4*)(buf + t * 8 + hc); }
            u32x2 o; o.x = cvt_pk_bf16(d[0], d[1]); o.y = cvt_pk_bf16(d[2], d[3]);
            *(u32x2*)(slab + (size_t)t * 8 + hc) = o;
            __syncthreads();
        }
    }
}

__device__ void phase_mlconv(const Params& p, int hf) {
    const int tid_ = TIDX; const int wave = (blockIdx.x * 512 + tid_) >> 6, lane = tid_ & 63, nw = 2048, tk = lane & 15, g = lane >> 4;
    const bf16_t* xm = (const bf16_t*)(p.ws + S_R1); bf16_t* xc = (bf16_t*)(p.ws + S_R2); float* gates = (float*)(p.ws + S_GATES);
    const bf16_t* aqk = (const bf16_t*)(p.out + W_AQK); const bf16_t* av = (const bf16_t*)(p.out + W_AV);
    const float* cw = p.in[18]; const float* cb = p.in[19];
    for (int it = wave; it < HR / 16; it += nw) {
        const int r = it * 16 + tk; const int pos = r < HLAT ? (r & 4095) : ((r - HLAT) & 255), len = r < HLAT ? SEQ : CTXL;
        const bool hasp = pos > 0, hasn = pos < len - 1;
        f32x4 acc = (f32x4){0.f, 0.f, 0.f, 0.f};
        for (int ks = 0; ks < 64; ++ks) { const int c0 = ks * 32 + g * 8;
            const u32x4 z4 = (u32x4){0u, 0u, 0u, 0u};
            const u32x4 wc_ = *(const u32x4*)(xm + (size_t)r * 2048 + c0);
            const u32x4 wp = hasp ? *(const u32x4*)(xm + (size_t)(r - 1) * 2048 + c0) : z4;
            const u32x4 wn = hasn ? *(const u32x4*)(xm + (size_t)(r + 1) * 2048 + c0) : z4;
            float o[8];
#pragma unroll
            for (int j = 0; j < 4; ++j) { const unsigned a = wp[j], b = wc_[j], c = wn[j]; const int cc = c0 + 2 * j;
                o[2 * j] = siluf_(cw[cc] * bflo(a) + cw[2048 + cc] * bflo(b) + cw[4096 + cc] * bflo(c) + cb[cc]);
                o[2 * j + 1] = siluf_(cw[cc + 1] * bfhi(a) + cw[2048 + cc + 1] * bfhi(b) + cw[4096 + cc + 1] * bfhi(c) + cb[cc + 1]); }
            u32x4 xo; xo.x = cvt_pk_bf16(o[0], o[1]); xo.y = cvt_pk_bf16(o[2], o[3]); xo.z = cvt_pk_bf16(o[4], o[5]); xo.w = cvt_pk_bf16(o[6], o[7]);
            *(u32x4*)(xc + (size_t)r * 2048 + c0) = xo;
            const bf16x8 bq = *(const bf16x8*)(aqk + (size_t)tk * 2048 + c0), bv = *(const bf16x8*)(av + (size_t)tk * 2048 + c0);
            acc = __builtin_amdgcn_mfma_f32_16x16x32_bf16(__builtin_bit_cast(bf16x8, xo), bq, acc, 0, 0, 0);
            acc = __builtin_amdgcn_mfma_f32_16x16x32_bf16(__builtin_bit_cast(bf16x8, wc_), bv, acc, 0, 0, 0); }
        const float bg = p.in[24][tk];
#pragma unroll
        for (int i = 0; i < 4; ++i) { float v = acc[i] + bg; if ((tk & 7) >= 4) v = fminf(v, 0.f) - log1pf(__expf(-fabsf(v)));
            gates[((size_t)hf * HR + it * 16 + 4 * g + i) * 16 + tk] = v; }
    }
}

__device__ void phase_mlout(const Params& p) {
    const int tid_ = TIDX; const int wave = (blockIdx.x * 512 + tid_) >> 6, lane = tid_ & 63, nw = 2048;
    const bf16_t* hfw = (const bf16_t*)(p.ws + S_R1); const bf16_t* hbw = (const bf16_t*)(p.ws + S_R6); bf16_t* xc = (bf16_t*)(p.ws + S_R2); const bf16_t* z = (const bf16_t*)(p.ws + S_R3);
    const float* ng = p.in[25]; const float* sk = p.in[26];
    for (int r = wave; r < HLAT; r += nw) {
#pragma unroll
        for (int hh = 0; hh < 4; ++hh) { const int c = hh * 512 + lane * 8; const size_t o = (size_t)r * 2048 + c;
            const u32x4 a = *(const u32x4*)(hfw + o), b = *(const u32x4*)(hbw + o), xw = *(const u32x4*)(xc + o), zw = *(const u32x4*)(z + o);
            float x[8]; float s = 0.f;
#pragma unroll
            for (int j = 0; j < 4; ++j) { x[2 * j] = bflo(a[j]) + bflo(b[j]); x[2 * j + 1] = bfhi(a[j]) + bfhi(b[j]); s += x[2 * j] + x[2 * j + 1]; }
            const float mu = wave_sum(s) * (1.0f / 512.0f); float q = 0.f;
#pragma unroll
            for (int j = 0; j < 8; ++j) { x[j] -= mu; q += x[j] * x[j]; }
            const float rstd = rsqrtf(wave_sum(q) * (1.0f / 512.0f) + LNEPS);
            float y[8];
#pragma unroll
            for (int j = 0; j < 4; ++j) {
                y[2 * j] = (x[2 * j] * rstd * ng[c + 2 * j] + sk[c + 2 * j] * bflo(xw[j])) * siluf_(bflo(zw[j]));
                y[2 * j + 1] = (x[2 * j + 1] * rstd * ng[c + 2 * j + 1] + sk[c + 2 * j + 1] * bfhi(xw[j])) * siluf_(bfhi(zw[j])); }
            u32x4 w; w.x = cvt_pk_bf16(y[0], y[1]); w.y = cvt_pk_bf16(y[2], y[3]); w.z = cvt_pk_bf16(y[4], y[5]); w.w = cvt_pk_bf16(y[6], y[7]);
            *(u32x4*)(xc + o) = w; }
    }
}

constexpr int QS_STRIDE = 1040, KT_STRIDE = 144, PS_STRIDE = 144;
constexpr int L_QS = 0, L_KT = 64 * QS_STRIDE  , L_PS = L_KT + 512 * KT_STRIDE  , L_VEC = L_PS + 64 * PS_STRIDE  ;
__device__ void phase_scan(const Params& p, int hf, LAS unsigned char* lds) {
    if (blockIdx.x >= 128) return;
    const int tid0 = TIDX, wid = tid0 >> 6;
    const int wg = blockIdx.x, vs = wg & 3, dir = (wg >> 2) & 1, h = (wg >> 3) & 3, bl = wg >> 5;
    const bf16_t* qc = (const bf16_t*)(p.ws + S_R3); const bf16_t* kc = (const bf16_t*)(p.ws + S_R4); const bf16_t* vtc = (const bf16_t*)(p.ws + S_R5);
    bf16_t* hout = (bf16_t*)(p.ws + (dir ? S_R6 : S_R1));
    const float* gates = (const float*)(p.ws + S_GATES) + (size_t)hf * HR * 16;
    LAS float* vec = (LAS float*)(lds + L_VEC);
    LAS float* a_p = vec, *M_p = vec + 64, *e_p = vec + 128, *iw_p = vec + 192, *fl_p = vec + 256, *rs = vec + 320, *qn = vec + 384, *nst = vec + 448;
    f32x4 C[32];
#pragma unroll
    for (int i = 0; i < 32; ++i) C[i] = (f32x4){0.f, 0.f, 0.f, 0.f};
    nst[tid0] = 0.f;
    float mstate = 0.f;
    const int dvw = vs * 128 + wid * 16;
    __syncthreads();
    for (int step = 0; step < 68; ++step) {
        int tid = tid0; asm volatile("" : "+v"(tid));
        const int lane = tid & 63, tk = lane & 15, g = lane >> 4;
        const bool isctx = step < 4; const int ci = isctx ? step : step - 4, nchunk = isctx ? 4 : 64;
        const int cn = dir ? nchunk - 1 - ci : ci;
        const int chunk = isctx ? 256 + bl * 4 + cn : bl * 64 + cn;
        const int rowbase = isctx ? HLAT + bl * CTXL + cn * 64 : bl * SEQ + cn * 64;
        const int pp = dir ? 63 - lane : lane;
        const float ic = gates[(size_t)(rowbase + pp) * 16 + dir * 8 + h], fc = gates[(size_t)(rowbase + pp) * 16 + dir * 8 + 4 + h];
        float bcs = fc;
#pragma unroll
        for (int o = 1; o < 64; o <<= 1) { const float t = __shfl_up(bcs, o); if (lane >= o) bcs += t; }
        const float blast = __shfl(bcs, 63);
        const float wend = blast - bcs + ic;
        const float mnew = fmaxf(blast + mstate, wave_max(wend));
        const float decay = __expf(blast + mstate - mnew);
        const float ev = __expf(wend - mnew);
        const float av = ic - bcs; float cm = av;
#pragma unroll
        for (int o = 1; o < 64; o <<= 1) { const float t = __shfl_up(cm, o); if (lane >= o) cm = fmaxf(cm, t); }
        const float Mx = fmaxf(mstate, cm);
        if (wid == 0) { a_p[pp] = av; M_p[pp] = Mx; e_p[pp] = ev; iw_p[pp] = __expf(mstate - Mx); fl_p[pp] = __expf(-(bcs + Mx)); rs[lane] = 0.f; }
        const bf16_t* qg = qc + ((size_t)chunk * 4 + h) * 64 * 512; const bf16_t* kg = kc + ((size_t)chunk * 4 + h) * 64 * 512;
        if (!isctx) {
#pragma unroll
            for (int i = 0; i < 8; ++i) { const int e = tid + i * 512, t = e >> 6, cc = e & 63;
                *(LAS u32x4*)(lds + L_QS + t * QS_STRIDE + cc * 16) = *(const u32x4*)(qg + (size_t)t * 512 + cc * 8); }
        }
        {
#pragma unroll
          for (int i = 0; i < 4; ++i) { const int sp = tid & 31, dg = (tid >> 5) + i * 16;
              const u32x4 r0 = *(const u32x4*)(kg + (size_t)(2 * sp) * 512 + dg * 8), r1 = *(const u32x4*)(kg + (size_t)(2 * sp + 1) * 512 + dg * 8);
#pragma unroll
              for (int j = 0; j < 4; ++j) { const unsigned lo = (r0[j] & 0xffffu) | (r1[j] << 16), hi = (r0[j] >> 16) | (r1[j] & 0xffff0000u);
                  *(LAS unsigned*)(lds + L_KT + (dg * 8 + 2 * j) * KT_STRIDE + sp * 4) = lo; *(LAS unsigned*)(lds + L_KT + (dg * 8 + 2 * j + 1) * KT_STRIDE + sp * 4) = hi; } } }
        const bf16_t* vg = vtc + (((size_t)chunk * 4 + h) * 512 + dvw + tk) * 64;
        const u32x4 v0 = *(const u32x4*)(vg + g * 8), v1 = *(const u32x4*)(vg + 32 + g * 8);
        __syncthreads();
        f32x4 O[4];
        if (!isctx) {
            { const int st = wid >> 1, tt0 = 2 * (wid & 1); f32x4 S0 = (f32x4){0.f, 0.f, 0.f, 0.f}, S1 = S0;
              const bf16_t* ka = kg + (size_t)(st * 16 + tk) * 512 + g * 8;
#pragma unroll 4
              for (int kk = 0; kk < 16; ++kk) { const bf16x8 a = *(const bf16x8*)(ka + kk * 32);
                  const bf16x8 b0 = *(const LAS bf16x8*)(lds + L_QS + (tt0 * 16 + tk) * QS_STRIDE + (kk * 32 + g * 8) * 2);
                  const bf16x8 b1 = *(const LAS bf16x8*)(lds + L_QS + ((tt0 + 1) * 16 + tk) * QS_STRIDE + (kk * 32 + g * 8) * 2);
                  S0 = __builtin_amdgcn_mfma_f32_16x16x32_bf16(a, b0, S0, 0, 0, 0); S1 = __builtin_amdgcn_mfma_f32_16x16x32_bf16(a, b1, S1, 0, 0, 0); }
#pragma unroll
              for (int x = 0; x < 2; ++x) { const int t = (tt0 + x) * 16 + tk; const float Mt = M_p[t]; const f32x4 Sv = x ? S1 : S0; float pv[4]; float psum = 0.f;
#pragma unroll
                  for (int i = 0; i < 4; ++i) { const int s = st * 16 + 4 * g + i; const bool ok = dir ? (s >= t) : (s <= t);
                      const float d = ok ? __expf(a_p[s] - Mt) : 0.f; const unsigned pk = cvt_pk_bf16(Sv[i] * d, 0.f); pv[i] = bflo(pk); psum += pv[i]; }
                  u32x2 w; w.x = cvt_pk_bf16(pv[0], pv[1]); w.y = cvt_pk_bf16(pv[2], pv[3]);
                  *(LAS u32x2*)(lds + L_PS + t * PS_STRIDE + (st * 16 + 4 * g) * 2) = w;
                  psum += __shfl_xor(psum, 16); psum += __shfl_xor(psum, 32);
                  if (g == 0) __hip_atomic_fetch_add(rs + t, psum, __ATOMIC_RELAXED, __HIP_MEMORY_SCOPE_WORKGROUP); } }
            { const int t = tid >> 3, part = tid & 7; float s = 0.f;
#pragma unroll
              for (int i = 0; i < 8; ++i) { const u32x4 w = *(const LAS u32x4*)(lds + L_QS + t * QS_STRIDE + (part * 64 + i * 8) * 2); const LAS float* np = nst + part * 64 + i * 8;
                  s += bflo(w.x) * np[0] + bfhi(w.x) * np[1] + bflo(w.y) * np[2] + bfhi(w.y) * np[3] + bflo(w.z) * np[4] + bfhi(w.z) * np[5] + bflo(w.w) * np[6] + bfhi(w.w) * np[7]; }
              s += __shfl_xor(s, 1); s += __shfl_xor(s, 2); s += __shfl_xor(s, 4);
              if (part == 0) qn[t] = s; }
#pragma unroll
            for (int mt = 0; mt < 4; ++mt) O[mt] = (f32x4){0.f, 0.f, 0.f, 0.f};
#pragma unroll
            for (int kk = 0; kk < 16; ++kk) { u32x4 bw; bw.x = cvt_pk_bf16(C[2 * kk][0], C[2 * kk][1]); bw.y = cvt_pk_bf16(C[2 * kk][2], C[2 * kk][3]); bw.z = cvt_pk_bf16(C[2 * kk + 1][0], C[2 * kk + 1][1]); bw.w = cvt_pk_bf16(C[2 * kk + 1][2], C[2 * kk + 1][3]);
                const bf16x8 b = __builtin_bit_cast(bf16x8, bw);
#pragma unroll
                for (int mt = 0; mt < 4; ++mt) { const LAS unsigned char* qp = lds + L_QS + (mt * 16 + tk) * QS_STRIDE + (kk * 32 + 4 * g) * 2;
                    const u32x2 lo = *(const LAS u32x2*)qp, hi = *(const LAS u32x2*)(qp + 32); u32x4 aw; aw.x = lo.x; aw.y = lo.y; aw.z = hi.x; aw.w = hi.y;
                    O[mt] = __builtin_amdgcn_mfma_f32_16x16x32_bf16(__builtin_bit_cast(bf16x8, aw), b, O[mt], 0, 0, 0); }
                __builtin_amdgcn_sched_barrier(0); }
        }
        __syncthreads();
        if (!isctx) {
            const bf16x8 vb0 = __builtin_bit_cast(bf16x8, v0), vb1 = __builtin_bit_cast(bf16x8, v1);
#pragma unroll
            for (int mt = 0; mt < 4; ++mt) {
#pragma unroll
                for (int i = 0; i < 4; ++i) O[mt][i] *= iw_p[mt * 16 + 4 * g + i];
                const bf16x8 pa0 = *(const LAS bf16x8*)(lds + L_PS + (mt * 16 + tk) * PS_STRIDE + (g * 8) * 2), pa1 = *(const LAS bf16x8*)(lds + L_PS + (mt * 16 + tk) * PS_STRIDE + (32 + g * 8) * 2);
                O[mt] = __builtin_amdgcn_mfma_f32_16x16x32_bf16(pa0, vb0, O[mt], 0, 0, 0);
                O[mt] = __builtin_amdgcn_mfma_f32_16x16x32_bf16(pa1, vb1, O[mt], 0, 0, 0);
#pragma unroll
                for (int i = 0; i < 4; ++i) { const int t = mt * 16 + 4 * g + i; const float den = iw_p[t] * qn[t] + rs[t];
                    const float hv = O[mt][i] / fmaxf(fabsf(den), fl_p[t]);
                    hout[(size_t)(rowbase + t) * 2048 + h * 512 + dvw + tk] = (bf16_t)(cvt_pk_bf16(hv, 0.f) & 0xffffu); } }
        }
        { u32x4 w0, w1;
#pragma unroll
          for (int j = 0; j < 4; ++j) { const int t = g * 8 + 2 * j; w0[j] = cvt_pk_bf16(bflo(v0[j]) * e_p[t], bfhi(v0[j]) * e_p[t + 1]); w1[j] = cvt_pk_bf16(bflo(v1[j]) * e_p[32 + t], bfhi(v1[j]) * e_p[32 + t + 1]); }
          const bf16x8 ve0 = __builtin_bit_cast(bf16x8, w0), ve1 = __builtin_bit_cast(bf16x8, w1);
#pragma unroll
          for (int i = 0; i < 32; ++i) { const LAS unsigned char* kp = lds + L_KT + (i * 16 + tk) * KT_STRIDE + g * 16;
              const bf16x8 a0 = *(const LAS bf16x8*)kp, a1 = *(const LAS bf16x8*)(kp + 64);
              C[i] = C[i] * decay;
              C[i] = __builtin_amdgcn_mfma_f32_16x16x32_bf16(a0, ve0, C[i], 0, 0, 0);
              C[i] = __builtin_amdgcn_mfma_f32_16x16x32_bf16(a1, ve1, C[i], 0, 0, 0);
              if (i & 1) __builtin_amdgcn_sched_barrier(0); } }
        { float s = 0.f; const LAS unsigned char* kp = lds + L_KT + tid * KT_STRIDE;
#pragma unroll
          for (int i = 0; i < 8; ++i) { const u32x4 w = *(const LAS u32x4*)(kp + i * 16); const LAS float* ep = e_p + i * 8;
              s += bflo(w.x) * ep[0] + bfhi(w.x) * ep[1] + bflo(w.y) * ep[2] + bfhi(w.y) * ep[3] + bflo(w.z) * ep[4] + bfhi(w.z) * ep[5] + bflo(w.w) * ep[6] + bfhi(w.w) * ep[7]; }
          nst[tid] = decay * nst[tid] + s; }
        mstate = mnew;
        __syncthreads();
    }
}

DI Sch mk_sch(int nM, int nN, int nsub, const void* A0, const void* B0, size_t a_tile, size_t b_tile, size_t a_sub, size_t b_sub, int a_mod = 0, int b_mod = 0) {
    Sch s; s.nM = nM; s.nN = nN; s.nsub = nsub; s.G = 256; s.c = blockIdx.x; s.A0 = (const char*)A0; s.B0 = (const char*)B0;
    s.a_tile = a_tile; s.b_tile = b_tile; s.a_sub = a_sub; s.b_sub = b_sub; s.a_mod = a_mod; s.b_mod = b_mod; return s;
}

__global__ void __launch_bounds__(512, 2) mega(Params p, int ph_lo, int ph_hi) {
    extern __shared__ __attribute__((aligned(16))) unsigned char smem[];
    LAS unsigned char* lds = (LAS unsigned char*)smem;
    cg::grid_group grid = cg::this_grid();
    const int nskip = __builtin_amdgcn_readfirstlane(ph_lo + (ph_lo < 1 ? 1 : 0) + 1);
    for (int ph = ph_lo; ph < ph_hi; ++ph) {
        if (ph > ph_lo) { if (ph == 1) grid.sync(); else { unsigned gen = (unsigned)__builtin_amdgcn_readfirstlane(ph - nskip); grid_bar((unsigned*)(p.ws + S_BAR), gen); } }
        const float* mods = (const float*)(p.out + W_MODS);
        _Float16* hb = (_Float16*)(p.out + O_HB);
        unsigned char* ub = p.ws + S_UB;
#ifndef ONLY
#define EN(x) 1
#else
#define EN(x) ((x) == ONLY)
#endif
        switch (ph) {
        case 0: if (EN(0)) phase_prep(p, lds); break;
        case 1: if (EN(1)) phase_embed(p); break;
        case 2: if (EN(2)) { GemmCfg g{2048, 16, 2048, 16, 16}; Sch S = mk_sch(136, 6, 1, ub, p.out + W_ABIN, 256 * 2048, 256 * 2048, 0, 0);
                  EpiAbIn E{(bf16_t*)(p.ws + S_R1), (bf16_t*)(p.ws + S_R1 + 34 * MiB)}; gemm_phase(lds, g, S, E); } break;
        case 3: if (EN(3)) phase_poolconv(p, lds); break;
        case 4: if (EN(2)) { GemmCfg g{16, (unsigned)NR * 16u, 1024, 16, 8}; Sch S = mk_sch(136, 2, 1, p.ws + S_R1, p.out + W_POOL, 256 * 16, 256 * 1024, 0, 0);
                  EpiPool E{(bf16_t*)(p.ws + S_R2), p.in[10], p.in[11]}; gemm_phase(lds, g, S, E); } break;
        case 5: if (EN(2)) { GemmCfg g{2048, 16, 2048, 16, 16}; Sch S = mk_sch(136, 4, 1, p.ws + S_R2, p.out + W_ABOUT, 256 * 2048, 256 * 2048, 0, 0);
                  EpiRes E{hb, hb, mods + 2 * 1024, 0}; gemm_phase(lds, g, S, E); } break;
        case 6: if (EN(1)) phase_ln(p, hb, 0, 0, 0, 3, 0); break;
        case 7: if (EN(2)) { GemmCfg g{2048, 16, 2048, 16, 16}; Sch S = mk_sch(136, 22, 1, ub, p.out + W_FFNIN, 256 * 2048, 256 * 2048, 0, 0);
                  EpiFfnIn E{(bf16_t*)(p.ws + S_R3), 0}; gemm_phase(lds, g, S, E); } break;
        case 8: if (EN(2)) { GemmCfg g{FF * 2, 16, FF * 2, 16, 44}; Sch S = mk_sch(136, 4, 1, p.ws + S_R3, p.out + W_FFNOUT, (size_t)256 * FF * 2, (size_t)256 * FF * 2, 0, 0);
                  EpiRes E{hb, hb, mods + 5 * 1024, 0}; gemm_phase(lds, g, S, E); } break;
        case 9: if (EN(1)) phase_ln(p, hb, 0, 1, 1, 0, 0); break;
        case 10: case 17: if (EN(2)) { const int hf = ph >= 17; GemmCfg g{2048, 16, 2048, 16, 16};
                  Sch S = mk_sch(68, 8, 1, ub + (size_t)hf * HR * 2048, p.out + W_MLIN, 256 * 2048, 256 * 2048, 0, 0);
                  EpiPlain E{(bf16_t*)(p.ws + S_R1), 2048}; gemm_phase(lds, g, S, E); } break;
        case 11: case 18: if (EN(4)) phase_mlconv(p, ph >= 18); break;
        case 12: case 19: if (EN(2)) {
                  { GemmCfg g{4096, 16, 1024, 16, 8}; Sch S = mk_sch(68, 2, 8, p.ws + S_R2, p.out + W_Q, 256 * 4096, 256 * 1024, 1024, 524288, 4, 0);
                    EpiQK E{(bf16_t*)(p.ws + S_R3), (bf16_t*)(p.ws + S_R4)}; gemm_phase(lds, g, S, E); }
                  { GemmCfg g{1024, 16, 4096, 16, 8}; Sch S = mk_sch(2, 68, 4, p.out + W_V, p.ws + S_R1, 256 * 1024, 256 * 4096, 524288, 1024);
                    EpiVT E{(bf16_t*)(p.ws + S_R5)}; gemm_phase(lds, g, S, E); } } break;
        case 13: case 20: if (EN(5)) phase_scan(p, ph >= 20, lds); break;
        case 14: case 21: if (EN(2)) { const int hf = ph >= 21; GemmCfg g{2048, 16, 2048, 16, 16};
                  Sch S = mk_sch(64, 8, 1, ub + (size_t)hf * HR * 2048, p.out + W_MLIN + (size_t)2048 * 2048, 256 * 2048, 256 * 2048, 0, 0);
                  EpiPlain E{(bf16_t*)(p.ws + S_R3), 2048}; gemm_phase(lds, g, S, E); } break;
        case 15: case 22: if (EN(1)) phase_mlout(p); break;
        case 16: case 23: if (EN(2)) { const int hf = ph >= 23; GemmCfg g{4096, 16, 4096, 16, 32};
                  Sch S = mk_sch(64, 4, 1, p.ws + S_R2, p.out + W_MLOUT, 256 * 4096, 256 * 4096, 0, 0);
                  EpiRes E{hb + (size_t)hf * HR * 1024, hb + (size_t)hf * HR * 1024, mods + 9 * 6144 + 2 * 1024 - (size_t)0, 0};
                  E.gate = mods + 9 * 6144 + 2 * 1024 + (size_t)hf * 4 * 6144; gemm_phase(lds, g, S, E); } break;
        case 24: if (EN(1)) phase_ln(p, hb, 1, 0, 1, 3, 1); break;
        case 25: if (EN(2)) { GemmCfg g{2048, 16, 2048, 16, 16}; Sch S = mk_sch(64, 22, 2, ub, p.out + W_FFNIN + 11534336, 256 * 2048, 256 * 2048, (size_t)HR * 2048, 0);
                  EpiFfnIn E{(bf16_t*)(p.ws + S_R1), HR}; gemm_phase(lds, g, S, E); } break;
        case 26: if (EN(2)) { GemmCfg g{FF * 2, 16, FF * 2, 16, 44}; Sch S = mk_sch(64, 4, 2, p.ws + S_R1, p.out + W_FFNOUT + 5767168, (size_t)256 * FF * 2, (size_t)256 * FF * 2, (size_t)HR * FF * 2, 0);
                  EpiRes E{hb, (_Float16*)(p.ws + S_R5), mods + 9 * 6144 + 5 * 1024, HR}; gemm_phase(lds, g, S, E); } break;
        case 27: if (EN(1)) phase_ln(p, (const _Float16*)(p.ws + S_R5), 1, 1, -1, 0, 2); break;
        default: break;
        }
    }
}
constexpr int NPHASE = 28;

extern "C" void kernel_launch(void* const* d_in, const int* in_sizes, int n_in, void* d_out, int out_size, void* d_ws, size_t ws_size, hipStream_t stream) {
    static int grid = 0;
    if (grid == 0) {
        if (n_in != 30 || ws_size < WS_NEED) { fprintf(stderr, "kernel_launch: unexpected n_in %d or ws_size %zu (< %zu)\n", n_in, ws_size, (size_t)WS_NEED); grid = -1; return; }
        int dev = 0, cus = 0, per_cu = 0;
        hipGetDevice(&dev); hipDeviceGetAttribute(&cus, hipDeviceAttributeMultiprocessorCount, dev);
        if (hipFuncSetAttribute((const void*)mega, hipFuncAttributeMaxDynamicSharedMemorySize, LDS_BYTES) != hipSuccess) { fprintf(stderr, "hipFuncSetAttribute failed\n"); grid = -1; return; }
        hipOccupancyMaxActiveBlocksPerMultiprocessor(&per_cu, (const void*)mega, 512, LDS_BYTES);
        (void)hipGetLastError();
        grid = 256; if (cus != 256) fprintf(stderr, "kernel_launch: device reports %d CUs; this kernel is built for a 256-workgroup grid\n", cus);
        if (per_cu < 1) fprintf(stderr, "kernel_launch: occupancy query says %d blocks per CU\n", per_cu);
    }
    if (grid < 0) return;
    hipMemsetAsync((unsigned char*)d_ws + S_BAR, 0, 256, stream);
    Params p{};
    for (int i = 0; i < 30; ++i) p.in[i] = (const float*)d_in[i];
    p.out = (unsigned char*)d_out; p.ws = (unsigned char*)d_ws;
    int lo = 0, hi = NPHASE;
    void* args[] = {&p, &lo, &hi};
    hipError_t e = hipLaunchCooperativeKernel((const void*)mega, dim3(grid), dim3(512), args, LDS_BYTES, stream);
    if (e != hipSuccess) fprintf(stderr, "cooperative launch failed: %s (grid %d)\n", hipGetErrorString(e), grid);
}
```

```cpp
#include <hip/hip_runtime.h>
#include <hip/hip_cooperative_groups.h>
#include <cstdio>
namespace cg = cooperative_groups;

#define LAS __attribute__((address_space(3)))
#define DI __device__ __forceinline__
typedef unsigned short bf16_t;
typedef short bf16x8 __attribute__((ext_vector_type(8)));
typedef float f32x4 __attribute__((ext_vector_type(4)));
typedef unsigned u32x4 __attribute__((ext_vector_type(4)));
typedef unsigned u32x2 __attribute__((ext_vector_type(2)));
typedef _Float16 f16x8 __attribute__((ext_vector_type(8)));
typedef __bf16 bf16x2 __attribute__((ext_vector_type(2)));

constexpr int DM = 1024, NB = 8, SEQ = 4096, CTXL = 256, NR = 34816, HR = 17408, HLAT = 16384;
constexpr int FF = 2816, EIN = 2048, DH = 512;
constexpr float ALPHA = 1.41421356237f, LNEPS = 1e-5f, KSCALE = 0.04419417382f;
constexpr size_t MiB = 1048576;
constexpr size_t O_HB = 0, O_W = 68 * MiB;
constexpr size_t W_ABIN = O_W, W_POOL = W_ABIN + 3145728, W_ABOUT = W_POOL + 524288, W_FFNIN = W_ABOUT + 2097152  ,
                 W_FFNOUT = W_FFNIN + 2 * 11534336  , W_MLIN = W_FFNOUT + 2 * 5767168, W_Q = W_MLIN + 8388608, W_K = W_Q + 2097152,
                 W_V = W_K + 2097152, W_MLOUT = W_V + 2097152, W_AQK = W_MLOUT + 4194304, W_AV = W_AQK + 65536, W_MODS = W_AV + 65536,
                 W_END = W_MODS + 442368;
static_assert(W_END <= 128 * MiB, "weights region");
constexpr size_t RS = 68 * MiB;
constexpr size_t S_UB = 0, S_R1 = RS, S_R2 = 2 * RS, S_R3 = 3 * RS, S_R4 = 4 * RS, S_R5 = 5 * RS, S_R6 = 6 * RS, S_MISC = 7 * RS;
constexpr size_t S_GATES = S_MISC, S_BAR = S_MISC + 4 * MiB, S_RS = S_MISC + 5 * MiB, S_PRE = S_MISC + 8 * MiB, S_CPA = S_MISC + 12 * MiB, S_CPB = S_MISC + 20 * MiB;
static_assert(S_CPB + 8 * MiB <= 512 * MiB, "workspace");
constexpr int PRE_V = 32 * 68 * 256;
constexpr size_t WS_NEED = S_PRE + (size_t)(PRE_V + 32 * 68 * 2) * 4;
static_assert(WS_NEED <= 512 * MiB, "workspace");

constexpr int LDS_BYTES = 160 * 1024;

struct Params {
    const float* in[30];
    unsigned char* out;
    unsigned char* ws;
};

DI unsigned cvt_pk_bf16(float lo, float hi) { unsigned r; asm("v_cvt_pk_bf16_f32 %0, %1, %2\n\ts_nop 1" : "=v"(r) : "v"(lo), "v"(hi)); return r; }
DI int opaque_tid() { int t = threadIdx.x; asm volatile("" : "+v"(t)); return t; }
#define TIDX opaque_tid()
DI unsigned cvt_pk_bf16_mfma(float lo, float hi) { unsigned r; asm volatile("s_nop 7\n\ts_nop 7\n\tv_cvt_pk_bf16_f32 %0, %1, %2\n\ts_nop 1" : "=v"(r) : "v"(lo), "v"(hi)); return r; }
DI float bf2f(unsigned short b) { return __uint_as_float(((unsigned)b) << 16); }
DI float dot2bf(unsigned a, unsigned b, float c) { return __builtin_amdgcn_fdot2_f32_bf16(__builtin_bit_cast(bf16x2, a), __builtin_bit_cast(bf16x2, b), c, false); }
DI float bflo(unsigned w) { return __uint_as_float(w << 16); }
DI float bfhi(unsigned w) { return __uint_as_float(w & 0xffff0000u); }
DI float sigmoidf_(float x) { return __builtin_amdgcn_rcpf(1.0f + __expf(-x)); }
DI float siluf_(float x) { return x * __builtin_amdgcn_rcpf(1.0f + __expf(-x)); }
#define DPPF(v_, ctrl_) __builtin_bit_cast(float, __builtin_amdgcn_update_dpp(0, __builtin_bit_cast(int, (v_)), (ctrl_), 0xF, 0xF, true))
DI float wave_sum(float v) {
    v += DPPF(v, 0xB1); v += DPPF(v, 0x4E); v += DPPF(v, 0x124); v += DPPF(v, 0x128);
    const int vi = __builtin_bit_cast(int, v);
    const float r0 = __builtin_bit_cast(float, __builtin_amdgcn_readlane(vi, 0)), r1 = __builtin_bit_cast(float, __builtin_amdgcn_readlane(vi, 16));
    const float r2 = __builtin_bit_cast(float, __builtin_amdgcn_readlane(vi, 32)), r3 = __builtin_bit_cast(float, __builtin_amdgcn_readlane(vi, 48));
    return (r0 + r1) + (r2 + r3);
}
DI float wave_max(float v) {
#pragma unroll
    for (int o = 32; o >= 1; o >>= 1) v = fmaxf(v, __shfl_xor(v, o));
    return v;
}
DI int row_bm(int R) { const int hf = R >= HR ? 1 : 0; const int r = R - hf * HR; return r < HLAT ? hf * 4 + (r >> 12) : 8; }
DI const float* row_src(const Params& p, int R) {
    const int hf = R >= HR ? 1 : 0; const int r = R - hf * HR;
    if (r < HLAT) return p.in[0] + ((size_t)(hf * 4 + (r >> 12)) * SEQ + (r & 4095)) * DM;
    const int rc = r - HLAT; return p.in[2] + ((size_t)(hf * 4 + (rc >> 8)) * CTXL + (rc & 255)) * DM;
}

DI void grid_bar(unsigned* ctr, unsigned& gen) {
    asm volatile("s_waitcnt vmcnt(0)" ::: "memory");
    __syncthreads();
    gen += 1;
    if (threadIdx.x == 0) {
        __builtin_amdgcn_fence(__ATOMIC_RELEASE, "agent");
        asm volatile("s_waitcnt vmcnt(0)" ::: "memory");
        unsigned* grp = ctr + 64 * (1 + (blockIdx.x & 7));
        const unsigned old = __hip_atomic_fetch_add(grp, 1u, __ATOMIC_RELAXED, __HIP_MEMORY_SCOPE_AGENT);
        if (old + 1u == gen * (gridDim.x >> 3)) __hip_atomic_fetch_add(ctr, 1u, __ATOMIC_RELAXED, __HIP_MEMORY_SCOPE_AGENT);
        const unsigned target = gen * 8u;
        while (__hip_atomic_load(ctr, __ATOMIC_RELAXED, __HIP_MEMORY_SCOPE_AGENT) < target) __builtin_amdgcn_s_sleep(2);
        __builtin_amdgcn_fence(__ATOMIC_ACQUIRE, "agent");
        asm volatile("s_waitcnt vmcnt(0)" ::: "memory");
    }
    __syncthreads();
}

constexpr int BM = 256, BK = 64, HALF = 128, HTB = HALF * BK * 2;
DI int lds_byte(int r, int c) { const int st = (r >> 4) * 2 + (c >> 5), rr = r & 15, cc = c & 31, ob = rr * 64 + cc * 2; return st * 1024 + (ob ^ (((ob >> 9) & 1) << 5)); }
DI void stage_rc(int b, int& R, int& C) { const int st = b / 1024, sb = b % 1024, swz = sb ^ (((sb >> 9) & 1) << 5); R = (st >> 1) * 16 + swz / 64; C = (st & 1) * 32 + (swz % 64) / 2; }
DI int perm32(int rho) { const int n = rho >> 4, i = rho & 15; return 8 * (i >> 2) + 4 * n + (i & 3); }

struct Unit { const char* a; const char* b; int pm, pn, sub; };
struct GemmCfg { unsigned a_rs, a_cs, b_rs, b_cs; int nt; };
struct Sch {
    int nM, nN, nsub, G, c;
    const char* A0; const char* B0;
    size_t a_tile, b_tile, a_sub, b_sub, a_sub2; int a_mod, b_mod;
    DI bool next(int i, Unit& u) const {
        const long L = (long)i * G + c; const int per = nM * nN, nwg = per * nsub; if (L >= nwg) return false;
        int wgid = (int)L; { const int q = nwg / 8, r = nwg % 8, xcd = wgid % 8, off = wgid / 8; wgid = (xcd < r ? xcd * (q + 1) : r * (q + 1) + (xcd - r) * q) + off; }
        const int sub = wgid / per; wgid -= sub * per;
        const int nig = 8 * nN, gid = wgid / nig, fm = gid * 8, gsz = (nM - fm) < 8 ? (nM - fm) : 8;
        u.pm = fm + ((wgid % nig) % gsz); u.pn = (wgid % nig) / gsz; u.sub = sub;
        u.a = A0 + (size_t)u.pm * a_tile + (size_t)(a_mod ? sub % a_mod : sub) * a_sub + (size_t)(a_mod ? sub / a_mod : 0) * a_sub2;
        u.b = B0 + (size_t)u.pn * b_tile + (size_t)(b_mod ? sub % b_mod : sub) * b_sub;
        return true;
    }
};

template <class Epi>
DI void gemm_phase(LAS unsigned char* lds, const GemmCfg g, const Sch& S, const Epi& E) {
    const int tid = TIDX, wid = __builtin_amdgcn_readfirstlane(tid >> 6), lane = tid & 63, wr = wid >> 2, wc = wid & 3, fr = lane & 15, fq = lane >> 4;
    const int nt = g.nt;
    unsigned voffA[2], voffB[2];
#pragma unroll
    for (int i = 0; i < 2; ++i) { int R, C; stage_rc(tid * 16 + i * 8192, R, C); const int Rb = (R & ~31) + perm32(R & 31);
        voffA[i] = (unsigned)R * g.a_rs + (unsigned)(C >> 3) * g.a_cs; voffB[i] = (unsigned)Rb * g.b_rs + (unsigned)(C >> 3) * g.b_cs; }
    const size_t kstepA = (size_t)8 * g.a_cs, kstepB = (size_t)8 * g.b_cs, hstepA = (size_t)HALF * g.a_rs, hstepB = (size_t)HALF * g.b_rs;
    const unsigned ldsw = (unsigned)wid * 1024u;
    const int aoff = lds_byte(wr * 64 + fr, fq * 8), boff = lds_byte(wc * 32 + fr, fq * 8);
#define G_SA(b, h) (((b) * 2 + (h)) * HTB)
#define G_SB(b, h) ((4 + (b) * 2 + (h)) * HTB)
#define G_STAGE(bufoff, gbase, voff) do { _Pragma("unroll") for (int _i = 0; _i < 2; ++_i) \
        __builtin_amdgcn_global_load_lds((const unsigned*)((const char*)(gbase) + (voff)[_i]), (LAS unsigned*)(lds + (bufoff) + ldsw + _i * 8192), 16, 0, 0); } while (0)
#define G_LDA(dst, b, h) do { _Pragma("unroll") for (int m = 0; m < 4; ++m) _Pragma("unroll") for (int k = 0; k < 2; ++k) dst[m][k] = *(const LAS bf16x8*)(lds + G_SA(b, h) + aoff + m * 2048 + k * 1024); } while (0)
#define G_LDB(dst, b, h) do { _Pragma("unroll") for (int n = 0; n < 2; ++n) _Pragma("unroll") for (int k = 0; k < 2; ++k) dst[n][k] = *(const LAS bf16x8*)(lds + G_SB(b, h) + boff + n * 2048 + k * 1024); } while (0)
#define G_MMA(ai, bj, At, Bt) do { __builtin_amdgcn_s_setprio(1); _Pragma("unroll") for (int m = 0; m < 4; ++m) _Pragma("unroll") for (int n = 0; n < 2; ++n) _Pragma("unroll") for (int k = 0; k < 2; ++k) \
        acc[ai][bj][m][n] = __builtin_amdgcn_mfma_f32_16x16x32_bf16(Bt[n][k], At[m][k], acc[ai][bj][m][n], 0, 0, 0); __builtin_amdgcn_s_setprio(0); } while (0)
#define G_WAIT_V(n) asm volatile("s_waitcnt vmcnt(" #n ")" ::: "memory")
#define G_WAIT_L(n) asm volatile("s_waitcnt lgkmcnt(" #n ")" ::: "memory")
#define G_BAR __builtin_amdgcn_s_barrier()
#define G_SCHED __builtin_amdgcn_sched_barrier(0)
    Unit cur, nxt; int ui = 0;
    if (!S.next(0, cur)) return;
    f32x4 acc[2][2][4][2];
#pragma unroll
    for (int a = 0; a < 2; ++a)
#pragma unroll
        for (int b = 0; b < 2; ++b)
#pragma unroll
            for (int m = 0; m < 4; ++m)
#pragma unroll
                for (int n = 0; n < 2; ++n) acc[a][b][m][n] = (f32x4){0.f, 0.f, 0.f, 0.f};
    bf16x8 At[4][2], B0[2][2], B1[2][2];
    const char* cA = cur.a; const char* cB = cur.b;
    G_STAGE(G_SB(0, 0), cB, voffB); G_STAGE(G_SA(0, 0), cA, voffA); G_STAGE(G_SB(0, 1), cB + hstepB, voffB); G_STAGE(G_SA(0, 1), cA + hstepA, voffA);
    if (wr == 1) G_BAR;
    G_WAIT_V(4); G_BAR;
    G_STAGE(G_SB(1, 0), cB + kstepB, voffB); G_STAGE(G_SA(1, 0), cA + kstepA, voffA); G_STAGE(G_SB(1, 1), cB + hstepB + kstepB, voffB);
    G_WAIT_V(6); G_BAR;
    for (;;) {
        const bool has_next = S.next(ui + 1, nxt);
        const char* nA = has_next ? nxt.a : cA; const char* nB = has_next ? nxt.b : cB;
        for (int t = 0; t < nt; t += 2) {
            const bool last = (t == nt - 2);
            const char* a1 = cA + (size_t)(t + 1) * kstepA;
            const char* a2 = last ? nA : cA + (size_t)(t + 2) * kstepA; const char* b2 = last ? nB : cB + (size_t)(t + 2) * kstepB;
            const char* a3 = a2 + kstepA; const char* b3 = b2 + kstepB;
            G_LDB(B0, 0, 0); G_SCHED; G_LDA(At, 0, 0); G_STAGE(G_SA(1, 1), a1 + hstepA, voffA);
            G_WAIT_L(8); G_BAR; G_WAIT_L(0); G_MMA(0, 0, At, B0); G_BAR; G_SCHED;
            G_LDB(B1, 0, 1); G_STAGE(G_SB(0, 0), b2, voffB);
            G_BAR; G_WAIT_L(0); G_MMA(0, 1, At, B1); G_BAR;
            G_LDA(At, 0, 1); G_STAGE(G_SA(0, 0), a2, voffA);
            G_BAR; G_WAIT_L(0); G_MMA(1, 0, At, B0); G_BAR; G_SCHED;
            G_STAGE(G_SB(0, 1), b2 + hstepB, voffB);
            G_WAIT_V(6); G_BAR; G_MMA(1, 1, At, B1); G_BAR;
            G_LDB(B0, 1, 0); G_SCHED; G_LDA(At, 1, 0); G_STAGE(G_SA(0, 1), a2 + hstepA, voffA);
            G_WAIT_L(8); G_BAR; G_WAIT_L(0); G_MMA(0, 0, At, B0); G_BAR; G_SCHED;
            G_LDB(B1, 1, 1); G_STAGE(G_SB(1, 0), b3, voffB);
            G_BAR; G_WAIT_L(0); G_MMA(0, 1, At, B1); G_BAR;
            G_LDA(At, 1, 1); G_STAGE(G_SA(1, 0), a3, voffA);
            G_BAR; G_WAIT_L(0); G_MMA(1, 0, At, B0); G_BAR; G_SCHED;
            G_STAGE(G_SB(1, 1), b3 + hstepB, voffB);
            G_WAIT_V(6); G_BAR; G_MMA(1, 1, At, B1); G_BAR;
        }
        E(acc, cur, wr, wc, fr, fq);
        if (!has_next) break;
#pragma unroll
        for (int a = 0; a < 2; ++a)
#pragma unroll
            for (int b = 0; b < 2; ++b)
#pragma unroll
                for (int m = 0; m < 4; ++m)
#pragma unroll
                    for (int n = 0; n < 2; ++n) acc[a][b][m][n] = (f32x4){0.f, 0.f, 0.f, 0.f};
        cur = nxt; cA = nA; cB = nB; ++ui;
    }
    G_WAIT_V(0);
    if (wr == 0) G_BAR;
    G_BAR;
#undef G_SA
#undef G_SB
#undef G_STAGE
#undef G_LDA
#undef G_LDB
#undef G_MMA
}

#define EPI_ARGS const f32x4 (&acc)[2][2][4][2], const Unit& u, int wr, int wc, int fr, int fq
DI u32x4 pack8(const f32x4 v0, const f32x4 v1) { u32x4 w; w.x = cvt_pk_bf16(v0[0], v0[1]); w.y = cvt_pk_bf16(v0[2], v0[3]); w.z = cvt_pk_bf16(v1[0], v1[1]); w.w = cvt_pk_bf16(v1[2], v1[3]); return w; }

struct EpiAbIn {
    bf16_t* aslab; bf16_t* glu;
    DI void operator()(EPI_ARGS) const {
        const int row0 = u.pm * BM + wr * 64 + fr;
#pragma unroll
        for (int ai = 0; ai < 2; ++ai)
#pragma unroll
            for (int m = 0; m < 4; ++m) { const int R = row0 + ai * HALF + m * 16;
                if (u.pn < 2) {
#pragma unroll
                    for (int bj = 0; bj < 2; ++bj) { const int col = u.pn * BM + bj * HALF + wc * 32 + 8 * fq;
                        *(u32x4*)(aslab + ((size_t)(col >> 3) * NR + R) * 8) = pack8(acc[ai][bj][m][0], acc[ai][bj][m][1]); }
                } else {
                    f32x4 g0, g1;
#pragma unroll
                    for (int j = 0; j < 4; ++j) { g0[j] = acc[ai][0][m][0][j] * sigmoidf_(acc[ai][1][m][0][j]); g1[j] = acc[ai][0][m][1][j] * sigmoidf_(acc[ai][1][m][1][j]); }
                    *(u32x4*)(glu + (size_t)R * 512 + (u.pn - 2) * 128 + wc * 32 + 8 * fq) = pack8(g0, g1);
                } }
    }
};
struct EpiPool {
    bf16_t* ycat; const float* pb; const float* ps;
    DI void operator()(EPI_ARGS) const {
        const int row0 = u.pm * BM + wr * 64 + fr;
#pragma unroll
        for (int bj = 0; bj < 2; ++bj) { const int col = u.pn * BM + bj * HALF + wc * 32 + 8 * fq;
            const f32x4 b0 = *(const f32x4*)(pb + col), b1 = *(const f32x4*)(pb + col + 4), s0 = *(const f32x4*)(ps + col), s1 = *(const f32x4*)(ps + col + 4);
#pragma unroll
            for (int ai = 0; ai < 2; ++ai)
#pragma unroll
                for (int m = 0; m < 4; ++m) { const int R = row0 + ai * HALF + m * 16;
                    *(u32x4*)(ycat + (size_t)R * 1024 + col) = pack8((acc[ai][bj][m][0] + b0) * s0, (acc[ai][bj][m][1] + b1) * s1); } }
    }
};
struct EpiRes {
    const _Float16* src; _Float16* dst; const float* gate; int row_sub; float* pa; float* pb;
    DI void operator()(EPI_ARGS) const {
        if (pa != nullptr) {
            float* pd = (u.sub & 1) ? pb : pa; const int prow = (u.sub >> 1) * 1024 + u.pm * BM + wr * 64 + fr;
#pragma unroll
            for (int bj = 0; bj < 2; ++bj) { const int col = u.pn * BM + bj * HALF + wc * 32 + 8 * fq;
                const f32x4 g0 = *(const f32x4*)(gate + col), g1 = *(const f32x4*)(gate + col + 4);
#pragma unroll
                for (int ai = 0; ai < 2; ++ai)
#pragma unroll
                    for (int m = 0; m < 4; ++m) { float* o = pd + (size_t)(prow + ai * HALF + m * 16) * 1024 + col;
                        *(f32x4*)o = acc[ai][bj][m][0] * g0; *(f32x4*)(o + 4) = acc[ai][bj][m][1] * g1; } }
            return; }
        const int row0 = u.sub * row_sub + u.pm * BM + wr * 64 + fr;
#pragma unroll
        for (int ai = 0; ai < 2; ++ai)
#pragma unroll
            for (int m = 0; m < 4; ++m) { const int R = row0 + ai * HALF + m * 16; const float* gp = gate + (size_t)row_bm(R) * 6144;
#pragma unroll
                for (int bj = 0; bj < 2; ++bj) { const int col = u.pn * BM + bj * HALF + wc * 32 + 8 * fq;
                    const f32x4 g0 = *(const f32x4*)(gp + col), g1 = *(const f32x4*)(gp + col + 4);
                    const f16x8 hv = *(const f16x8*)(src + (size_t)R * 1024 + col); f16x8 o;
#pragma unroll
                    for (int j = 0; j < 4; ++j) { o[j] = (_Float16)(ALPHA * (float)hv[j] + g0[j] * acc[ai][bj][m][0][j]); o[4 + j] = (_Float16)(ALPHA * (float)hv[4 + j] + g1[j] * acc[ai][bj][m][1][j]); }
                    *(f16x8*)(dst + (size_t)R * 1024 + col) = o; } }
    }
};
struct EpiFfnIn {
    bf16_t* hid; int row_sub;
    DI void operator()(EPI_ARGS) const {
        const int row0 = u.sub * row_sub + u.pm * BM + wr * 64 + fr;
#pragma unroll
        for (int ai = 0; ai < 2; ++ai)
#pragma unroll
            for (int m = 0; m < 4; ++m) { const int R = row0 + ai * HALF + m * 16; f32x4 g0, g1;
#pragma unroll
                for (int j = 0; j < 4; ++j) { g0[j] = siluf_(acc[ai][0][m][0][j]) * acc[ai][1][m][0][j]; g1[j] = siluf_(acc[ai][0][m][1][j]) * acc[ai][1][m][1][j]; }
                *(u32x4*)(hid + (size_t)R * FF + u.pn * 128 + wc * 32 + 8 * fq) = pack8(g0, g1); }
    }
};
struct EpiPlain {
    bf16_t* out; int ld;
    DI void operator()(EPI_ARGS) const {
        const int row0 = u.pm * BM + wr * 64 + fr;
#pragma unroll
        for (int ai = 0; ai < 2; ++ai)
#pragma unroll
            for (int m = 0; m < 4; ++m) { const int R = row0 + ai * HALF + m * 16;
#pragma unroll
                for (int bj = 0; bj < 2; ++bj) { const int col = u.pn * BM + bj * HALF + wc * 32 + 8 * fq;
                    *(u32x4*)(out + (size_t)R * ld + col) = pack8(acc[ai][bj][m][0], acc[ai][bj][m][1]); } }
    }
};
struct EpiQK {
    bf16_t* q; bf16_t* k;
    DI void operator()(EPI_ARGS) const {
        const int which = u.sub >> 2, h = u.sub & 3; bf16_t* dst = which ? k : q; const float sc = which ? KSCALE : 1.0f;
        const int row0 = u.pm * BM + wr * 64 + fr;
#pragma unroll
        for (int ai = 0; ai < 2; ++ai)
#pragma unroll
            for (int m = 0; m < 4; ++m) { const int r = row0 + ai * HALF + m * 16; bf16_t* rp = dst + (((size_t)(r >> 6) * 4 + h) * 64 + (r & 63)) * 512;
#pragma unroll
                for (int bj = 0; bj < 2; ++bj) { const int col = u.pn * BM + bj * HALF + wc * 32 + 8 * fq;
                    *(u32x4*)(rp + col) = pack8(acc[ai][bj][m][0] * sc, acc[ai][bj][m][1] * sc); } }
    }
};
struct EpiVT {
    bf16_t* vt;
    DI void operator()(EPI_ARGS) const {
        const int h = u.sub; const int row0 = u.pm * BM + wr * 64 + fr;
#pragma unroll
        for (int ai = 0; ai < 2; ++ai)
#pragma unroll
            for (int m = 0; m < 4; ++m) { const int dv = row0 + ai * HALF + m * 16;
#pragma unroll
                for (int bj = 0; bj < 2; ++bj) { const int r = u.pn * BM + bj * HALF + wc * 32 + 8 * fq;
                    *(u32x4*)(vt + (((size_t)(r >> 6) * 4 + h) * 512 + dv) * 64 + (r & 63)) = pack8(acc[ai][bj][m][0], acc[ai][bj][m][1]); } }
    }
};

struct TJob { const float* src; bf16_t* dst; int K, N, sld, dld, map, ntile; };
DI int srccol(int map, int n) {
    if (map == 1) { if (n < 512) return n; const int j = (n - 512) >> 8, w = (n - 512) & 255; return w < 128 ? 512 + 128 * j + w : 1024 + 128 * j + (w - 128); }
    if (map == 2) { const int j = n >> 8, w = n & 255; return w < 128 ? 128 * j + w : FF + 128 * j + (w - 128); }
    return n;
}
constexpr int NJOB = 24;
DI TJob get_job(const Params& p, int j) {
    TJob t; bf16_t* W = (bf16_t*)p.out; t.map = 0;
    if (j == 0) { t.src = p.in[8]; t.dst = (bf16_t*)(p.out + W_ABIN); t.K = 1024; t.N = 1536; t.sld = 1536; t.dld = 1024; t.map = 1; }
    else if (j == 1) { t.src = p.in[16]; t.dst = (bf16_t*)(p.out + W_ABOUT); t.K = 1024; t.N = 1024; t.sld = 1024; t.dld = 1024; }
    else if (j < 4) { const int l = j - 2; t.src = p.in[28] + (size_t)l * 1024 * 5632; t.dst = (bf16_t*)(p.out + W_FFNIN + (size_t)l * 11534336); t.K = 1024; t.N = 5632; t.sld = 5632; t.dld = 1024; t.map = 2; }
    else if (j < 6) { const int l = j - 4; t.src = p.in[29] + (size_t)l * FF * 1024; t.dst = (bf16_t*)(p.out + W_FFNOUT + (size_t)l * 5767168); t.K = FF; t.N = 1024; t.sld = 1024; t.dld = FF; }
    else if (j == 6) { t.src = p.in[17]; t.dst = (bf16_t*)(p.out + W_MLIN); t.K = 1024; t.N = 4096; t.sld = 4096; t.dld = 1024; }
    else if (j < 19) { const int w = (j - 7) >> 2, h = (j - 7) & 3; t.src = p.in[w == 0 ? 20 : (w == 1 ? 21 : 22)] + (size_t)h * 512 * 512; t.dst = (bf16_t*)(p.out + W_Q + (size_t)w * 2097152) + (size_t)h * 512 * 512; t.K = 512; t.N = 512; t.sld = 512; t.dld = 512; }
    else if (j == 19) { t.src = p.in[27]; t.dst = (bf16_t*)(p.out + W_MLOUT); t.K = 2048; t.N = 1024; t.sld = 1024; t.dld = 2048; }
    else { const int g = j - 20; t.src = p.in[9] + (size_t)g * 128 * 128; t.dst = (bf16_t*)(p.out + W_POOL) + (size_t)g * 128 * 512 + g * 128; t.K = 128; t.N = 128; t.sld = 128; t.dld = 512; }
    (void)W; t.ntile = (t.K / 64) * (t.N / 64); return t;
}
__device__ void phase_prep(const Params& p, LAS unsigned char* lds) {
    const int tid = TIDX, G = 256;
    LAS float* tile = (LAS float*)lds;
    int base = 0;
    for (int j = 0; j < NJOB; ++j) {
        const TJob t = get_job(p, j); const int nkt = t.K / 64;
        for (int ti = blockIdx.x - base; ti < t.ntile; ti += G) { if (ti < 0) continue;
            const int kt = ti % nkt, nt_ = ti / nkt, k0 = kt * 64, n0 = nt_ * 64, sc0 = srccol(t.map, n0);
            const int i = tid >> 6, jj = tid & 63;
#pragma unroll
            for (int rr = 0; rr < 8; ++rr) tile[(i * 8 + rr) * 65 + jj] = t.src[(size_t)(k0 + i * 8 + rr) * t.sld + sc0 + jj];
            __syncthreads();
#pragma unroll
            for (int rr = 0; rr < 8; ++rr) { const int n = i * 8 + rr; t.dst[(size_t)(n0 + n) * t.dld + k0 + jj] = (bf16_t)(cvt_pk_bf16(tile[jj * 65 + n], 0.f) & 0xffffu); }
            __syncthreads();
        }
        base += t.ntile; while (base >= G) base -= G;
    }
    { bf16_t* wp = (bf16_t*)(p.out + W_POOL);
      for (int i = blockIdx.x * 512 + tid; i < 512 * 512; i += G * 512) { const int n = i >> 9, k = i & 511; if ((n >> 7) != (k >> 7)) wp[i] = 0; } }
    { LAS float* sc = (LAS float*)lds;
      LAS float* red = (LAS float*)(lds + 9 * 1024 * 4);
      __syncthreads();
      for (int i = tid; i < 9 * 1024; i += 512) { const float v = i < 8192 ? p.in[1][i] : p.in[3][i - 8192]; sc[i] = siluf_(v); }
      __syncthreads();
      float* mods = (float*)(p.out + W_MODS);
      for (int job = blockIdx.x; job < 96; job += G) {
          const int l = job / 48, nb = job % 48, col = nb * 128 + (tid & 127), kq = tid >> 7;
          const float* w = p.in[4] + (size_t)l * 1024 * 6144 + col;
          float a[9];
#pragma unroll
          for (int b = 0; b < 9; ++b) a[b] = 0.f;
#pragma unroll 4
          for (int k = kq * 256; k < kq * 256 + 256; ++k) { const float wv = __builtin_nontemporal_load(w + (size_t)k * 6144);
#pragma unroll
              for (int b = 0; b < 9; ++b) a[b] += sc[b * 1024 + k] * wv; }
#pragma unroll
          for (int b = 0; b < 9; ++b) red[(kq * 9 + b) * 128 + (tid & 127)] = a[b];
          __syncthreads();
          for (int i = tid; i < 9 * 128; i += 512) { const int b = i >> 7, c = i & 127;
              mods[((size_t)l * 9 + b) * 6144 + nb * 128 + c] = red[(0 * 9 + b) * 128 + c] + red[(1 * 9 + b) * 128 + c] + red[(2 * 9 + b) * 128 + c] + red[(3 * 9 + b) * 128 + c] + p.in[5][(size_t)l * 6144 + nb * 128 + c]; }
          __syncthreads();
      } }
    { const int wave = (blockIdx.x * 512 + tid) >> 6, lane = tid & 63, nw = G * 8;
      bf16_t* aqk = (bf16_t*)(p.out + W_AQK); bf16_t* av = (bf16_t*)(p.out + W_AV);
      for (int job = wave; job < 4096; job += nw) {
          const int isv = job >> 11, hc = job & 2047, h = hc >> 9, c = hc & 511;
          float a[16];
#pragma unroll
          for (int g = 0; g < 16; ++g) a[g] = 0.f;
          const int npass = isv ? 1 : 2;
          for (int ps = 0; ps < npass; ++ps) {
              const int which = isv ? 2 : ps;
              const float* wrow = p.in[which == 0 ? 20 : (which == 1 ? 21 : 22)] + ((size_t)h * 512 + c) * 512 + lane * 8;
#pragma unroll
              for (int e = 0; e < 8; ++e) { const float wv = wrow[e]; const int ef = h * 512 + lane * 8 + e;
#pragma unroll
                  for (int z = 0; z < 2; ++z) { const float* gp = p.in[23] + (((size_t)z * 3 + which) * 2048 + ef) * 8;
#pragma unroll
                      for (int jx = 0; jx < 8; ++jx) a[z * 8 + jx] += wv * gp[jx]; } }
          }
#pragma unroll
          for (int g = 0; g < 16; ++g) { const float s = wave_sum(a[g]); if (lane == g) (isv ? av : aqk)[(size_t)g * 2048 + hc] = (bf16_t)(cvt_pk_bf16(s, 0.f) & 0xffffu); }
      } }
}

__device__ void phase_embed(const Params& p) {
    const int tid_ = TIDX; const int wave = (blockIdx.x * 512 + tid_) >> 6, lane = tid_ & 63, nw = 2048;
    const float* mods = (const float*)(p.out + W_MODS); _Float16* hb = (_Float16*)(p.out + O_HB); bf16_t* ub = (bf16_t*)(p.ws + S_UB);
    for (int R = wave; R < NR; R += nw) {
        const float* src = row_src(p, R); const float* mp = mods + (size_t)row_bm(R) * 6144;
#pragma unroll
        for (int i = 0; i < 2; ++i) { const int c = lane * 8 + i * 512;
            const f32x4 x0 = *(const f32x4*)(src + c), x1 = *(const f32x4*)(src + c + 4);
            const f32x4 sh0 = *(const f32x4*)(mp + c), sh1 = *(const f32x4*)(mp + c + 4), sc0 = *(const f32x4*)(mp + 1024 + c), sc1 = *(const f32x4*)(mp + 1024 + c + 4);
            f16x8 hv;
#pragma unroll
            for (int j = 0; j < 4; ++j) { hv[j] = (_Float16)x0[j]; hv[4 + j] = (_Float16)x1[j]; }
            *(f16x8*)(hb + (size_t)R * 1024 + c) = hv;
            *(u32x4*)(ub + (size_t)R * 1024 + c) = pack8(x0 * (sc0 + 1.0f) + sh0, x1 * (sc1 + 1.0f) + sh1); }
    }
}
__device__ void phase_ln(const Params& p, const _Float16* tsrc, int l, int which, int mod_l, int mod_idx, int mode, float probe_b = 0.f, const float* cpa = nullptr, const float* cpb = nullptr) {
    const int tid_ = TIDX; const int wave = (blockIdx.x * 512 + tid_) >> 6, lane = tid_ & 63, nw = 2048;
    const float* mods = (const float*)(p.out + W_MODS) + (size_t)(mod_l < 0 ? 0 : mod_l) * 9 * 6144; _Float16* hb = (_Float16*)(p.out + O_HB); bf16_t* ub = (bf16_t*)(p.ws + S_UB);
    const float* lg = p.in[6] + ((size_t)l * 2 + which) * 1024; const float* lb = p.in[7] + ((size_t)l * 2 + which) * 1024;
    f16x8 n0 = *(const f16x8*)(tsrc + (size_t)wave * 1024 + lane * 8), n1 = *(const f16x8*)(tsrc + (size_t)wave * 1024 + 512 + lane * 8);
    for (int R = wave; R < NR; R += nw) {
        const f16x8 t0 = n0, t1 = n1;
        if (R + nw < NR) { n0 = *(const f16x8*)(tsrc + (size_t)(R + nw) * 1024 + lane * 8); n1 = *(const f16x8*)(tsrc + (size_t)(R + nw) * 1024 + 512 + lane * 8); }
        const int hf = R >= HR ? 1 : 0, r = R - hf * HR; if (mode != 0 && r >= HLAT) continue;
        float x[16]; float s = 0.f;
#pragma unroll
        for (int j = 0; j < 8; ++j) { x[j] = (float)t0[j]; x[8 + j] = (float)t1[j]; }
        if (cpa != nullptr && r >= HLAT) {
            const size_t o = (size_t)(hf * 1024 + (r - HLAT)) * 1024 + lane * 8;
#pragma unroll
            for (int i = 0; i < 2; ++i) { const f32x4 a0 = *(const f32x4*)(cpa + o + i * 512), a1 = *(const f32x4*)(cpa + o + i * 512 + 4), b0 = *(const f32x4*)(cpb + o + i * 512), b1 = *(const f32x4*)(cpb + o + i * 512 + 4);
#pragma unroll
                for (int j = 0; j < 4; ++j) { x[i * 8 + j] = ALPHA * x[i * 8 + j] + (a0[j] + b0[j]); x[i * 8 + 4 + j] = ALPHA * x[i * 8 + 4 + j] + (a1[j] + b1[j]); } } }
#pragma unroll
        for (int j = 0; j < 16; ++j) s += x[j];
        const float mu = wave_sum(s) * (1.0f / 1024.0f); float q = 0.f;
#pragma unroll
        for (int j = 0; j < 16; ++j) { x[j] -= mu; q += x[j] * x[j]; }
        const float rstd = rsqrtf(wave_sum(q) * (1.0f / 1024.0f) + LNEPS);
        const float* mp = mods + (size_t)row_bm(R) * 6144;
#pragma unroll
        for (int i = 0; i < 2; ++i) { const int c = lane * 8 + i * 512;
            const f32x4 g0 = *(const f32x4*)(lg + c), g1 = *(const f32x4*)(lg + c + 4), b0 = *(const f32x4*)(lb + c), b1 = *(const f32x4*)(lb + c + 4);
            f32x4 h0, h1;
#pragma unroll
            for (int j = 0; j < 4; ++j) { h0[j] = x[i * 8 + j] * rstd * g0[j] + b0[j]; h1[j] = x[i * 8 + 4 + j] * rstd * g1[j] + b1[j]; }
            if (mode == 2) {
#ifdef PROBE
                if (hf == 1) { h0 += probe_b; h1 += probe_b; }
#endif
                float* o = (float*)p.out + ((size_t)(hf * 4 + (r >> 12)) * SEQ + (r & 4095)) * DM + c;
                *(f32x4*)o = h0; *(f32x4*)(o + 4) = h1;
            } else {
                f16x8 hv;
#pragma unroll
                for (int j = 0; j < 4; ++j) { hv[j] = (_Float16)h0[j]; hv[4 + j] = (_Float16)h1[j]; }
                *(f16x8*)(hb + (size_t)R * 1024 + c) = hv;
                const f32x4 sh0 = *(const f32x4*)(mp + mod_idx * 1024 + c), sh1 = *(const f32x4*)(mp + mod_idx * 1024 + c + 4);
                const f32x4 sc0 = *(const f32x4*)(mp + (mod_idx + 1) * 1024 + c), sc1 = *(const f32x4*)(mp + (mod_idx + 1) * 1024 + c + 4);
                *(u32x4*)(ub + (size_t)R * 1024 + c) = pack8(h0 * (sc0 + 1.0f) + sh0, h1 * (sc1 + 1.0f) + sh1);
            } }
    }
}

template <int W>
DI void box64(const float (&v)[64], LAS float* dst, int stride) {
#pragma unroll
    for (int t = 0; t < 64; ++t) { const int lo = t - W / 2 < 0 ? 0 : t - W / 2, hi = t + W - W / 2 > 64 ? 64 : t + W - W / 2; float s = 0.f;
#pragma unroll
        for (int j = lo; j < hi; ++j) s += v[j];
        dst[t * stride] = s * (1.0f / (float)(hi - lo)); }
}
template <int W>
DI void pool_lat_item(bf16_t* slab  , LAS float* buf) {
    const int tid = TIDX;
#pragma unroll
    for (int i = 0; i < 8; ++i) { const int t = tid + i * 512; const u32x4 w = *(const u32x4*)(slab + (size_t)t * 8); LAS float* d = buf + t * 8 + (t >> 6) * 8;
        *(LAS f32x4*)d = (f32x4){bflo(w.x), bfhi(w.x), bflo(w.y), bfhi(w.y)}; *(LAS f32x4*)(d + 4) = (f32x4){bflo(w.z), bfhi(w.z), bflo(w.w), bfhi(w.w)}; }
    __syncthreads();
    { const int c = tid >> 3, ch = tid & 7; float v[64];
#pragma unroll
      for (int r = 0; r < 64; ++r) v[r] = buf[r * 520 + c * 8 + ch];
      box64<W>(v, buf + c * 8 + ch, 520); }
    __syncthreads();
    { const int r = tid >> 3, ch = tid & 7; float v[64];
#pragma unroll
      for (int c = 0; c < 64; ++c) v[c] = buf[r * 520 + c * 8 + ch];
      box64<W>(v, buf + r * 520 + ch, 8); }
    __syncthreads();
#pragma unroll
    for (int i = 0; i < 8; ++i) { const int t = tid + i * 512; const u32x4 w = *(const u32x4*)(slab + (size_t)t * 8); const LAS float* d = buf + t * 8 + (t >> 6) * 8;
        const f32x4 p0 = *(const LAS f32x4*)d, p1 = *(const LAS f32x4*)(d + 4);
        const f32x4 s0 = (f32x4){bflo(w.x), bfhi(w.x), bflo(w.y), bfhi(w.y)}, s1 = (f32x4){bflo(w.z), bfhi(w.z), bflo(w.w), bfhi(w.w)};
        *(u32x4*)(slab + (size_t)t * 8) = pack8(p0 - s0, p1 - s1); }
    __syncthreads();
}
__device__ void phase_poolconv(const Params& p, LAS unsigned char* lds) {
    const int tid = TIDX, G = 256;
    bf16_t* aslab = (bf16_t*)(p.ws + S_R1); const bf16_t* glu = (const bf16_t*)(p.ws + S_R1 + 34 * MiB); bf16_t* ycat = (bf16_t*)(p.ws + S_R2);
    const int NPL = 512, NCV = 1088, NPC = 512;
    for (int it = blockIdx.x; it < NPL + NCV + NPC; it += G) {
        if (it < NPL) {
            const int b = it >> 6, sl = it & 63; const int R0 = (b >> 2) * HR + (b & 3) * SEQ;
            bf16_t* slab = aslab + ((size_t)sl * NR + R0) * 8; LAS float* buf = (LAS float*)lds;
            const int gi = sl >> 4;
            if (gi == 0) pool_lat_item<2>(slab, buf); else if (gi == 1) pool_lat_item<4>(slab, buf); else if (gi == 2) pool_lat_item<8>(slab, buf); else pool_lat_item<16>(slab, buf);
        } else if (it < NPL + NCV) {
            const int ci = it - NPL; int R0, len, t0;
            if (ci < 1024) { const int b = ci >> 7; R0 = (b >> 2) * HR + (b & 3) * SEQ; len = SEQ; t0 = (ci & 127) * 32; }
            else { const int cj = ci - 1024, b = cj >> 3; R0 = (b >> 2) * HR + HLAT + (b & 3) * CTXL; len = CTXL; t0 = (cj & 7) * 32; }
            LAS unsigned* gin = (LAS unsigned*)lds;
            LAS float* cout = (LAS float*)(lds + 62 * 1024);
            for (int i = tid; i < 62 * 64; i += 512) { const int rr = i >> 6, cc = i & 63, t = t0 - 15 + rr;
                u32x4 w = (u32x4){0u, 0u, 0u, 0u}; if (t >= 0 && t < len) w = *(const u32x4*)(glu + (size_t)(R0 + t) * 512 + cc * 8);
                *(LAS u32x4*)(gin + rr * 256 + cc * 4) = w; }
            __syncthreads();
            { const float* cw = p.in[12] + tid; float w[31];
#pragma unroll
              for (int j = 0; j < 31; ++j) w[j] = cw[j * 512];
              float a[32]; const float cb0 = p.in[13][tid];
#pragma unroll
              for (int t = 0; t < 32; ++t) a[t] = cb0;
              const LAS unsigned short* gs = (const LAS unsigned short*)gin + tid;
#pragma unroll
              for (int rr = 0; rr < 62; ++rr) { const float x = bf2f(gs[rr * 512]);
#pragma unroll
                  for (int t = 0; t < 32; ++t) { const int j = rr - t; if (j >= 0 && j < 31) a[t] += w[j] * x; } }
#pragma unroll
              for (int t = 0; t < 32; ++t) cout[t * 512 + tid] = a[t]; }
            __syncthreads();
            { const int wv = tid >> 6, lane = tid & 63;
              for (int tt = 0; tt < 4; ++tt) { const int t = wv * 4 + tt; const LAS float* rp = cout + t * 512 + lane * 8;
                  const f32x4 v0 = *(const LAS f32x4*)rp, v1 = *(const LAS f32x4*)(rp + 4);
                  float s = (v0[0] + v0[1]) + (v0[2] + v0[3]) + (v1[0] + v1[1]) + (v1[2] + v1[3]);
                  const float mu = wave_sum(s) * (1.0f / 512.0f); const f32x4 d0 = v0 - mu, d1 = v1 - mu;
                  float q = d0[0] * d0[0] + d0[1] * d0[1] + d0[2] * d0[2] + d0[3] * d0[3] + d1[0] * d1[0] + d1[1] * d1[1] + d1[2] * d1[2] + d1[3] * d1[3];
                  const float rstd = rsqrtf(wave_sum(q) * (1.0f / 512.0f) + LNEPS);
                  const float* ng = p.in[14] + lane * 8; const float* nb = p.in[15] + lane * 8; f32x4 y0, y1;
#pragma unroll
                  for (int j = 0; j < 4; ++j) { y0[j] = siluf_(d0[j] * rstd * ng[j] + nb[j]); y1[j] = siluf_(d1[j] * rstd * ng[4 + j] + nb[4 + j]); }
                  *(u32x4*)(ycat + (size_t)(R0 + t0 + t) * 1024 + 512 + lane * 8) = pack8(y0, y1); } }
            __syncthreads();
        } else {
            const int pi = it - NPL - NCV, b = pi >> 6, sl = pi & 63; const int R0 = (b >> 2) * HR + HLAT + (b & 3) * CTXL; const int W = 2 << (sl >> 4);
            bf16_t* slab = aslab + ((size_t)sl * NR + R0) * 8; LAS float* buf = (LAS float*)lds;
            if (tid < 256) { const u32x4 w = *(const u32x4*)(slab + (size_t)tid * 8);
                *(LAS f32x4*)(buf + tid * 8) = (f32x4){bflo(w.x), bfhi(w.x), bflo(w.y), bfhi(w.y)}; *(LAS f32x4*)(buf + tid * 8 + 4) = (f32x4){bflo(w.z), bfhi(w.z), bflo(w.w), bfhi(w.w)}; }
            __syncthreads();
            f32x4 d = (f32x4){0.f, 0.f, 0.f, 0.f}; const int t = tid >> 1, hc = (tid & 1) * 4;
            { const int lo = t - W / 2 < 0 ? 0 : t - W / 2, hi = t + W - W / 2 > 256 ? 256 : t + W - W / 2; f32x4 s = (f32x4){0.f, 0.f, 0.f, 0.f};
              for (int j = lo; j < hi; ++j) s += *(const LAS f32x4*)(buf + j * 8 + hc);
              d = s * (1.0f / (float)(hi - lo)) - *(const LAS f32x4*)(buf + t * 8 + hc); }
            u32x2 o; o.x = cvt_pk_bf16(d[0], d[1]); o.y = cvt_pk_bf16(d[2], d[3]);
            *(u32x2*)(slab + (size_t)t * 8 + hc) = o;
            __syncthreads();
        }
    }
}

__device__ void phase_mlconv(const Params& p, int hf) {
    const int tid_ = TIDX; const int wave = (blockIdx.x * 512 + tid_) >> 6, lane = tid_ & 63, nw = 2048, tk = lane & 15, g = lane >> 4;
    const bf16_t* xm = (const bf16_t*)(p.ws + S_R1); bf16_t* xc = (bf16_t*)(p.ws + S_R2); float* gates = (float*)(p.ws + S_GATES);
    const bf16_t* aqk = (const bf16_t*)(p.out + W_AQK); const bf16_t* av = (const bf16_t*)(p.out + W_AV);
    const float* cw = p.in[18]; const float* cb = p.in[19];
    (void)wave; (void)nw;
    for (int it = (tid_ >> 6) * 256 + (int)blockIdx.x; it < HR / 16; it += 2048) {
        const int r = it * 16 + tk; const int pos = r < HLAT ? (r & 4095) : ((r - HLAT) & 255), len = r < HLAT ? SEQ : CTXL;
        const bool hasp = pos > 0, hasn = pos < len - 1;
        f32x4 acc = (f32x4){0.f, 0.f, 0.f, 0.f};
#pragma unroll 2
        for (int ks = 0; ks < 64; ++ks) { const int c0 = ks * 32 + g * 8;
            const u32x4 z4 = (u32x4){0u, 0u, 0u, 0u};
            const u32x4 wc_ = *(const u32x4*)(xm + (size_t)r * 2048 + c0);
            const u32x4 wp = hasp ? *(const u32x4*)(xm + (size_t)(r - 1) * 2048 + c0) : z4;
            const u32x4 wn = hasn ? *(const u32x4*)(xm + (size_t)(r + 1) * 2048 + c0) : z4;
            float o[8];
            float w0v[8], w1v[8], w2v[8], bbv[8];
            { const f32x4 a0 = *(const f32x4*)(cw + c0), a1 = *(const f32x4*)(cw + c0 + 4), b0 = *(const f32x4*)(cw + 2048 + c0), b1 = *(const f32x4*)(cw + 2048 + c0 + 4);
              const f32x4 c0v = *(const f32x4*)(cw + 4096 + c0), c1v = *(const f32x4*)(cw + 4096 + c0 + 4), d0 = *(const f32x4*)(cb + c0), d1 = *(const f32x4*)(cb + c0 + 4);
#pragma unroll
              for (int e = 0; e < 4; ++e) { w0v[e] = a0[e]; w0v[4 + e] = a1[e]; w1v[e] = b0[e]; w1v[4 + e] = b1[e]; w2v[e] = c0v[e]; w2v[4 + e] = c1v[e]; bbv[e] = d0[e]; bbv[4 + e] = d1[e]; } }
#pragma unroll
            for (int j = 0; j < 4; ++j) { const unsigned a = wp[j], b = wc_[j], c = wn[j];
                o[2 * j] = siluf_(w0v[2 * j] * bflo(a) + w1v[2 * j] * bflo(b) + w2v[2 * j] * bflo(c) + bbv[2 * j]);
                o[2 * j + 1] = siluf_(w0v[2 * j + 1] * bfhi(a) + w1v[2 * j + 1] * bfhi(b) + w2v[2 * j + 1] * bfhi(c) + bbv[2 * j + 1]); }
            u32x4 xo; xo.x = cvt_pk_bf16(o[0], o[1]); xo.y = cvt_pk_bf16(o[2], o[3]); xo.z = cvt_pk_bf16(o[4], o[5]); xo.w = cvt_pk_bf16(o[6], o[7]);
            *(u32x4*)(xc + (size_t)r * 2048 + c0) = xo;
            const bf16x8 bq = *(const bf16x8*)(aqk + (size_t)tk * 2048 + c0), bv = *(const bf16x8*)(av + (size_t)tk * 2048 + c0);
            acc = __builtin_amdgcn_mfma_f32_16x16x32_bf16(__builtin_bit_cast(bf16x8, xo), bq, acc, 0, 0, 0);
            acc = __builtin_amdgcn_mfma_f32_16x16x32_bf16(__builtin_bit_cast(bf16x8, wc_), bv, acc, 0, 0, 0); }
        const float bg = p.in[24][tk];
#pragma unroll
        for (int i = 0; i < 4; ++i) { float v = acc[i] + bg; if ((tk & 7) >= 4) v = fminf(v, 0.f) - log1pf(__expf(-fabsf(v)));
            gates[((size_t)hf * HR + it * 16 + 4 * g + i) * 16 + tk] = v; }
    }
}

__device__ void phase_mlout(const Params& p) {
    const int tid_ = TIDX; const int wave = (blockIdx.x * 512 + tid_) >> 6, lane = tid_ & 63, nw = 2048;
    const bf16_t* hfw = (const bf16_t*)(p.ws + S_R1); const bf16_t* hbw = (const bf16_t*)(p.ws + S_R6); bf16_t* xc = (bf16_t*)(p.ws + S_R2); const bf16_t* z = (const bf16_t*)(p.ws + S_R3);
    const float* ng = p.in[25]; const float* sk = p.in[26];
    for (int r = wave; r < HLAT; r += nw) {
#pragma unroll
        for (int hh = 0; hh < 4; ++hh) { const int c = hh * 512 + lane * 8; const size_t o = (size_t)r * 2048 + c;
            const u32x4 a = *(const u32x4*)(hfw + o), b = *(const u32x4*)(hbw + o), xw = *(const u32x4*)(xc + o), zw = *(const u32x4*)(z + o);
            float x[8]; float s = 0.f;
#pragma unroll
            for (int j = 0; j < 4; ++j) { x[2 * j] = bflo(a[j]) + bflo(b[j]); x[2 * j + 1] = bfhi(a[j]) + bfhi(b[j]); s += x[2 * j] + x[2 * j + 1]; }
            const float mu = wave_sum(s) * (1.0f / 512.0f); float q = 0.f;
#pragma unroll
            for (int j = 0; j < 8; ++j) { x[j] -= mu; q += x[j] * x[j]; }
            const float rstd = rsqrtf(wave_sum(q) * (1.0f / 512.0f) + LNEPS);
            float y[8];
#pragma unroll
            for (int j = 0; j < 4; ++j) {
                y[2 * j] = (x[2 * j] * rstd * ng[c + 2 * j] + sk[c + 2 * j] * bflo(xw[j])) * siluf_(bflo(zw[j]));
                y[2 * j + 1] = (x[2 * j + 1] * rstd * ng[c + 2 * j + 1] + sk[c + 2 * j + 1] * bfhi(xw[j])) * siluf_(bfhi(zw[j])); }
            u32x4 w; w.x = cvt_pk_bf16(y[0], y[1]); w.y = cvt_pk_bf16(y[2], y[3]); w.z = cvt_pk_bf16(y[4], y[5]); w.w = cvt_pk_bf16(y[6], y[7]);
            *(u32x4*)(xc + o) = w; }
    }
}

constexpr int QS_STRIDE = 1040, KT_STRIDE = 144, PS_STRIDE = 144;
constexpr int L_QS = 0, L_KT = 64 * QS_STRIDE  , L_PS = L_KT + 512 * KT_STRIDE  , PS_HALF = 64 * PS_STRIDE  , L_VEC = L_PS + 2 * PS_HALF  ;
static_assert(L_VEC + 3840 <= LDS_BYTES, "scan LDS");
#define LDS_BAR() asm volatile("s_waitcnt lgkmcnt(0)\n\ts_barrier" ::: "memory")
struct ScanPos { int chunk, rowbase; bool isctx; };
DI ScanPos scan_pos(int step, int dir, int bl) {
    ScanPos sp; sp.isctx = step < 4; const int ci = sp.isctx ? step : step - 4, nchunk = sp.isctx ? 4 : 64;
    const int cn = dir ? nchunk - 1 - ci : ci;
    sp.chunk = sp.isctx ? 256 + bl * 4 + cn : bl * 64 + cn;
    sp.rowbase = sp.isctx ? HLAT + bl * CTXL + cn * 64 : bl * SEQ + cn * 64;
    return sp;
}
__device__ void phase_pre(const Params& p, int hf) {
    const int tid_ = TIDX; const int wave = (blockIdx.x * 512 + tid_) >> 6, lane = tid_ & 63;
    const float* gates = (const float*)(p.ws + S_GATES) + (size_t)hf * HR * 16; float* pre = (float*)(p.ws + S_PRE);
    for (int job = wave; job < 32 * 68; job += 2048) { const int combo = job / 68, c = job - combo * 68, dir = combo & 1, h = (combo >> 1) & 3, bl = combo >> 3;
        const ScanPos sp = scan_pos(c, dir, bl); const int pp = dir ? 63 - lane : lane;
        const float ic = gates[(size_t)(sp.rowbase + pp) * 16 + dir * 8 + h], fc = gates[(size_t)(sp.rowbase + pp) * 16 + dir * 8 + 4 + h];
        float bcs = fc;
#pragma unroll
        for (int o = 1; o < 64; o <<= 1) { const float t = __shfl_up(bcs, o); if (lane >= o) bcs += t; }
        const float blast = __shfl(bcs, 63); const float mw = wave_max(blast - bcs + ic);
        float cm = ic - bcs;
#pragma unroll
        for (int o = 1; o < 64; o <<= 1) { const float t = __shfl_up(cm, o); if (lane >= o) cm = fmaxf(cm, t); }
        *(f32x4*)(pre + ((size_t)job * 64 + lane) * 4) = (f32x4){bcs, cm, ic, 0.f};
        if (lane == 0) { pre[PRE_V + job * 2] = blast; pre[PRE_V + job * 2 + 1] = mw; } }
}
__device__ void phase_intra(const Params& p, LAS unsigned char* lds) {
    const int tid = TIDX, wid = __builtin_amdgcn_readfirstlane(tid >> 6), lane = tid & 63, tk = lane & 15, g = lane >> 4;
    const bf16_t* qc = (const bf16_t*)(p.ws + S_R3); const bf16_t* kc = (const bf16_t*)(p.ws + S_R4); const bf16_t* vtc = (const bf16_t*)(p.ws + S_R5);
    const float* pre = (const float*)(p.ws + S_PRE); float* RS = (float*)(p.ws + S_RS);
    LAS float* A_ = (LAS float*)(lds + 2 * PS_HALF);
    LAS float* M_ = A_ + 128; LAS float* rsl = A_ + 256;
    for (int item = blockIdx.x; item < 1024; item += 256) {
        const int bl = item >> 8, h = (item >> 6) & 3, cn = item & 63; const int chunk = bl * 64 + cn, rowbase = bl * SEQ + cn * 64;
        if (wid < 2) { const int d = wid, combo = d + 2 * h + 8 * bl, kq = d ? 63 - cn : cn;
            const float* sc = pre + PRE_V + (size_t)combo * 68 * 2;
            float m4 = 0.f;
#pragma unroll
            for (int k = 0; k < 4; ++k) m4 = fmaxf(sc[k * 2] + m4, sc[k * 2 + 1]);
            float B = sc[(4 + lane) * 2], W = sc[(4 + lane) * 2 + 1];
#pragma unroll
            for (int o = 1; o < 64; o <<= 1) { const float Bp = __shfl_up(B, o), Wp = __shfl_up(W, o); if (lane >= o) { W = fmaxf(Wp + B, W); B = Bp + B; } }
            const float mafter = fmaxf(m4 + B, W); const float mprev = __shfl(mafter, kq > 0 ? kq - 1 : 0); const float mstart = kq > 0 ? mprev : m4;
            const f32x4 pv = *(const f32x4*)(pre + (((size_t)combo * 68 + 4 + kq) * 64 + lane) * 4); const int pp = d ? 63 - lane : lane;
            A_[d * 64 + pp] = pv[2] - pv[0]; M_[d * 64 + pp] = fmaxf(mstart, pv[1]); rsl[d * 64 + lane] = 0.f; }
        __syncthreads();
        {
            const int st = wid >> 1, tt0 = 2 * (wid & 1); f32x4 S0 = (f32x4){0.f, 0.f, 0.f, 0.f}, S1 = S0;
            const bf16_t* ka = kc + ((size_t)chunk * 4 + h) * 64 * 512 + (size_t)(st * 16 + tk) * 512 + g * 8;
            const bf16_t* qa = qc + ((size_t)chunk * 4 + h) * 64 * 512 + (size_t)(tt0 * 16 + tk) * 512 + g * 8;
#pragma unroll 8
            for (int kk = 0; kk < 16; ++kk) { const bf16x8 a = *(const bf16x8*)(ka + kk * 32), b0 = *(const bf16x8*)(qa + kk * 32), b1 = *(const bf16x8*)(qa + 16 * 512 + kk * 32);
                S0 = __builtin_amdgcn_mfma_f32_16x16x32_bf16(a, b0, S0, 0, 0, 0); S1 = __builtin_amdgcn_mfma_f32_16x16x32_bf16(a, b1, S1, 0, 0, 0); }
#pragma unroll
            for (int d = 0; d < 2; ++d)
#pragma unroll
                for (int x = 0; x < 2; ++x) { const int t = (tt0 + x) * 16 + tk; const float Mt = M_[d * 64 + t]; const f32x4 Sv = x ? S1 : S0; float pv[4]; float psum = 0.f;
#pragma unroll
                    for (int i = 0; i < 4; ++i) { const int sx = st * 16 + 4 * g + i; const bool ok = d ? (sx >= t) : (sx <= t);
                        const float dd = ok ? __expf(A_[d * 64 + sx] - Mt) : 0.f; pv[i] = Sv[i] * dd; psum += pv[i]; }
                    u32x2 w; w.x = cvt_pk_bf16(pv[0], pv[1]); w.y = cvt_pk_bf16(pv[2], pv[3]);
                    *(LAS u32x2*)(lds + d * PS_HALF + t * PS_STRIDE + (st * 16 + 4 * g) * 2) = w;
                    (void)psum; } }
        __syncthreads();
        {
            u32x4 va[4][2];
#pragma unroll
            for (int mi = 0; mi < 4; ++mi) { const bf16_t* vg = vtc + (((size_t)chunk * 4 + h) * 512 + wid * 64 + mi * 16 + tk) * 64; va[mi][0] = *(const u32x4*)(vg + g * 8); va[mi][1] = *(const u32x4*)(vg + 32 + g * 8); }
#pragma unroll
            for (int d = 0; d < 2; ++d) { bf16_t* hout = (bf16_t*)(p.ws + (d ? S_R6 : S_R1));
#pragma unroll
                for (int ni = 0; ni < 4; ++ni) { const bf16x8 pb0 = *(const LAS bf16x8*)(lds + d * PS_HALF + (ni * 16 + tk) * PS_STRIDE + (g * 8) * 2), pb1 = *(const LAS bf16x8*)(lds + d * PS_HALF + (ni * 16 + tk) * PS_STRIDE + (32 + g * 8) * 2);
#pragma unroll
                    for (int mi = 0; mi < 4; ++mi) { f32x4 acc = (f32x4){0.f, 0.f, 0.f, 0.f};
                        acc = __builtin_amdgcn_mfma_f32_16x16x32_bf16(__builtin_bit_cast(bf16x8, va[mi][0]), pb0, acc, 0, 0, 0);
                        acc = __builtin_amdgcn_mfma_f32_16x16x32_bf16(__builtin_bit_cast(bf16x8, va[mi][1]), pb1, acc, 0, 0, 0);
                        u32x2 w; w.x = cvt_pk_bf16_mfma(acc[0], acc[1]); w.y = cvt_pk_bf16_mfma(acc[2], acc[3]);
                        *(u32x2*)(hout + (size_t)(rowbase + ni * 16 + tk) * 2048 + h * 512 + wid * 64 + mi * 16 + 4 * g) = w; } } } }
        if (tid < 128) { const int d = tid >> 6, t = tid & 63; float sum = 0.f;
#pragma unroll
            for (int i = 0; i < 8; ++i) { const u32x4 w = *(const LAS u32x4*)(lds + d * PS_HALF + t * PS_STRIDE + i * 16); sum += (bflo(w.x) + bfhi(w.x)) + (bflo(w.y) + bfhi(w.y)) + (bflo(w.z) + bfhi(w.z)) + (bflo(w.w) + bfhi(w.w)); }
            RS[((size_t)(rowbase + t) * 2 + d) * 4 + h] = sum; }
        __syncthreads();
    }
}

__device__ void phase_scan(const Params& p, int hf, LAS unsigned char* lds) {
    const int tid0 = TIDX, wid = __builtin_amdgcn_readfirstlane(tid0 >> 6);
    const int wg = blockIdx.x, vs = wg >> 5, dir = wg & 1, h = (wg >> 1) & 3, bl = (wg >> 3) & 3;
    const int dvg = wid & 3, kh = wid >> 2;
    const bf16_t* qc = (const bf16_t*)(p.ws + S_R3); const bf16_t* kc = (const bf16_t*)(p.ws + S_R4); const bf16_t* vtc = (const bf16_t*)(p.ws + S_R5);
    bf16_t* hout = (bf16_t*)(p.ws + (dir ? S_R6 : S_R1));
    (void)hf;
    LAS float* vec = (LAS float*)(lds + L_VEC);
    LAS float* fin4 = vec  , *e_p = vec + 256, *iw_p = vec + 320, *qn = vec + 384;
    LAS unsigned* nbf = (LAS unsigned*)(vec + 448);
    LAS unsigned* ebf = (LAS unsigned*)(vec + 704);
    f32x4 C[16];
#pragma unroll
    for (int i = 0; i < 16; ++i) C[i] = (f32x4){0.f, 0.f, 0.f, 0.f};
    float nreg = 0.f; ((LAS unsigned short*)nbf)[tid0] = 0;
    float mstate = 0.f;
    const int dvw = vs * 64 + dvg * 16;
    const int combo = wg & 31; const float* pre = (const float*)(p.ws + S_PRE) + (size_t)combo * 68 * 256; const float* pres = (const float*)(p.ws + S_PRE) + PRE_V + (size_t)combo * 68 * 2;
    const float* RS = (const float*)(p.ws + S_RS);
    f32x4 pv_n; float bl_n, mw_n, rs_n = 0.f; unsigned short numi_n[8] = {0, 0, 0, 0, 0, 0, 0, 0}; u32x4 kr[8];
    { const ScanPos s0 = scan_pos(0, dir, bl); const int lane = tid0 & 63, tk = lane & 15, g = lane >> 4, pp = dir ? 63 - lane : lane;
      (void)pp; pv_n = *(const f32x4*)(pre + (size_t)lane * 4); bl_n = pres[0]; mw_n = pres[1];
      const bf16_t* kg = kc + ((size_t)s0.chunk * 4 + h) * 64 * 512 + (size_t)((wid >> 1) * 16 + tk) * 512 + (wid & 1) * 256 + g * 8;
#pragma unroll
      for (int j = 0; j < 8; ++j) kr[j] = *(const u32x4*)(kg + j * 32); }
    __syncthreads();
    for (int step = 0; step < 68; ++step) {
        int tid = tid0; asm volatile("" : "+v"(tid));
        const int lane = tid & 63, tk = lane & 15, g = lane >> 4;
        const ScanPos cur = scan_pos(step, dir, bl); const bool isctx = cur.isctx; const int rowbase = cur.rowbase;
        const bool has_next = step < 67; const ScanPos nxt = scan_pos(has_next ? step + 1 : step, dir, bl);
        const int pp = dir ? 63 - lane : lane;
        unsigned short numi_c[8];
#pragma unroll
        for (int k = 0; k < 8; ++k) numi_c[k] = numi_n[k];
        const float bcs = pv_n[0], cm = pv_n[1], ic = pv_n[2], blast = bl_n;
        const float mnew = fmaxf(blast + mstate, mw_n);
        const float decay = __expf(blast + mstate - mnew);
        const float ev = __expf(blast - bcs + ic - mnew);
        const float av = ic - bcs;
        const float Mx = fmaxf(mstate, cm);
        if (wid == 0) { (void)av; const float iwv = __expf(mstate - Mx); e_p[pp] = ev; iw_p[pp] = iwv; fin4[pp * 4] = iwv; fin4[pp * 4 + 2] = __expf(-(bcs + Mx)); fin4[lane * 4 + 1] = rs_n; ((LAS unsigned short*)ebf)[pp] = (unsigned short)(cvt_pk_bf16(ev, 0.f) & 0xffffu); }
        { const int sel = tk & 1, srow = (wid >> 1) * 16 + tk, dk0 = (wid & 1) * 256 + g * 8 + (sel ? 4 : 0);
          LAS unsigned char* kb = lds + L_KT + dk0 * KT_STRIDE + (srow >> 1) * 4;
#pragma unroll
          for (int j = 0; j < 8; ++j) { const u32x4 d = kr[j]; u32x4 q4;
#pragma unroll
              for (int m = 0; m < 4; ++m) q4[m] = (unsigned)__builtin_amdgcn_update_dpp(0, (int)d[m], 0xB1, 0xF, 0xF, false);
              const unsigned ae0 = sel ? q4[2] : d[0], ae1 = sel ? q4[3] : d[1], bo0 = sel ? d[2] : q4[0], bo1 = sel ? d[3] : q4[1];
              LAS unsigned char* kp = kb + j * 32 * KT_STRIDE;
              *(LAS unsigned*)(kp) = __builtin_amdgcn_perm(bo0, ae0, 0x05040100u); *(LAS unsigned*)(kp + KT_STRIDE) = __builtin_amdgcn_perm(bo0, ae0, 0x07060302u);
              *(LAS unsigned*)(kp + 2 * KT_STRIDE) = __builtin_amdgcn_perm(bo1, ae1, 0x05040100u); *(LAS unsigned*)(kp + 3 * KT_STRIDE) = __builtin_amdgcn_perm(bo1, ae1, 0x07060302u); } }
        if (step == 4) {
            const bf16_t* qg = qc + ((size_t)cur.chunk * 4 + h) * 64 * 512;
#pragma unroll
            for (int i = 0; i < 8; ++i) { const int t = wid * 8 + i;
                __builtin_amdgcn_global_load_lds((const unsigned*)(qg + (size_t)t * 512 + lane * 8), (LAS unsigned*)(lds + L_QS + t * QS_STRIDE), 16, 0, 0); }
        }
        asm volatile("s_waitcnt vmcnt(0)" ::: "memory");
        LDS_BAR();
        const bf16_t* vg = vtc + (((size_t)cur.chunk * 4 + h) * 512 + dvw + tk) * 64;
        const u32x4 v0 = *(const u32x4*)(vg + g * 8), v1 = *(const u32x4*)(vg + 32 + g * 8);
        if (has_next) { pv_n = *(const f32x4*)(pre + ((size_t)(step + 1) * 64 + lane) * 4); bl_n = pres[(step + 1) * 2]; mw_n = pres[(step + 1) * 2 + 1];
                        if (!nxt.isctx) { rs_n = RS[((size_t)(nxt.rowbase + lane) * 2 + dir) * 4 + h];
#pragma unroll
                            for (int m2 = 0; m2 < 2; ++m2)
#pragma unroll
                                for (int i = 0; i < 4; ++i) { const int t = (kh * 2 + m2) * 16 + 4 * g + i; numi_n[m2 * 4 + i] = hout[(size_t)(nxt.rowbase + t) * 2048 + h * 512 + dvw + tk]; } } }
        f32x4 O[4];
        if (!isctx) {
            { const int t = tid >> 3, part = tid & 7; float s = 0.f;
#pragma unroll
              for (int i = 0; i < 8; ++i) { const u32x4 w = *(const LAS u32x4*)(lds + L_QS + t * QS_STRIDE + (part * 64 + i * 8) * 2); const u32x4 nv = *(const LAS u32x4*)(nbf + part * 32 + i * 4);
                  s = dot2bf(w.x, nv.x, s); s = dot2bf(w.y, nv.y, s); s = dot2bf(w.z, nv.z, s); s = dot2bf(w.w, nv.w, s); }
              s += __builtin_bit_cast(float, __builtin_amdgcn_update_dpp(0, __builtin_bit_cast(int, s), 0xB1, 0xF, 0xF, true));
              s += __builtin_bit_cast(float, __builtin_amdgcn_update_dpp(0, __builtin_bit_cast(int, s), 0x4E, 0xF, 0xF, true));
              s += __builtin_bit_cast(float, __builtin_amdgcn_update_dpp(0, __builtin_bit_cast(int, s), 0x104, 0xF, 0xF, true));
              if (part == 0) qn[t] = s; }
#pragma unroll
            for (int mt = 0; mt < 4; ++mt) O[mt] = (f32x4){0.f, 0.f, 0.f, 0.f};
            { u32x4 aw[2][4];
#define QC_LOAD(buf, j_) do { _Pragma("unroll") for (int mt = 0; mt < 4; ++mt) aw[buf][mt] = *(const LAS u32x4*)(lds + L_QS + (mt * 16 + tk) * QS_STRIDE + ((kh * 8 + (j_)) * 32 + 8 * g) * 2); } while (0)
              QC_LOAD(0, 0);
#pragma unroll
              for (int j = 0; j < 8; ++j) {
                  if (j < 7) QC_LOAD((j + 1) & 1, j + 1);
                  u32x4 bw; bw.x = cvt_pk_bf16(C[2 * j][0], C[2 * j][1]); bw.y = cvt_pk_bf16(C[2 * j][2], C[2 * j][3]); bw.z = cvt_pk_bf16(C[2 * j + 1][0], C[2 * j + 1][1]); bw.w = cvt_pk_bf16(C[2 * j + 1][2], C[2 * j + 1][3]);
                  const bf16x8 bb = __builtin_bit_cast(bf16x8, bw);
                  __builtin_amdgcn_sched_barrier(0);
#pragma unroll
                  for (int mt = 0; mt < 4; ++mt) O[mt] = __builtin_amdgcn_mfma_f32_16x16x32_bf16(__builtin_bit_cast(bf16x8, aw[j & 1][mt]), bb, O[mt], 0, 0, 0);
                  __builtin_amdgcn_sched_barrier(0); }
#undef QC_LOAD
            }
        }
        LDS_BAR();
        if (has_next) {
            if (!nxt.isctx) { const bf16_t* qg = qc + ((size_t)nxt.chunk * 4 + h) * 64 * 512;
#pragma unroll
                for (int i = 0; i < 8; ++i) { const int t = wid * 8 + i;
                    __builtin_amdgcn_global_load_lds((const unsigned*)(qg + (size_t)t * 512 + lane * 8), (LAS unsigned*)(lds + L_QS + t * QS_STRIDE), 16, 0, 0); } }
            const bf16_t* kgn = kc + ((size_t)nxt.chunk * 4 + h) * 64 * 512 + (size_t)((wid >> 1) * 16 + tk) * 512 + (wid & 1) * 256 + g * 8;
#pragma unroll
            for (int j = 0; j < 8; ++j) kr[j] = *(const u32x4*)(kgn + j * 32);
        }
        if (!isctx) {
            float numi[8];
#pragma unroll
            for (int m2 = 0; m2 < 2; ++m2)
#pragma unroll
                for (int i = 0; i < 4; ++i) numi[m2 * 4 + i] = bf2f(numi_c[m2 * 4 + i]);
#pragma unroll
            for (int mt = 0; mt < 4; ++mt) { const f32x4 iw4 = *(const LAS f32x4*)(iw_p + mt * 16 + 4 * g); O[mt] = O[mt] * iw4; }
            LAS float* xw = (LAS float*)(lds + L_PS) + (dvg * 2 + kh) * 512 + lane * 8;
            const LAS float* xr = (const LAS float*)(lds + L_PS) + (dvg * 2 + (kh ^ 1)) * 512 + lane * 8;
            *(LAS f32x4*)xw = kh ? O[0] : O[2]; *(LAS f32x4*)(xw + 4) = kh ? O[1] : O[3];
            LDS_BAR();
            { const f32x4 xp0 = *(const LAS f32x4*)xr, xp1 = *(const LAS f32x4*)(xr + 4);
#pragma unroll
              for (int m2 = 0; m2 < 2; ++m2) { const int mt = kh * 2 + m2; const f32x4 own = kh ? O[2 + m2] : O[m2]; const f32x4 xp = m2 ? xp1 : xp0; const f32x4 qn4 = *(const LAS f32x4*)(qn + mt * 16 + 4 * g);
#pragma unroll
                  for (int i = 0; i < 4; ++i) { const int t = mt * 16 + 4 * g + i; const f32x4 f = *(const LAS f32x4*)(fin4 + t * 4); const float den = f[0] * qn4[i] + f[1];
                      const float hv = (own[i] + xp[i] + numi[m2 * 4 + i]) * __builtin_amdgcn_rcpf(fmaxf(fabsf(den), f[2]));
                      hout[(size_t)(rowbase + t) * 2048 + h * 512 + dvw + tk] = (bf16_t)(cvt_pk_bf16(hv, 0.f) & 0xffffu); } } }
        }
        { u32x4 w0, w1;
#pragma unroll
          for (int j = 0; j < 4; ++j) { const int t = g * 8 + 2 * j; w0[j] = cvt_pk_bf16(bflo(v0[j]) * e_p[t], bfhi(v0[j]) * e_p[t + 1]); w1[j] = cvt_pk_bf16(bflo(v1[j]) * e_p[32 + t], bfhi(v1[j]) * e_p[32 + t + 1]); }
          const bf16x8 ve0 = __builtin_bit_cast(bf16x8, w0), ve1 = __builtin_bit_cast(bf16x8, w1);
          const LAS unsigned char* kbase = lds + L_KT + (kh * 256 + 8 * (tk >> 2) + (tk & 3)) * KT_STRIDE + g * 16;
          bf16x8 ka[2][2];
          ka[0][0] = *(const LAS bf16x8*)kbase; ka[0][1] = *(const LAS bf16x8*)(kbase + 64);
#pragma unroll
          for (int i = 0; i < 16; ++i) {
              if (i < 15) { const LAS unsigned char* kp = kbase + (32 * ((i + 1) >> 1) + 4 * ((i + 1) & 1)) * KT_STRIDE; ka[(i + 1) & 1][0] = *(const LAS bf16x8*)kp; ka[(i + 1) & 1][1] = *(const LAS bf16x8*)(kp + 64); }
              C[i] = C[i] * decay;
              __builtin_amdgcn_sched_barrier(0);
              C[i] = __builtin_amdgcn_mfma_f32_16x16x32_bf16(ka[i & 1][0], ve0, C[i], 0, 0, 0);
              C[i] = __builtin_amdgcn_mfma_f32_16x16x32_bf16(ka[i & 1][1], ve1, C[i], 0, 0, 0);
              __builtin_amdgcn_sched_barrier(0); } }
        { float sacc = 0.f; const LAS unsigned char* kp = lds + L_KT + tid * KT_STRIDE;
#pragma unroll
          for (int i = 0; i < 8; ++i) { const u32x4 w = *(const LAS u32x4*)(kp + i * 16); const u32x4 e4 = *(const LAS u32x4*)(ebf + i * 4);
              sacc = dot2bf(w.x, e4.x, sacc); sacc = dot2bf(w.y, e4.y, sacc); sacc = dot2bf(w.z, e4.z, sacc); sacc = dot2bf(w.w, e4.w, sacc); }
          nreg = decay * nreg + sacc; ((LAS unsigned short*)nbf)[tid] = (unsigned short)(cvt_pk_bf16(nreg, 0.f) & 0xffffu); }
        mstate = mnew;
        LDS_BAR();
    }
}

DI Sch mk_sch(int nM, int nN, int nsub, const void* A0, const void* B0, size_t a_tile, size_t b_tile, size_t a_sub, size_t b_sub, int a_mod = 0, int b_mod = 0) {
    Sch s; s.nM = nM; s.nN = nN; s.nsub = nsub; s.G = 256; s.c = blockIdx.x; s.A0 = (const char*)A0; s.B0 = (const char*)B0;
    s.a_tile = a_tile; s.b_tile = b_tile; s.a_sub = a_sub; s.b_sub = b_sub; s.a_sub2 = 0; s.a_mod = a_mod; s.b_mod = b_mod; return s;
}

__global__ void __launch_bounds__(512, 2) mega(Params p, int ph_lo, int ph_hi) {
    extern __shared__ __attribute__((aligned(16))) unsigned char smem[];
    LAS unsigned char* lds = (LAS unsigned char*)smem;
    cg::grid_group grid = cg::this_grid();
#ifdef PROBE
    unsigned long long tprev = 0, accA = 0, accB = 0;
#endif
    for (int ph = 0; ph < 30; ++ph) {
        if (ph > 0) { if (p.ws == nullptr) grid.sync();
                      unsigned gen = (unsigned)(ph - 1); grid_bar((unsigned*)(p.ws + S_BAR), gen); }
#ifdef PROBE
        { const unsigned long long tn = __builtin_amdgcn_s_memrealtime(); if (ph > 0) { if ((PROBE_MA >> (ph - 1)) & 1u) accA += tn - tprev; if ((PROBE_MB >> (ph - 1)) & 1u) accB += tn - tprev; } tprev = tn; }
        const float probe_b = (float)accB * 0.01f;
#else
        const float probe_b = 0.f;
#endif
        const float* mods = (const float*)(p.out + W_MODS);
        _Float16* hb = (_Float16*)(p.out + O_HB);
        unsigned char* ub = p.ws + S_UB;
#ifndef ONLY
#define EN(x) 1
#else
#define EN(x) ((x) == ONLY)
#endif
        switch (ph) {
        case 0: if (EN(0)) phase_prep(p, lds); break;
        case 1: if (EN(1)) phase_embed(p); break;
        case 2: if (EN(2)) { GemmCfg g{2048, 16, 2048, 16, 16}; Sch S = mk_sch(136, 6, 1, ub, p.out + W_ABIN, 256 * 2048, 256 * 2048, 0, 0);
                  EpiAbIn E{(bf16_t*)(p.ws + S_R1), (bf16_t*)(p.ws + S_R1 + 34 * MiB)}; gemm_phase(lds, g, S, E); } break;
        case 3: if (EN(3)) phase_poolconv(p, lds); break;
        case 4: if (EN(2)) { GemmCfg g{16, (unsigned)NR * 16u, 1024, 16, 8}; Sch S = mk_sch(136, 2, 1, p.ws + S_R1, p.out + W_POOL, 256 * 16, 256 * 1024, 0, 0);
                  EpiPool E{(bf16_t*)(p.ws + S_R2), p.in[10], p.in[11]}; gemm_phase(lds, g, S, E); } break;
        case 5: if (EN(2)) { GemmCfg g{2048, 16, 2048, 16, 16}; Sch S = mk_sch(136, 4, 1, p.ws + S_R2, p.out + W_ABOUT, 256 * 2048, 256 * 2048, 0, 0);
                  EpiRes E{hb, hb, mods + 2 * 1024, 0, nullptr, nullptr}; gemm_phase(lds, g, S, E); } break;
        case 6: if (EN(1)) phase_ln(p, hb, 0, 0, 0, 3, 0); break;
        case 7: if (EN(2)) { GemmCfg g{2048, 16, 2048, 16, 16}; Sch S = mk_sch(136, 22, 1, ub, p.out + W_FFNIN, 256 * 2048, 256 * 2048, 0, 0);
                  EpiFfnIn E{(bf16_t*)(p.ws + S_R3), 0}; gemm_phase(lds, g, S, E); } break;
        case 8: if (EN(2)) {
                  for (int cpart = 0; cpart < 2; ++cpart) {
                      GemmCfg g{FF * 2, 16, FF * 2, 16, cpart ? 22 : 44};
                      Sch S = mk_sch(cpart ? 4 : 64, 4, cpart ? 4 : 2, p.ws + S_R3 + (cpart ? (size_t)HLAT * FF * 2 : (size_t)0), p.out + W_FFNOUT, (size_t)256 * FF * 2, (size_t)256 * FF * 2,
                                     cpart ? (size_t)1408 * 2 : (size_t)HR * FF * 2, cpart ? (size_t)1408 * 2 : (size_t)0, cpart ? 2 : 0, cpart ? 2 : 0);
                      if (cpart) { S.a_sub2 = (size_t)HR * FF * 2; S.c = 255 - (int)blockIdx.x; }
                      EpiRes E{hb, hb, mods + (cpart ? 8 * 6144 : 0) + 5 * 1024, HR, cpart ? (float*)(p.ws + S_CPA) : (float*)nullptr, (float*)(p.ws + S_CPB)};
                      gemm_phase(lds, g, S, E); } } break;
        case 9: if (EN(1)) phase_ln(p, hb, 0, 1, 1, 0, 0, 0.f, (const float*)(p.ws + S_CPA), (const float*)(p.ws + S_CPB)); break;
        case 10: case 18: if (EN(2)) { const int hf = ph >= 18; GemmCfg g{2048, 16, 2048, 16, 16};
                  Sch S = mk_sch(68, 8, 1, ub + (size_t)hf * HR * 2048, p.out + W_MLIN, 256 * 2048, 256 * 2048, 0, 0);
                  EpiPlain E{(bf16_t*)(p.ws + S_R1), 2048}; gemm_phase(lds, g, S, E); } break;
        case 11: case 19: if (EN(4)) phase_mlconv(p, ph >= 19); break;
        case 12: case 20: if (EN(2)) {
                  phase_pre(p, ph >= 20);
                  { GemmCfg g{4096, 16, 1024, 16, 8}; Sch S = mk_sch(68, 2, 8, p.ws + S_R2, p.out + W_Q, 256 * 4096, 256 * 1024, 1024, 524288, 4, 0);
                    EpiQK E{(bf16_t*)(p.ws + S_R3), (bf16_t*)(p.ws + S_R4)}; gemm_phase(lds, g, S, E); }
                  { GemmCfg g{1024, 16, 4096, 16, 8}; Sch S = mk_sch(2, 68, 4, p.out + W_V, p.ws + S_R1, 256 * 1024, 256 * 4096, 524288, 1024);
                    S.c = 255 - (int)blockIdx.x;
                    EpiVT E{(bf16_t*)(p.ws + S_R5)}; gemm_phase(lds, g, S, E); } } break;
        case 13: case 21: if (EN(5)) phase_intra(p, lds); break;
        case 14: case 22: if (EN(5)) phase_scan(p, ph >= 22, lds); break;
        case 15: case 23: if (EN(2)) { const int hf = ph >= 23; GemmCfg g{2048, 16, 2048, 16, 16};
                  Sch S = mk_sch(64, 8, 1, ub + (size_t)hf * HR * 2048, p.out + W_MLIN + (size_t)2048 * 2048, 256 * 2048, 256 * 2048, 0, 0);
                  EpiPlain E{(bf16_t*)(p.ws + S_R3), 2048}; gemm_phase(lds, g, S, E); } break;
        case 16: case 24: if (EN(1)) phase_mlout(p); break;
        case 17: case 25: if (EN(2)) { const int hf = ph >= 25; GemmCfg g{4096, 16, 4096, 16, 32};
                  Sch S = mk_sch(64, 4, 1, p.ws + S_R2, p.out + W_MLOUT, 256 * 4096, 256 * 4096, 0, 0);
                  EpiRes E{hb + (size_t)hf * HR * 1024, hb + (size_t)hf * HR * 1024, mods + 9 * 6144 + 2 * 1024 + (size_t)hf * 4 * 6144, 0, nullptr, nullptr};
                  gemm_phase(lds, g, S, E); } break;
        case 26: if (EN(1)) phase_ln(p, hb, 1, 0, 1, 3, 1); break;
        case 27: if (EN(2)) { GemmCfg g{2048, 16, 2048, 16, 16}; Sch S = mk_sch(64, 22, 2, ub, p.out + W_FFNIN + 11534336, 256 * 2048, 256 * 2048, (size_t)HR * 2048, 0);
                  EpiFfnIn E{(bf16_t*)(p.ws + S_R1), HR}; gemm_phase(lds, g, S, E); } break;
        case 28: if (EN(2)) { GemmCfg g{FF * 2, 16, FF * 2, 16, 44}; Sch S = mk_sch(64, 4, 2, p.ws + S_R1, p.out + W_FFNOUT + 5767168, (size_t)256 * FF * 2, (size_t)256 * FF * 2, (size_t)HR * FF * 2, 0);
                  EpiRes E{hb, (_Float16*)(p.ws + S_R5), mods + 9 * 6144 + 5 * 1024, HR, nullptr, nullptr}; gemm_phase(lds, g, S, E); } break;
        case 29: if (EN(1)) phase_ln(p, (const _Float16*)(p.ws + S_R5), 1, 1, -1, 0, 2, probe_b); break;
        default: break;
        }
    }
#ifdef PROBE
    { const unsigned long long tn = __builtin_amdgcn_s_memrealtime(); if ((PROBE_MA >> 29) & 1u) accA += tn - tprev;
      __syncthreads(); if (blockIdx.x == 0 && threadIdx.x == 0) ((float*)p.out)[0] = (float)accA * 0.01f; }
#endif
}
constexpr int NPHASE = 30;

extern "C" void kernel_launch(void* const* d_in, const int* in_sizes, int n_in, void* d_out, int out_size, void* d_ws, size_t ws_size, hipStream_t stream) {
    static int grid = 0;
    if (grid == 0) {
        if (n_in != 30 || ws_size < WS_NEED) { fprintf(stderr, "kernel_launch: unexpected n_in %d or ws_size %zu (< %zu)\n", n_in, ws_size, (size_t)WS_NEED); grid = -1; return; }
        int dev = 0, cus = 0, per_cu = 0;
        hipGetDevice(&dev); hipDeviceGetAttribute(&cus, hipDeviceAttributeMultiprocessorCount, dev);
        if (hipFuncSetAttribute((const void*)mega, hipFuncAttributeMaxDynamicSharedMemorySize, LDS_BYTES) != hipSuccess) { fprintf(stderr, "hipFuncSetAttribute failed\n"); grid = -1; return; }
        hipOccupancyMaxActiveBlocksPerMultiprocessor(&per_cu, (const void*)mega, 512, LDS_BYTES);
        (void)hipGetLastError();
        grid = 256; if (cus != 256) fprintf(stderr, "kernel_launch: device reports %d CUs; this kernel is built for a 256-workgroup grid\n", cus);
        if (per_cu < 1) fprintf(stderr, "kernel_launch: occupancy query says %d blocks per CU\n", per_cu);
    }
    if (grid < 0) return;
    hipMemsetAsync((unsigned char*)d_ws + S_BAR, 0, 4096, stream);
    Params p{};
    for (int i = 0; i < 30; ++i) p.in[i] = (const float*)d_in[i];
    p.out = (unsigned char*)d_out; p.ws = (unsigned char*)d_ws;
    int lo = 0, hi = NPHASE;
    void* args[] = {&p, &lo, &hi};
    hipError_t e = hipLaunchCooperativeKernel((const void*)mega, dim3(grid), dim3(512), args, LDS_BYTES, stream);
    if (e != hipSuccess) fprintf(stderr, "cooperative launch failed: %s (grid %d)\n", hipGetErrorString(e), grid);
}
```

```cpp
#include <hip/hip_runtime.h>
#include <hip/hip_cooperative_groups.h>
#include <cstdio>
namespace cg = cooperative_groups;

#define LAS __attribute__((address_space(3)))
#define DI __device__ __forceinline__
typedef unsigned short bf16_t;
typedef short bf16x8 __attribute__((ext_vector_type(8)));
typedef float f32x4 __attribute__((ext_vector_type(4)));
typedef unsigned u32x4 __attribute__((ext_vector_type(4)));
typedef unsigned u32x2 __attribute__((ext_vector_type(2)));
typedef _Float16 f16x8 __attribute__((ext_vector_type(8)));
typedef __bf16 bf16x2 __attribute__((ext_vector_type(2)));

constexpr int DM = 1024, NB = 8, SEQ = 4096, CTXL = 256, NR = 34816, HR = 17408, HLAT = 16384;
constexpr int FF = 2816, EIN = 2048, DH = 512;
constexpr float ALPHA = 1.41421356237f, LNEPS = 1e-5f, KSCALE = 0.04419417382f;
constexpr size_t MiB = 1048576;
constexpr size_t O_HB = 0, O_W = 68 * MiB;
constexpr size_t W_ABIN = O_W, W_POOL = W_ABIN + 3145728, W_ABOUT = W_POOL + 524288, W_FFNIN = W_ABOUT + 2097152  ,
                 W_FFNOUT = W_FFNIN + 2 * 11534336  , W_MLIN = W_FFNOUT + 2 * 5767168, W_Q = W_MLIN + 8388608, W_K = W_Q + 2097152,
                 W_V = W_K + 2097152, W_MLOUT = W_V + 2097152, W_AQK = W_MLOUT + 4194304, W_AV = W_AQK + 65536, W_MODS = W_AV + 65536,
                 W_END = W_MODS + 442368;
static_assert(W_END <= 128 * MiB, "weights region");
constexpr size_t RS = 68 * MiB;
constexpr size_t S_UB = 0, S_R1 = RS, S_R2 = 2 * RS, S_R3 = 3 * RS, S_R4 = 4 * RS, S_R5 = 5 * RS, S_R6 = 6 * RS, S_MISC = 7 * RS;
constexpr size_t S_GATES = S_MISC, S_BAR = S_MISC + 4 * MiB, S_RS = S_MISC + 5 * MiB, S_PRE = S_MISC + 8 * MiB, S_CPA = S_MISC + 12 * MiB, S_CPB = S_MISC + 20 * MiB;
static_assert(S_CPB + 8 * MiB <= 512 * MiB, "workspace");
constexpr int PRE_V = 32 * 68 * 256;
constexpr size_t WS_NEED = S_PRE + (size_t)(PRE_V + 32 * 68 * 2) * 4;
static_assert(WS_NEED <= 512 * MiB, "workspace");

constexpr int LDS_BYTES = 160 * 1024;

struct Params {
    const float* in[30];
    unsigned char* out;
    unsigned char* ws;
};

DI unsigned cvt_pk_bf16(float lo, float hi) { unsigned r; asm("v_cvt_pk_bf16_f32 %0, %1, %2\n\ts_nop 1" : "=v"(r) : "v"(lo), "v"(hi)); return r; }
DI int opaque_tid() { int t = threadIdx.x; asm volatile("" : "+v"(t)); return t; }
#define TIDX opaque_tid()
DI unsigned cvt_pk_bf16_mfma(float lo, float hi) { unsigned r; asm volatile("s_nop 7\n\ts_nop 7\n\tv_cvt_pk_bf16_f32 %0, %1, %2\n\ts_nop 1" : "=v"(r) : "v"(lo), "v"(hi)); return r; }
DI float bf2f(unsigned short b) { return __uint_as_float(((unsigned)b) << 16); }
DI float dot2bf(unsigned a, unsigned b, float c) { return __builtin_amdgcn_fdot2_f32_bf16(__builtin_bit_cast(bf16x2, a), __builtin_bit_cast(bf16x2, b), c, false); }
DI float bflo(unsigned w) { return __uint_as_float(w << 16); }
DI float bfhi(unsigned w) { return __uint_as_float(w & 0xffff0000u); }
DI float sigmoidf_(float x) { return __builtin_amdgcn_rcpf(1.0f + __expf(-x)); }
DI float siluf_(float x) { return x * __builtin_amdgcn_rcpf(1.0f + __expf(-x)); }
DI float wave_sum(float v) {
#pragma unroll
    for (int o = 32; o >= 1; o >>= 1) v += __shfl_xor(v, o);
    return v;
}
DI float wave_max(float v) {
#pragma unroll
    for (int o = 32; o >= 1; o >>= 1) v = fmaxf(v, __shfl_xor(v, o));
    return v;
}
DI int row_bm(int R) { const int hf = R >= HR ? 1 : 0; const int r = R - hf * HR; return r < HLAT ? hf * 4 + (r >> 12) : 8; }
DI const float* row_src(const Params& p, int R) {
    const int hf = R >= HR ? 1 : 0; const int r = R - hf * HR;
    if (r < HLAT) return p.in[0] + ((size_t)(hf * 4 + (r >> 12)) * SEQ + (r & 4095)) * DM;
    const int rc = r - HLAT; return p.in[2] + ((size_t)(hf * 4 + (rc >> 8)) * CTXL + (rc & 255)) * DM;
}

DI void grid_bar(unsigned* ctr, unsigned& gen) {
    asm volatile("s_waitcnt vmcnt(0)" ::: "memory");
    __syncthreads();
    gen += 1;
    if (threadIdx.x == 0) {
        __builtin_amdgcn_fence(__ATOMIC_RELEASE, "agent");
        asm volatile("s_waitcnt vmcnt(0)" ::: "memory");
        unsigned* grp = ctr + 64 * (1 + (blockIdx.x & 7));
        const unsigned old = __hip_atomic_fetch_add(grp, 1u, __ATOMIC_RELAXED, __HIP_MEMORY_SCOPE_AGENT);
        if (old + 1u == gen * (gridDim.x >> 3)) __hip_atomic_fetch_add(ctr, 1u, __ATOMIC_RELAXED, __HIP_MEMORY_SCOPE_AGENT);
        const unsigned target = gen * 8u;
        while (__hip_atomic_load(ctr, __ATOMIC_RELAXED, __HIP_MEMORY_SCOPE_AGENT) < target) __builtin_amdgcn_s_sleep(2);
        __builtin_amdgcn_fence(__ATOMIC_ACQUIRE, "agent");
        asm volatile("s_waitcnt vmcnt(0)" ::: "memory");
    }
    __syncthreads();
}

constexpr int BM = 256, BK = 64, HALF = 128, HTB = HALF * BK * 2;
DI int lds_byte(int r, int c) { const int st = (r >> 4) * 2 + (c >> 5), rr = r & 15, cc = c & 31, ob = rr * 64 + cc * 2; return st * 1024 + (ob ^ (((ob >> 9) & 1) << 5)); }
DI void stage_rc(int b, int& R, int& C) { const int st = b / 1024, sb = b % 1024, swz = sb ^ (((sb >> 9) & 1) << 5); R = (st >> 1) * 16 + swz / 64; C = (st & 1) * 32 + (swz % 64) / 2; }
DI int perm32(int rho) { const int n = rho >> 4, i = rho & 15; return 8 * (i >> 2) + 4 * n + (i & 3); }

struct Unit { const char* a; const char* b; int pm, pn, sub; };
struct GemmCfg { unsigned a_rs, a_cs, b_rs, b_cs; int nt; };
struct Sch {
    int nM, nN, nsub, G, c;
    const char* A0; const char* B0;
    size_t a_tile, b_tile, a_sub, b_sub, a_sub2; int a_mod, b_mod;
    DI bool next(int i, Unit& u) const {
        const long L = (long)i * G + c; const int per = nM * nN, nwg = per * nsub; if (L >= nwg) return false;
        int wgid = (int)L; { const int q = nwg / 8, r = nwg % 8, xcd = wgid % 8, off = wgid / 8; wgid = (xcd < r ? xcd * (q + 1) : r * (q + 1) + (xcd - r) * q) + off; }
        const int sub = wgid / per; wgid -= sub * per;
        const int nig = 8 * nN, gid = wgid / nig, fm = gid * 8, gsz = (nM - fm) < 8 ? (nM - fm) : 8;
        u.pm = fm + ((wgid % nig) % gsz); u.pn = (wgid % nig) / gsz; u.sub = sub;
        u.a = A0 + (size_t)u.pm * a_tile + (size_t)(a_mod ? sub % a_mod : sub) * a_sub + (size_t)(a_mod ? sub / a_mod : 0) * a_sub2;
        u.b = B0 + (size_t)u.pn * b_tile + (size_t)(b_mod ? sub % b_mod : sub) * b_sub;
        return true;
    }
};

template <class Epi>
DI void gemm_phase(LAS unsigned char* lds, const GemmCfg g, const Sch& S, const Epi& E) {
    const int tid = TIDX, wid = __builtin_amdgcn_readfirstlane(tid >> 6), lane = tid & 63, wr = wid >> 2, wc = wid & 3, fr = lane & 15, fq = lane >> 4;
    const int nt = g.nt;
    unsigned voffA[2], voffB[2];
#pragma unroll
    for (int i = 0; i < 2; ++i) { int R, C; stage_rc(tid * 16 + i * 8192, R, C); const int Rb = (R & ~31) + perm32(R & 31);
        voffA[i] = (unsigned)R * g.a_rs + (unsigned)(C >> 3) * g.a_cs; voffB[i] = (unsigned)Rb * g.b_rs + (unsigned)(C >> 3) * g.b_cs; }
    const size_t kstepA = (size_t)8 * g.a_cs, kstepB = (size_t)8 * g.b_cs, hstepA = (size_t)HALF * g.a_rs, hstepB = (size_t)HALF * g.b_rs;
    const unsigned ldsw = (unsigned)wid * 1024u;
    const int aoff = lds_byte(wr * 64 + fr, fq * 8), boff = lds_byte(wc * 32 + fr, fq * 8);
#define G_SA(b, h) (((b) * 2 + (h)) * HTB)
#define G_SB(b, h) ((4 + (b) * 2 + (h)) * HTB)
#define G_STAGE(bufoff, gbase, voff) do { _Pragma("unroll") for (int _i = 0; _i < 2; ++_i) \
        __builtin_amdgcn_global_load_lds((const unsigned*)((const char*)(gbase) + (voff)[_i]), (LAS unsigned*)(lds + (bufoff) + ldsw + _i * 8192), 16, 0, 0); } while (0)
#define G_LDA(dst, b, h) do { _Pragma("unroll") for (int m = 0; m < 4; ++m) _Pragma("unroll") for (int k = 0; k < 2; ++k) dst[m][k] = *(const LAS bf16x8*)(lds + G_SA(b, h) + aoff + m * 2048 + k * 1024); } while (0)
#define G_LDB(dst, b, h) do { _Pragma("unroll") for (int n = 0; n < 2; ++n) _Pragma("unroll") for (int k = 0; k < 2; ++k) dst[n][k] = *(const LAS bf16x8*)(lds + G_SB(b, h) + boff + n * 2048 + k * 1024); } while (0)
#define G_MMA(ai, bj, At, Bt) do { __builtin_amdgcn_s_setprio(1); _Pragma("unroll") for (int m = 0; m < 4; ++m) _Pragma("unroll") for (int n = 0; n < 2; ++n) _Pragma("unroll") for (int k = 0; k < 2; ++k) \
        acc[ai][bj][m][n] = __builtin_amdgcn_mfma_f32_16x16x32_bf16(Bt[n][k], At[m][k], acc[ai][bj][m][n], 0, 0, 0); __builtin_amdgcn_s_setprio(0); } while (0)
#define G_WAIT_V(n) asm volatile("s_waitcnt vmcnt(" #n ")" ::: "memory")
#define G_WAIT_L(n) asm volatile("s_waitcnt lgkmcnt(" #n ")" ::: "memory")
#define G_BAR __builtin_amdgcn_s_barrier()
#define G_SCHED __builtin_amdgcn_sched_barrier(0)
    Unit cur, nxt; int ui = 0;
    if (!S.next(0, cur)) return;
    f32x4 acc[2][2][4][2];
#pragma unroll
    for (int a = 0; a < 2; ++a)
#pragma unroll
        for (int b = 0; b < 2; ++b)
#pragma unroll
            for (int m = 0; m < 4; ++m)
#pragma unroll
                for (int n = 0; n < 2; ++n) acc[a][b][m][n] = (f32x4){0.f, 0.f, 0.f, 0.f};
    bf16x8 At[4][2], B0[2][2], B1[2][2];
    const char* cA = cur.a; const char* cB = cur.b;
    G_STAGE(G_SB(0, 0), cB, voffB); G_STAGE(G_SA(0, 0), cA, voffA); G_STAGE(G_SB(0, 1), cB + hstepB, voffB); G_STAGE(G_SA(0, 1), cA + hstepA, voffA);
    if (wr == 1) G_BAR;
    G_WAIT_V(4); G_BAR;
    G_STAGE(G_SB(1, 0), cB + kstepB, voffB); G_STAGE(G_SA(1, 0), cA + kstepA, voffA); G_STAGE(G_SB(1, 1), cB + hstepB + kstepB, voffB);
    G_WAIT_V(6); G_BAR;
    for (;;) {
        const bool has_next = S.next(ui + 1, nxt);
        const char* nA = has_next ? nxt.a : cA; const char* nB = has_next ? nxt.b : cB;
        for (int t = 0; t < nt; t += 2) {
            const bool last = (t == nt - 2);
            const char* a1 = cA + (size_t)(t + 1) * kstepA;
            const char* a2 = last ? nA : cA + (size_t)(t + 2) * kstepA; const char* b2 = last ? nB : cB + (size_t)(t + 2) * kstepB;
            const char* a3 = a2 + kstepA; const char* b3 = b2 + kstepB;
            G_LDB(B0, 0, 0); G_SCHED; G_LDA(At, 0, 0); G_STAGE(G_SA(1, 1), a1 + hstepA, voffA);
            G_WAIT_L(8); G_BAR; G_WAIT_L(0); G_MMA(0, 0, At, B0); G_BAR; G_SCHED;
            G_LDB(B1, 0, 1); G_STAGE(G_SB(0, 0), b2, voffB);
            G_BAR; G_WAIT_L(0); G_MMA(0, 1, At, B1); G_BAR;
            G_LDA(At, 0, 1); G_STAGE(G_SA(0, 0), a2, voffA);
            G_BAR; G_WAIT_L(0); G_MMA(1, 0, At, B0); G_BAR; G_SCHED;
            G_STAGE(G_SB(0, 1), b2 + hstepB, voffB);
            G_WAIT_V(6); G_BAR; G_MMA(1, 1, At, B1); G_BAR;
            G_LDB(B0, 1, 0); G_SCHED; G_LDA(At, 1, 0); G_STAGE(G_SA(0, 1), a2 + hstepA, voffA);
            G_WAIT_L(8); G_BAR; G_WAIT_L(0); G_MMA(0, 0, At, B0); G_BAR; G_SCHED;
            G_LDB(B1, 1, 1); G_STAGE(G_SB(1, 0), b3, voffB);
            G_BAR; G_WAIT_L(0); G_MMA(0, 1, At, B1); G_BAR;
            G_LDA(At, 1, 1); G_STAGE(G_SA(1, 0), a3, voffA);
            G_BAR; G_WAIT_L(0); G_MMA(1, 0, At, B0); G_BAR; G_SCHED;
            G_STAGE(G_SB(1, 1), b3 + hstepB, voffB);
            G_WAIT_V(6); G_BAR; G_MMA(1, 1, At, B1); G_BAR;
        }
        E(acc, cur, wr, wc, fr, fq);
        if (!has_next) break;
#pragma unroll
        for (int a = 0; a < 2; ++a)
#pragma unroll
            for (int b = 0; b < 2; ++b)
#pragma unroll
                for (int m = 0; m < 4; ++m)
#pragma unroll
                    for (int n = 0; n < 2; ++n) acc[a][b][m][n] = (f32x4){0.f, 0.f, 0.f, 0.f};
        cur = nxt; cA = nA; cB = nB; ++ui;
    }
    G_WAIT_V(0);
    if (wr == 0) G_BAR;
    G_BAR;
#undef G_SA
#undef G_SB
#undef G_STAGE
#undef G_LDA
#undef G_LDB
#undef G_MMA
}

#define EPI_ARGS const f32x4 (&acc)[2][2][4][2], const Unit& u, int wr, int wc, int fr, int fq
DI u32x4 pack8(const f32x4 v0, const f32x4 v1) { u32x4 w; w.x = cvt_pk_bf16(v0[0], v0[1]); w.y = cvt_pk_bf16(v0[2], v0[3]); w.z = cvt_pk_bf16(v1[0], v1[1]); w.w = cvt_pk_bf16(v1[2], v1[3]); return w; }

struct EpiAbIn {
    bf16_t* aslab; bf16_t* glu;
    DI void operator()(EPI_ARGS) const {
        const int row0 = u.pm * BM + wr * 64 + fr;
#pragma unroll
        for (int ai = 0; ai < 2; ++ai)
#pragma unroll
            for (int m = 0; m < 4; ++m) { const int R = row0 + ai * HALF + m * 16;
                if (u.pn < 2) {
#pragma unroll
                    for (int bj = 0; bj < 2; ++bj) { const int col = u.pn * BM + bj * HALF + wc * 32 + 8 * fq;
                        *(u32x4*)(aslab + ((size_t)(col >> 3) * NR + R) * 8) = pack8(acc[ai][bj][m][0], acc[ai][bj][m][1]); }
                } else {
                    f32x4 g0, g1;
#pragma unroll
                    for (int j = 0; j < 4; ++j) { g0[j] = acc[ai][0][m][0][j] * sigmoidf_(acc[ai][1][m][0][j]); g1[j] = acc[ai][0][m][1][j] * sigmoidf_(acc[ai][1][m][1][j]); }
                    *(u32x4*)(glu + (size_t)R * 512 + (u.pn - 2) * 128 + wc * 32 + 8 * fq) = pack8(g0, g1);
                } }
    }
};
struct EpiPool {
    bf16_t* ycat; const float* pb; const float* ps;
    DI void operator()(EPI_ARGS) const {
        const int row0 = u.pm * BM + wr * 64 + fr;
#pragma unroll
        for (int bj = 0; bj < 2; ++bj) { const int col = u.pn * BM + bj * HALF + wc * 32 + 8 * fq;
            const f32x4 b0 = *(const f32x4*)(pb + col), b1 = *(const f32x4*)(pb + col + 4), s0 = *(const f32x4*)(ps + col), s1 = *(const f32x4*)(ps + col + 4);
#pragma unroll
            for (int ai = 0; ai < 2; ++ai)
#pragma unroll
                for (int m = 0; m < 4; ++m) { const int R = row0 + ai * HALF + m * 16;
                    *(u32x4*)(ycat + (size_t)R * 1024 + col) = pack8((acc[ai][bj][m][0] + b0) * s0, (acc[ai][bj][m][1] + b1) * s1); } }
    }
};
struct EpiRes {
    const _Float16* src; _Float16* dst; const float* gate; int row_sub; float* pa; float* pb;
    DI void operator()(EPI_ARGS) const {
        if (pa != nullptr) {
            float* pd = (u.sub & 1) ? pb : pa; const int prow = (u.sub >> 1) * 1024 + u.pm * BM + wr * 64 + fr;
#pragma unroll
            for (int bj = 0; bj < 2; ++bj) { const int col = u.pn * BM + bj * HALF + wc * 32 + 8 * fq;
                const f32x4 g0 = *(const f32x4*)(gate + col), g1 = *(const f32x4*)(gate + col + 4);
#pragma unroll
                for (int ai = 0; ai < 2; ++ai)
#pragma unroll
                    for (int m = 0; m < 4; ++m) { float* o = pd + (size_t)(prow + ai * HALF + m * 16) * 1024 + col;
                        *(f32x4*)o = acc[ai][bj][m][0] * g0; *(f32x4*)(o + 4) = acc[ai][bj][m][1] * g1; } }
            return; }
        const int row0 = u.sub * row_sub + u.pm * BM + wr * 64 + fr;
#pragma unroll
        for (int ai = 0; ai < 2; ++ai)
#pragma unroll
            for (int m = 0; m < 4; ++m) { const int R = row0 + ai * HALF + m * 16; const float* gp = gate + (size_t)row_bm(R) * 6144;
#pragma unroll
                for (int bj = 0; bj < 2; ++bj) { const int col = u.pn * BM + bj * HALF + wc * 32 + 8 * fq;
                    const f32x4 g0 = *(const f32x4*)(gp + col), g1 = *(const f32x4*)(gp + col + 4);
                    const f16x8 hv = *(const f16x8*)(src + (size_t)R * 1024 + col); f16x8 o;
#pragma unroll
                    for (int j = 0; j < 4; ++j) { o[j] = (_Float16)(ALPHA * (float)hv[j] + g0[j] * acc[ai][bj][m][0][j]); o[4 + j] = (_Float16)(ALPHA * (float)hv[4 + j] + g1[j] * acc[ai][bj][m][1][j]); }
                    *(f16x8*)(dst + (size_t)R * 1024 + col) = o; } }
    }
};
struct EpiFfnIn {
    bf16_t* hid; int row_sub;
    DI void operator()(EPI_ARGS) const {
        const int row0 = u.sub * row_sub + u.pm * BM + wr * 64 + fr;
#pragma unroll
        for (int ai = 0; ai < 2; ++ai)
#pragma unroll
            for (int m = 0; m < 4; ++m) { const int R = row0 + ai * HALF + m * 16; f32x4 g0, g1;
#pragma unroll
                for (int j = 0; j < 4; ++j) { g0[j] = siluf_(acc[ai][0][m][0][j]) * acc[ai][1][m][0][j]; g1[j] = siluf_(acc[ai][0][m][1][j]) * acc[ai][1][m][1][j]; }
                *(u32x4*)(hid + (size_t)R * FF + u.pn * 128 + wc * 32 + 8 * fq) = pack8(g0, g1); }
    }
};
struct EpiPlain {
    bf16_t* out; int ld;
    DI void operator()(EPI_ARGS) const {
        const int row0 = u.pm * BM + wr * 64 + fr;
#pragma unroll
        for (int ai = 0; ai < 2; ++ai)
#pragma unroll
            for (int m = 0; m < 4; ++m) { const int R = row0 + ai * HALF + m * 16;
#pragma unroll
                for (int bj = 0; bj < 2; ++bj) { const int col = u.pn * BM + bj * HALF + wc * 32 + 8 * fq;
                    *(u32x4*)(out + (size_t)R * ld + col) = pack8(acc[ai][bj][m][0], acc[ai][bj][m][1]); } }
    }
};
struct EpiQK {
    bf16_t* q; bf16_t* k;
    DI void operator()(EPI_ARGS) const {
        const int which = u.sub >> 2, h = u.sub & 3; bf16_t* dst = which ? k : q; const float sc = which ? KSCALE : 1.0f;
        const int row0 = u.pm * BM + wr * 64 + fr;
#pragma unroll
        for (int ai = 0; ai < 2; ++ai)
#pragma unroll
            for (int m = 0; m < 4; ++m) { const int r = row0 + ai * HALF + m * 16; bf16_t* rp = dst + (((size_t)(r >> 6) * 4 + h) * 64 + (r & 63)) * 512;
#pragma unroll
                for (int bj = 0; bj < 2; ++bj) { const int col = u.pn * BM + bj * HALF + wc * 32 + 8 * fq;
                    *(u32x4*)(rp + col) = pack8(acc[ai][bj][m][0] * sc, acc[ai][bj][m][1] * sc); } }
    }
};
struct EpiVT {
    bf16_t* vt;
    DI void operator()(EPI_ARGS) const {
        const int h = u.sub; const int row0 = u.pm * BM + wr * 64 + fr;
#pragma unroll
        for (int ai = 0; ai < 2; ++ai)
#pragma unroll
            for (int m = 0; m < 4; ++m) { const int dv = row0 + ai * HALF + m * 16;
#pragma unroll
                for (int bj = 0; bj < 2; ++bj) { const int r = u.pn * BM + bj * HALF + wc * 32 + 8 * fq;
                    *(u32x4*)(vt + (((size_t)(r >> 6) * 4 + h) * 512 + dv) * 64 + (r & 63)) = pack8(acc[ai][bj][m][0], acc[ai][bj][m][1]); } }
    }
};

struct TJob { const float* src; bf16_t* dst; int K, N, sld, dld, map, ntile; };
DI int srccol(int map, int n) {
    if (map == 1) { if (n < 512) return n; const int j = (n - 512) >> 8, w = (n - 512) & 255; return w < 128 ? 512 + 128 * j + w : 1024 + 128 * j + (w - 128); }
    if (map == 2) { const int j = n >> 8, w = n & 255; return w < 128 ? 128 * j + w : FF + 128 * j + (w - 128); }
    return n;
}
constexpr int NJOB = 24;
DI TJob get_job(const Params& p, int j) {
    TJob t; bf16_t* W = (bf16_t*)p.out; t.map = 0;
    if (j == 0) { t.src = p.in[8]; t.dst = (bf16_t*)(p.out + W_ABIN); t.K = 1024; t.N = 1536; t.sld = 1536; t.dld = 1024; t.map = 1; }
    else if (j == 1) { t.src = p.in[16]; t.dst = (bf16_t*)(p.out + W_ABOUT); t.K = 1024; t.N = 1024; t.sld = 1024; t.dld = 1024; }
    else if (j < 4) { const int l = j - 2; t.src = p.in[28] + (size_t)l * 1024 * 5632; t.dst = (bf16_t*)(p.out + W_FFNIN + (size_t)l * 11534336); t.K = 1024; t.N = 5632; t.sld = 5632; t.dld = 1024; t.map = 2; }
    else if (j < 6) { const int l = j - 4; t.src = p.in[29] + (size_t)l * FF * 1024; t.dst = (bf16_t*)(p.out + W_FFNOUT + (size_t)l * 5767168); t.K = FF; t.N = 1024; t.sld = 1024; t.dld = FF; }
    else if (j == 6) { t.src = p.in[17]; t.dst = (bf16_t*)(p.out + W_MLIN); t.K = 1024; t.N = 4096; t.sld = 4096; t.dld = 1024; }
    else if (j < 19) { const int w = (j - 7) >> 2, h = (j - 7) & 3; t.src = p.in[w == 0 ? 20 : (w == 1 ? 21 : 22)] + (size_t)h * 512 * 512; t.dst = (bf16_t*)(p.out + W_Q + (size_t)w * 2097152) + (size_t)h * 512 * 512; t.K = 512; t.N = 512; t.sld = 512; t.dld = 512; }
    else if (j == 19) { t.src = p.in[27]; t.dst = (bf16_t*)(p.out + W_MLOUT); t.K = 2048; t.N = 1024; t.sld = 1024; t.dld = 2048; }
    else { const int g = j - 20; t.src = p.in[9] + (size_t)g * 128 * 128; t.dst = (bf16_t*)(p.out + W_POOL) + (size_t)g * 128 * 512 + g * 128; t.K = 128; t.N = 128; t.sld = 128; t.dld = 512; }
    (void)W; t.ntile = (t.K / 64) * (t.N / 64); return t;
}
__device__ void phase_prep(const Params& p, LAS unsigned char* lds) {
    const int tid = TIDX, G = 256;
    LAS float* tile = (LAS float*)lds;
    int base = 0;
    for (int j = 0; j < NJOB; ++j) {
        const TJob t = get_job(p, j); const int nkt = t.K / 64;
        for (int ti = blockIdx.x - base; ti < t.ntile; ti += G) { if (ti < 0) continue;
            const int kt = ti % nkt, nt_ = ti / nkt, k0 = kt * 64, n0 = nt_ * 64, sc0 = srccol(t.map, n0);
            const int i = tid >> 6, jj = tid & 63;
#pragma unroll
            for (int rr = 0; rr < 8; ++rr) tile[(i * 8 + rr) * 65 + jj] = t.src[(size_t)(k0 + i * 8 + rr) * t.sld + sc0 + jj];
            __syncthreads();
#pragma unroll
            for (int rr = 0; rr < 8; ++rr) { const int n = i * 8 + rr; t.dst[(size_t)(n0 + n) * t.dld + k0 + jj] = (bf16_t)(cvt_pk_bf16(tile[jj * 65 + n], 0.f) & 0xffffu); }
            __syncthreads();
        }
        base += t.ntile; while (base >= G) base -= G;
    }
    { bf16_t* wp = (bf16_t*)(p.out + W_POOL);
      for (int i = blockIdx.x * 512 + tid; i < 512 * 512; i += G * 512) { const int n = i >> 9, k = i & 511; if ((n >> 7) != (k >> 7)) wp[i] = 0; } }
    { LAS float* sc = (LAS float*)lds;
      LAS float* red = (LAS float*)(lds + 9 * 1024 * 4);
      __syncthreads();
      for (int i = tid; i < 9 * 1024; i += 512) { const float v = i < 8192 ? p.in[1][i] : p.in[3][i - 8192]; sc[i] = siluf_(v); }
      __syncthreads();
      float* mods = (float*)(p.out + W_MODS);
      for (int job = blockIdx.x; job < 96; job += G) {
          const int l = job / 48, nb = job % 48, col = nb * 128 + (tid & 127), kq = tid >> 7;
          const float* w = p.in[4] + (size_t)l * 1024 * 6144 + col;
          float a[9];
#pragma unroll
          for (int b = 0; b < 9; ++b) a[b] = 0.f;
#pragma unroll 4
          for (int k = kq * 256; k < kq * 256 + 256; ++k) { const float wv = __builtin_nontemporal_load(w + (size_t)k * 6144);
#pragma unroll
              for (int b = 0; b < 9; ++b) a[b] += sc[b * 1024 + k] * wv; }
#pragma unroll
          for (int b = 0; b < 9; ++b) red[(kq * 9 + b) * 128 + (tid & 127)] = a[b];
          __syncthreads();
          for (int i = tid; i < 9 * 128; i += 512) { const int b = i >> 7, c = i & 127;
              mods[((size_t)l * 9 + b) * 6144 + nb * 128 + c] = red[(0 * 9 + b) * 128 + c] + red[(1 * 9 + b) * 128 + c] + red[(2 * 9 + b) * 128 + c] + red[(3 * 9 + b) * 128 + c] + p.in[5][(size_t)l * 6144 + nb * 128 + c]; }
          __syncthreads();
      } }
    { const int wave = (blockIdx.x * 512 + tid) >> 6, lane = tid & 63, nw = G * 8;
      bf16_t* aqk = (bf16_t*)(p.out + W_AQK); bf16_t* av = (bf16_t*)(p.out + W_AV);
      for (int job = wave; job < 4096; job += nw) {
          const int isv = job >> 11, hc = job & 2047, h = hc >> 9, c = hc & 511;
          float a[16];
#pragma unroll
          for (int g = 0; g < 16; ++g) a[g] = 0.f;
          const int npass = isv ? 1 : 2;
          for (int ps = 0; ps < npass; ++ps) {
              const int which = isv ? 2 : ps;
              const float* wrow = p.in[which == 0 ? 20 : (which == 1 ? 21 : 22)] + ((size_t)h * 512 + c) * 512 + lane * 8;
#pragma unroll
              for (int e = 0; e < 8; ++e) { const float wv = wrow[e]; const int ef = h * 512 + lane * 8 + e;
#pragma unroll
                  for (int z = 0; z < 2; ++z) { const float* gp = p.in[23] + (((size_t)z * 3 + which) * 2048 + ef) * 8;
#pragma unroll
                      for (int jx = 0; jx < 8; ++jx) a[z * 8 + jx] += wv * gp[jx]; } }
          }
#pragma unroll
          for (int g = 0; g < 16; ++g) { const float s = wave_sum(a[g]); if (lane == g) (isv ? av : aqk)[(size_t)g * 2048 + hc] = (bf16_t)(cvt_pk_bf16(s, 0.f) & 0xffffu); }
      } }
}

__device__ void phase_embed(const Params& p) {
    const int tid_ = TIDX; const int wave = (blockIdx.x * 512 + tid_) >> 6, lane = tid_ & 63, nw = 2048;
    const float* mods = (const float*)(p.out + W_MODS); _Float16* hb = (_Float16*)(p.out + O_HB); bf16_t* ub = (bf16_t*)(p.ws + S_UB);
    for (int R = wave; R < NR; R += nw) {
        const float* src = row_src(p, R); const float* mp = mods + (size_t)row_bm(R) * 6144;
#pragma unroll
        for (int i = 0; i < 2; ++i) { const int c = lane * 8 + i * 512;
            const f32x4 x0 = *(const f32x4*)(src + c), x1 = *(const f32x4*)(src + c + 4);
            const f32x4 sh0 = *(const f32x4*)(mp + c), sh1 = *(const f32x4*)(mp + c + 4), sc0 = *(const f32x4*)(mp + 1024 + c), sc1 = *(const f32x4*)(mp + 1024 + c + 4);
            f16x8 hv;
#pragma unroll
            for (int j = 0; j < 4; ++j) { hv[j] = (_Float16)x0[j]; hv[4 + j] = (_Float16)x1[j]; }
            *(f16x8*)(hb + (size_t)R * 1024 + c) = hv;
            *(u32x4*)(ub + (size_t)R * 1024 + c) = pack8(x0 * (sc0 + 1.0f) + sh0, x1 * (sc1 + 1.0f) + sh1); }
    }
}
__device__ void phase_ln(const Params& p, const _Float16* tsrc, int l, int which, int mod_l, int mod_idx, int mode, float probe_b = 0.f, const float* cpa = nullptr, const float* cpb = nullptr) {
    const int tid_ = TIDX; const int wave = (blockIdx.x * 512 + tid_) >> 6, lane = tid_ & 63, nw = 2048;
    const float* mods = (const float*)(p.out + W_MODS) + (size_t)(mod_l < 0 ? 0 : mod_l) * 9 * 6144; _Float16* hb = (_Float16*)(p.out + O_HB); bf16_t* ub = (bf16_t*)(p.ws + S_UB);
    const float* lg = p.in[6] + ((size_t)l * 2 + which) * 1024; const float* lb = p.in[7] + ((size_t)l * 2 + which) * 1024;
    f16x8 n0 = *(const f16x8*)(tsrc + (size_t)wave * 1024 + lane * 8), n1 = *(const f16x8*)(tsrc + (size_t)wave * 1024 + 512 + lane * 8);
    for (int R = wave; R < NR; R += nw) {
        const f16x8 t0 = n0, t1 = n1;
        if (R + nw < NR) { n0 = *(const f16x8*)(tsrc + (size_t)(R + nw) * 1024 + lane * 8); n1 = *(const f16x8*)(tsrc + (size_t)(R + nw) * 1024 + 512 + lane * 8); }
        const int hf = R >= HR ? 1 : 0, r = R - hf * HR; if (mode != 0 && r >= HLAT) continue;
        float x[16]; float s = 0.f;
#pragma unroll
        for (int j = 0; j < 8; ++j) { x[j] = (float)t0[j]; x[8 + j] = (float)t1[j]; }
        if (cpa != nullptr && r >= HLAT) {
            const size_t o = (size_t)(hf * 1024 + (r - HLAT)) * 1024 + lane * 8;
#pragma unroll
            for (int i = 0; i < 2; ++i) { const f32x4 a0 = *(const f32x4*)(cpa + o + i * 512), a1 = *(const f32x4*)(cpa + o + i * 512 + 4), b0 = *(const f32x4*)(cpb + o + i * 512), b1 = *(const f32x4*)(cpb + o + i * 512 + 4);
#pragma unroll
                for (int j = 0; j < 4; ++j) { x[i * 8 + j] = ALPHA * x[i * 8 + j] + (a0[j] + b0[j]); x[i * 8 + 4 + j] = ALPHA * x[i * 8 + 4 + j] + (a1[j] + b1[j]); } } }
#pragma unroll
        for (int j = 0; j < 16; ++j) s += x[j];
        const float mu = wave_sum(s) * (1.0f / 1024.0f); float q = 0.f;
#pragma unroll
        for (int j = 0; j < 16; ++j) { x[j] -= mu; q += x[j] * x[j]; }
        const float rstd = rsqrtf(wave_sum(q) * (1.0f / 1024.0f) + LNEPS);
        const float* mp = mods + (size_t)row_bm(R) * 6144;
#pragma unroll
        for (int i = 0; i < 2; ++i) { const int c = lane * 8 + i * 512;
            const f32x4 g0 = *(const f32x4*)(lg + c), g1 = *(const f32x4*)(lg + c + 4), b0 = *(const f32x4*)(lb + c), b1 = *(const f32x4*)(lb + c + 4);
            f32x4 h0, h1;
#pragma unroll
            for (int j = 0; j < 4; ++j) { h0[j] = x[i * 8 + j] * rstd * g0[j] + b0[j]; h1[j] = x[i * 8 + 4 + j] * rstd * g1[j] + b1[j]; }
            if (mode == 2) {
#ifdef PROBE
                if (hf == 1) { h0 += probe_b; h1 += probe_b; }
#endif
                float* o = (float*)p.out + ((size_t)(hf * 4 + (r >> 12)) * SEQ + (r & 4095)) * DM + c;
                *(f32x4*)o = h0; *(f32x4*)(o + 4) = h1;
            } else {
                f16x8 hv;
#pragma unroll
                for (int j = 0; j < 4; ++j) { hv[j] = (_Float16)h0[j]; hv[4 + j] = (_Float16)h1[j]; }
                *(f16x8*)(hb + (size_t)R * 1024 + c) = hv;
                const f32x4 sh0 = *(const f32x4*)(mp + mod_idx * 1024 + c), sh1 = *(const f32x4*)(mp + mod_idx * 1024 + c + 4);
                const f32x4 sc0 = *(const f32x4*)(mp + (mod_idx + 1) * 1024 + c), sc1 = *(const f32x4*)(mp + (mod_idx + 1) * 1024 + c + 4);
                *(u32x4*)(ub + (size_t)R * 1024 + c) = pack8(h0 * (sc0 + 1.0f) + sh0, h1 * (sc1 + 1.0f) + sh1);
            } }
    }
}

template <int W>
DI void box64(const float (&v)[64], LAS float* dst, int stride) {
#pragma unroll
    for (int t = 0; t < 64; ++t) { const int lo = t - W / 2 < 0 ? 0 : t - W / 2, hi = t + W - W / 2 > 64 ? 64 : t + W - W / 2; float s = 0.f;
#pragma unroll
        for (int j = lo; j < hi; ++j) s += v[j];
        dst[t * stride] = s * (1.0f / (float)(hi - lo)); }
}
template <int W>
DI void pool_lat_item(bf16_t* slab  , LAS float* buf) {
    const int tid = TIDX;
#pragma unroll
    for (int i = 0; i < 8; ++i) { const int t = tid + i * 512; const u32x4 w = *(const u32x4*)(slab + (size_t)t * 8); LAS float* d = buf + t * 8 + (t >> 6) * 8;
        *(LAS f32x4*)d = (f32x4){bflo(w.x), bfhi(w.x), bflo(w.y), bfhi(w.y)}; *(LAS f32x4*)(d + 4) = (f32x4){bflo(w.z), bfhi(w.z), bflo(w.w), bfhi(w.w)}; }
    __syncthreads();
    { const int c = tid >> 3, ch = tid & 7; float v[64];
#pragma unroll
      for (int r = 0; r < 64; ++r) v[r] = buf[r * 520 + c * 8 + ch];
      box64<W>(v, buf + c * 8 + ch, 520); }
    __syncthreads();
    { const int r = tid >> 3, ch = tid & 7; float v[64];
#pragma unroll
      for (int c = 0; c < 64; ++c) v[c] = buf[r * 520 + c * 8 + ch];
      box64<W>(v, buf + r * 520 + ch, 8); }
    __syncthreads();
#pragma unroll
    for (int i = 0; i < 8; ++i) { const int t = tid + i * 512; const u32x4 w = *(const u32x4*)(slab + (size_t)t * 8); const LAS float* d = buf + t * 8 + (t >> 6) * 8;
        const f32x4 p0 = *(const LAS f32x4*)d, p1 = *(const LAS f32x4*)(d + 4);
        const f32x4 s0 = (f32x4){bflo(w.x), bfhi(w.x), bflo(w.y), bfhi(w.y)}, s1 = (f32x4){bflo(w.z), bfhi(w.z), bflo(w.w), bfhi(w.w)};
        *(u32x4*)(slab + (size_t)t * 8) = pack8(p0 - s0, p1 - s1); }
    __syncthreads();
}
__device__ void phase_poolconv(const Params& p, LAS unsigned char* lds) {
    const int tid = TIDX, G = 256;
    bf16_t* aslab = (bf16_t*)(p.ws + S_R1); const bf16_t* glu = (const bf16_t*)(p.ws + S_R1 + 34 * MiB); bf16_t* ycat = (bf16_t*)(p.ws + S_R2);
    const int NPL = 512, NCV = 1088, NPC = 512;
    for (int it = blockIdx.x; it < NPL + NCV + NPC; it += G) {
        if (it < NPL) {
            const int b = it >> 6, sl = it & 63; const int R0 = (b >> 2) * HR + (b & 3) * SEQ;
            bf16_t* slab = aslab + ((size_t)sl * NR + R0) * 8; LAS float* buf = (LAS float*)lds;
            const int gi = sl >> 4;
            if (gi == 0) pool_lat_item<2>(slab, buf); else if (gi == 1) pool_lat_item<4>(slab, buf); else if (gi == 2) pool_lat_item<8>(slab, buf); else pool_lat_item<16>(slab, buf);
        } else if (it < NPL + NCV) {
            const int ci = it - NPL; int R0, len, t0;
            if (ci < 1024) { const int b = ci >> 7; R0 = (b >> 2) * HR + (b & 3) * SEQ; len = SEQ; t0 = (ci & 127) * 32; }
            else { const int cj = ci - 1024, b = cj >> 3; R0 = (b >> 2) * HR + HLAT + (b & 3) * CTXL; len = CTXL; t0 = (cj & 7) * 32; }
            LAS unsigned* gin = (LAS unsigned*)lds;
            LAS float* cout = (LAS float*)(lds + 62 * 1024);
            for (int i = tid; i < 62 * 64; i += 512) { const int rr = i >> 6, cc = i & 63, t = t0 - 15 + rr;
                u32x4 w = (u32x4){0u, 0u, 0u, 0u}; if (t >= 0 && t < len) w = *(const u32x4*)(glu + (size_t)(R0 + t) * 512 + cc * 8);
                *(LAS u32x4*)(gin + rr * 256 + cc * 4) = w; }
            __syncthreads();
            { const float* cw = p.in[12] + tid; float w[31];
#pragma unroll
              for (int j = 0; j < 31; ++j) w[j] = cw[j * 512];
              float a[32]; const float cb0 = p.in[13][tid];
#pragma unroll
              for (int t = 0; t < 32; ++t) a[t] = cb0;
              const LAS unsigned short* gs = (const LAS unsigned short*)gin + tid;
#pragma unroll
              for (int rr = 0; rr < 62; ++rr) { const float x = bf2f(gs[rr * 512]);
#pragma unroll
                  for (int t = 0; t < 32; ++t) { const int j = rr - t; if (j >= 0 && j < 31) a[t] += w[j] * x; } }
#pragma unroll
              for (int t = 0; t < 32; ++t) cout[t * 512 + tid] = a[t]; }
            __syncthreads();
            { const int wv = tid >> 6, lane = tid & 63;
              for (int tt = 0; tt < 4; ++tt) { const int t = wv * 4 + tt; const LAS float* rp = cout + t * 512 + lane * 8;
                  const f32x4 v0 = *(const LAS f32x4*)rp, v1 = *(const LAS f32x4*)(rp + 4);
                  float s = (v0[0] + v0[1]) + (v0[2] + v0[3]) + (v1[0] + v1[1]) + (v1[2] + v1[3]);
                  const float mu = wave_sum(s) * (1.0f / 512.0f); const f32x4 d0 = v0 - mu, d1 = v1 - mu;
                  float q = d0[0] * d0[0] + d0[1] * d0[1] + d0[2] * d0[2] + d0[3] * d0[3] + d1[0] * d1[0] + d1[1] * d1[1] + d1[2] * d1[2] + d1[3] * d1[3];
                  const float rstd = rsqrtf(wave_sum(q) * (1.0f / 512.0f) + LNEPS);
                  const float* ng = p.in[14] + lane * 8; const float* nb = p.in[15] + lane * 8; f32x4 y0, y1;
#pragma unroll
                  for (int j = 0; j < 4; ++j) { y0[j] = siluf_(d0[j] * rstd * ng[j] + nb[j]); y1[j] = siluf_(d1[j] * rstd * ng[4 + j] + nb[4 + j]); }
                  *(u32x4*)(ycat + (size_t)(R0 + t0 + t) * 1024 + 512 + lane * 8) = pack8(y0, y1); } }
            __syncthreads();
        } else {
            const int pi = it - NPL - NCV, b = pi >> 6, sl = pi & 63; const int R0 = (b >> 2) * HR + HLAT + (b & 3) * CTXL; const int W = 2 << (sl >> 4);
            bf16_t* slab = aslab + ((size_t)sl * NR + R0) * 8; LAS float* buf = (LAS float*)lds;
            if (tid < 256) { const u32x4 w = *(const u32x4*)(slab + (size_t)tid * 8);
                *(LAS f32x4*)(buf + tid * 8) = (f32x4){bflo(w.x), bfhi(w.x), bflo(w.y), bfhi(w.y)}; *(LAS f32x4*)(buf + tid * 8 + 4) = (f32x4){bflo(w.z), bfhi(w.z), bflo(w.w), bfhi(w.w)}; }
            __syncthreads();
            f32x4 d = (f32x4){0.f, 0.f, 0.f, 0.f}; const int t = tid >> 1, hc = (tid & 1) * 4;
            { const int lo = t - W / 2 < 0 ? 0 : t - W / 2, hi = t + W - W / 2 > 256 ? 256 : t + W - W / 2; f32x4 s = (f32x4){0.f, 0.f, 0.f, 0.f};
              for (int j = lo; j < hi; ++j) s += *(const LAS f32x4*)(buf + j * 8 + hc);
              d = s * (1.0f / (float)(hi - lo)) - *(const LAS f32x4*)(buf + t * 8 + hc); }
            u32x2 o; o.x = cvt_pk_bf16(d[0], d[1]); o.y = cvt_pk_bf16(d[2], d[3]);
            *(u32x2*)(slab + (size_t)t * 8 + hc) = o;
            __syncthreads();
        }
    }
}

__device__ void phase_mlconv(const Params& p, int hf) {
    const int tid_ = TIDX; const int wave = (blockIdx.x * 512 + tid_) >> 6, lane = tid_ & 63, nw = 2048, tk = lane & 15, g = lane >> 4;
    const bf16_t* xm = (const bf16_t*)(p.ws + S_R1); bf16_t* xc = (bf16_t*)(p.ws + S_R2); float* gates = (float*)(p.ws + S_GATES);
    const bf16_t* aqk = (const bf16_t*)(p.out + W_AQK); const bf16_t* av = (const bf16_t*)(p.out + W_AV);
    const float* cw = p.in[18]; const float* cb = p.in[19];
    (void)wave; (void)nw;
    for (int it = (tid_ >> 6) * 256 + (int)blockIdx.x; it < HR / 16; it += 2048) {
        const int r = it * 16 + tk; const int pos = r < HLAT ? (r & 4095) : ((r - HLAT) & 255), len = r < HLAT ? SEQ : CTXL;
        const bool hasp = pos > 0, hasn = pos < len - 1;
        f32x4 acc = (f32x4){0.f, 0.f, 0.f, 0.f};
#pragma unroll 2
        for (int ks = 0; ks < 64; ++ks) { const int c0 = ks * 32 + g * 8;
            const u32x4 z4 = (u32x4){0u, 0u, 0u, 0u};
            const u32x4 wc_ = *(const u32x4*)(xm + (size_t)r * 2048 + c0);
            const u32x4 wp = hasp ? *(const u32x4*)(xm + (size_t)(r - 1) * 2048 + c0) : z4;
            const u32x4 wn = hasn ? *(const u32x4*)(xm + (size_t)(r + 1) * 2048 + c0) : z4;
            float o[8];
            float w0v[8], w1v[8], w2v[8], bbv[8];
            { const f32x4 a0 = *(const f32x4*)(cw + c0), a1 = *(const f32x4*)(cw + c0 + 4), b0 = *(const f32x4*)(cw + 2048 + c0), b1 = *(const f32x4*)(cw + 2048 + c0 + 4);
              const f32x4 c0v = *(const f32x4*)(cw + 4096 + c0), c1v = *(const f32x4*)(cw + 4096 + c0 + 4), d0 = *(const f32x4*)(cb + c0), d1 = *(const f32x4*)(cb + c0 + 4);
#pragma unroll
              for (int e = 0; e < 4; ++e) { w0v[e] = a0[e]; w0v[4 + e] = a1[e]; w1v[e] = b0[e]; w1v[4 + e] = b1[e]; w2v[e] = c0v[e]; w2v[4 + e] = c1v[e]; bbv[e] = d0[e]; bbv[4 + e] = d1[e]; } }
#pragma unroll
            for (int j = 0; j < 4; ++j) { const unsigned a = wp[j], b = wc_[j], c = wn[j];
                o[2 * j] = siluf_(w0v[2 * j] * bflo(a) + w1v[2 * j] * bflo(b) + w2v[2 * j] * bflo(c) + bbv[2 * j]);
                o[2 * j + 1] = siluf_(w0v[2 * j + 1] * bfhi(a) + w1v[2 * j + 1] * bfhi(b) + w2v[2 * j + 1] * bfhi(c) + bbv[2 * j + 1]); }
            u32x4 xo; xo.x = cvt_pk_bf16(o[0], o[1]); xo.y = cvt_pk_bf16(o[2], o[3]); xo.z = cvt_pk_bf16(o[4], o[5]); xo.w = cvt_pk_bf16(o[6], o[7]);
            *(u32x4*)(xc + (size_t)r * 2048 + c0) = xo;
            const bf16x8 bq = *(const bf16x8*)(aqk + (size_t)tk * 2048 + c0), bv = *(const bf16x8*)(av + (size_t)tk * 2048 + c0);
            acc = __builtin_amdgcn_mfma_f32_16x16x32_bf16(__builtin_bit_cast(bf16x8, xo), bq, acc, 0, 0, 0);
            acc = __builtin_amdgcn_mfma_f32_16x16x32_bf16(__builtin_bit_cast(bf16x8, wc_), bv, acc, 0, 0, 0); }
        const float bg = p.in[24][tk];
#pragma unroll
        for (int i = 0; i < 4; ++i) { float v = acc[i] + bg; if ((tk & 7) >= 4) v = fminf(v, 0.f) - log1pf(__expf(-fabsf(v)));
            gates[((size_t)hf * HR + it * 16 + 4 * g + i) * 16 + tk] = v; }
    }
}

__device__ void phase_mlout(const Params& p) {
    const int tid_ = TIDX; const int wave = (blockIdx.x * 512 + tid_) >> 6, lane = tid_ & 63, nw = 2048;
    const bf16_t* hfw = (const bf16_t*)(p.ws + S_R1); const bf16_t* hbw = (const bf16_t*)(p.ws + S_R6); bf16_t* xc = (bf16_t*)(p.ws + S_R2); const bf16_t* z = (const bf16_t*)(p.ws + S_R3);
    const float* ng = p.in[25]; const float* sk = p.in[26];
    for (int r = wave; r < HLAT; r += nw) {
#pragma unroll
        for (int hh = 0; hh < 4; ++hh) { const int c = hh * 512 + lane * 8; const size_t o = (size_t)r * 2048 + c;
            const u32x4 a = *(const u32x4*)(hfw + o), b = *(const u32x4*)(hbw + o), xw = *(const u32x4*)(xc + o), zw = *(const u32x4*)(z + o);
            float x[8]; float s = 0.f;
#pragma unroll
            for (int j = 0; j < 4; ++j) { x[2 * j] = bflo(a[j]) + bflo(b[j]); x[2 * j + 1] = bfhi(a[j]) + bfhi(b[j]); s += x[2 * j] + x[2 * j + 1]; }
            const float mu = wave_sum(s) * (1.0f / 512.0f); float q = 0.f;
#pragma unroll
            for (int j = 0; j < 8; ++j) { x[j] -= mu; q += x[j] * x[j]; }
            const float rstd = rsqrtf(wave_sum(q) * (1.0f / 512.0f) + LNEPS);
            float y[8];
#pragma unroll
            for (int j = 0; j < 4; ++j) {
                y[2 * j] = (x[2 * j] * rstd * ng[c + 2 * j] + sk[c + 2 * j] * bflo(xw[j])) * siluf_(bflo(zw[j]));
                y[2 * j + 1] = (x[2 * j + 1] * rstd * ng[c + 2 * j + 1] + sk[c + 2 * j + 1] * bfhi(xw[j])) * siluf_(bfhi(zw[j])); }
            u32x4 w; w.x = cvt_pk_bf16(y[0], y[1]); w.y = cvt_pk_bf16(y[2], y[3]); w.z = cvt_pk_bf16(y[4], y[5]); w.w = cvt_pk_bf16(y[6], y[7]);
            *(u32x4*)(xc + o) = w; }
    }
}

constexpr int QS_STRIDE = 1040, KT_STRIDE = 144, PS_STRIDE = 144;
constexpr int L_QS = 0, L_KT = 64 * QS_STRIDE  , L_PS = L_KT + 512 * KT_STRIDE  , PS_HALF = 64 * PS_STRIDE  , L_VEC = L_PS + 2 * PS_HALF  ;
static_assert(L_VEC + 3840 <= LDS_BYTES, "scan LDS");
#define LDS_BAR() asm volatile("s_waitcnt lgkmcnt(0)\n\ts_barrier" ::: "memory")
struct ScanPos { int chunk, rowbase; bool isctx; };
DI ScanPos scan_pos(int step, int dir, int bl) {
    ScanPos sp; sp.isctx = step < 4; const int ci = sp.isctx ? step : step - 4, nchunk = sp.isctx ? 4 : 64;
    const int cn = dir ? nchunk - 1 - ci : ci;
    sp.chunk = sp.isctx ? 256 + bl * 4 + cn : bl * 64 + cn;
    sp.rowbase = sp.isctx ? HLAT + bl * CTXL + cn * 64 : bl * SEQ + cn * 64;
    return sp;
}
__device__ void phase_pre(const Params& p, int hf) {
    const int tid_ = TIDX; const int wave = (blockIdx.x * 512 + tid_) >> 6, lane = tid_ & 63;
    const float* gates = (const float*)(p.ws + S_GATES) + (size_t)hf * HR * 16; float* pre = (float*)(p.ws + S_PRE);
    for (int job = wave; job < 32 * 68; job += 2048) { const int combo = job / 68, c = job - combo * 68, dir = combo & 1, h = (combo >> 1) & 3, bl = combo >> 3;
        const ScanPos sp = scan_pos(c, dir, bl); const int pp = dir ? 63 - lane : lane;
        const float ic = gates[(size_t)(sp.rowbase + pp) * 16 + dir * 8 + h], fc = gates[(size_t)(sp.rowbase + pp) * 16 + dir * 8 + 4 + h];
        float bcs = fc;
#pragma unroll
        for (int o = 1; o < 64; o <<= 1) { const float t = __shfl_up(bcs, o); if (lane >= o) bcs += t; }
        const float blast = __shfl(bcs, 63); const float mw = wave_max(blast - bcs + ic);
        float cm = ic - bcs;
#pragma unroll
        for (int o = 1; o < 64; o <<= 1) { const float t = __shfl_up(cm, o); if (lane >= o) cm = fmaxf(cm, t); }
        *(f32x4*)(pre + ((size_t)job * 64 + lane) * 4) = (f32x4){bcs, cm, ic, 0.f};
        if (lane == 0) { pre[PRE_V + job * 2] = blast; pre[PRE_V + job * 2 + 1] = mw; } }
}
__device__ void phase_intra(const Params& p, LAS unsigned char* lds) {
    const int tid = TIDX, wid = __builtin_amdgcn_readfirstlane(tid >> 6), lane = tid & 63, tk = lane & 15, g = lane >> 4;
    const bf16_t* qc = (const bf16_t*)(p.ws + S_R3); const bf16_t* kc = (const bf16_t*)(p.ws + S_R4); const bf16_t* vtc = (const bf16_t*)(p.ws + S_R5);
    const float* pre = (const float*)(p.ws + S_PRE); float* RS = (float*)(p.ws + S_RS);
    LAS float* A_ = (LAS float*)(lds + 2 * PS_HALF);
    LAS float* M_ = A_ + 128; LAS float* rsl = A_ + 256;
    for (int item = blockIdx.x; item < 1024; item += 256) {
        const int bl = item >> 8, h = (item >> 6) & 3, cn = item & 63; const int chunk = bl * 64 + cn, rowbase = bl * SEQ + cn * 64;
        if (wid < 2) { const int d = wid, combo = d + 2 * h + 8 * bl, kq = d ? 63 - cn : cn;
            const float* sc = pre + PRE_V + (size_t)combo * 68 * 2;
            float m4 = 0.f;
#pragma unroll
            for (int k = 0; k < 4; ++k) m4 = fmaxf(sc[k * 2] + m4, sc[k * 2 + 1]);
            float B = sc[(4 + lane) * 2], W = sc[(4 + lane) * 2 + 1];
#pragma unroll
            for (int o = 1; o < 64; o <<= 1) { const float Bp = __shfl_up(B, o), Wp = __shfl_up(W, o); if (lane >= o) { W = fmaxf(Wp + B, W); B = Bp + B; } }
            const float mafter = fmaxf(m4 + B, W); const float mprev = __shfl(mafter, kq > 0 ? kq - 1 : 0); const float mstart = kq > 0 ? mprev : m4;
            const f32x4 pv = *(const f32x4*)(pre + (((size_t)combo * 68 + 4 + kq) * 64 + lane) * 4); const int pp = d ? 63 - lane : lane;
            A_[d * 64 + pp] = pv[2] - pv[0]; M_[d * 64 + pp] = fmaxf(mstart, pv[1]); rsl[d * 64 + lane] = 0.f; }
        __syncthreads();
        {
            const int st = wid >> 1, tt0 = 2 * (wid & 1); f32x4 S0 = (f32x4){0.f, 0.f, 0.f, 0.f}, S1 = S0;
            const bf16_t* ka = kc + ((size_t)chunk * 4 + h) * 64 * 512 + (size_t)(st * 16 + tk) * 512 + g * 8;
            const bf16_t* qa = qc + ((size_t)chunk * 4 + h) * 64 * 512 + (size_t)(tt0 * 16 + tk) * 512 + g * 8;
#pragma unroll 8
            for (int kk = 0; kk < 16; ++kk) { const bf16x8 a = *(const bf16x8*)(ka + kk * 32), b0 = *(const bf16x8*)(qa + kk * 32), b1 = *(const bf16x8*)(qa + 16 * 512 + kk * 32);
                S0 = __builtin_amdgcn_mfma_f32_16x16x32_bf16(a, b0, S0, 0, 0, 0); S1 = __builtin_amdgcn_mfma_f32_16x16x32_bf16(a, b1, S1, 0, 0, 0); }
#pragma unroll
            for (int d = 0; d < 2; ++d)
#pragma unroll
                for (int x = 0; x < 2; ++x) { const int t = (tt0 + x) * 16 + tk; const float Mt = M_[d * 64 + t]; const f32x4 Sv = x ? S1 : S0; float pv[4]; float psum = 0.f;
#pragma unroll
                    for (int i = 0; i < 4; ++i) { const int sx = st * 16 + 4 * g + i; const bool ok = d ? (sx >= t) : (sx <= t);
                        const float dd = ok ? __expf(A_[d * 64 + sx] - Mt) : 0.f; pv[i] = Sv[i] * dd; psum += pv[i]; }
                    u32x2 w; w.x = cvt_pk_bf16(pv[0], pv[1]); w.y = cvt_pk_bf16(pv[2], pv[3]);
                    *(LAS u32x2*)(lds + d * PS_HALF + t * PS_STRIDE + (st * 16 + 4 * g) * 2) = w;
                    (void)psum; } }
        __syncthreads();
        {
            u32x4 va[4][2];
#pragma unroll
            for (int mi = 0; mi < 4; ++mi) { const bf16_t* vg = vtc + (((size_t)chunk * 4 + h) * 512 + wid * 64 + mi * 16 + tk) * 64; va[mi][0] = *(const u32x4*)(vg + g * 8); va[mi][1] = *(const u32x4*)(vg + 32 + g * 8); }
#pragma unroll
            for (int d = 0; d < 2; ++d) { bf16_t* hout = (bf16_t*)(p.ws + (d ? S_R6 : S_R1));
#pragma unroll
                for (int ni = 0; ni < 4; ++ni) { const bf16x8 pb0 = *(const LAS bf16x8*)(lds + d * PS_HALF + (ni * 16 + tk) * PS_STRIDE + (g * 8) * 2), pb1 = *(const LAS bf16x8*)(lds + d * PS_HALF + (ni * 16 + tk) * PS_STRIDE + (32 + g * 8) * 2);
#pragma unroll
                    for (int mi = 0; mi < 4; ++mi) { f32x4 acc = (f32x4){0.f, 0.f, 0.f, 0.f};
                        acc = __builtin_amdgcn_mfma_f32_16x16x32_bf16(pb0, __builtin_bit_cast(bf16x8, va[mi][0]), acc, 0, 0, 0);
                        acc = __builtin_amdgcn_mfma_f32_16x16x32_bf16(pb1, __builtin_bit_cast(bf16x8, va[mi][1]), acc, 0, 0, 0);
                        u32x2 w; w.x = cvt_pk_bf16_mfma(acc[0], acc[1]); w.y = cvt_pk_bf16_mfma(acc[2], acc[3]);
                        *(u32x2*)(hout + (size_t)(rowbase + ni * 16 + 4 * g + (tk & 3)) * 2048 + h * 512 + wid * 64 + mi * 16 + (tk & ~3)) = w; } } } }
        if (tid < 128) { const int d = tid >> 6, t = tid & 63; float sum = 0.f;
#pragma unroll
            for (int i = 0; i < 8; ++i) { const u32x4 w = *(const LAS u32x4*)(lds + d * PS_HALF + t * PS_STRIDE + i * 16); sum += (bflo(w.x) + bfhi(w.x)) + (bflo(w.y) + bfhi(w.y)) + (bflo(w.z) + bfhi(w.z)) + (bflo(w.w) + bfhi(w.w)); }
            RS[((size_t)(rowbase + t) * 2 + d) * 4 + h] = sum; }
        __syncthreads();
    }
}

__device__ void phase_scan(const Params& p, int hf, LAS unsigned char* lds) {
    const int tid0 = TIDX, wid = __builtin_amdgcn_readfirstlane(tid0 >> 6);
    const int wg = blockIdx.x, vs = wg >> 5, dir = wg & 1, h = (wg >> 1) & 3, bl = (wg >> 3) & 3;
    const int dvg = wid & 3, kh = wid >> 2;
    const bf16_t* qc = (const bf16_t*)(p.ws + S_R3); const bf16_t* kc = (const bf16_t*)(p.ws + S_R4); const bf16_t* vtc = (const bf16_t*)(p.ws + S_R5);
    bf16_t* hout = (bf16_t*)(p.ws + (dir ? S_R6 : S_R1));
    (void)hf;
    LAS float* vec = (LAS float*)(lds + L_VEC);
    LAS float* fin4 = vec  , *e_p = vec + 256, *iw_p = vec + 320, *qn = vec + 384;
    LAS unsigned* nbf = (LAS unsigned*)(vec + 448);
    LAS unsigned* ebf = (LAS unsigned*)(vec + 704);
    f32x4 C[16];
#pragma unroll
    for (int i = 0; i < 16; ++i) C[i] = (f32x4){0.f, 0.f, 0.f, 0.f};
    float nreg = 0.f; ((LAS unsigned short*)nbf)[tid0] = 0;
    float mstate = 0.f;
    const int dvw = vs * 64 + dvg * 16;
    const int combo = wg & 31; const float* pre = (const float*)(p.ws + S_PRE) + (size_t)combo * 68 * 256; const float* pres = (const float*)(p.ws + S_PRE) + PRE_V + (size_t)combo * 68 * 2;
    const float* RS = (const float*)(p.ws + S_RS);
    f32x4 pv_n; float bl_n, mw_n, rs_n = 0.f; u32x2 numi_n[2] = {(u32x2){0u, 0u}, (u32x2){0u, 0u}}; u32x4 kr[8];
    { const ScanPos s0 = scan_pos(0, dir, bl); const int lane = tid0 & 63, tk = lane & 15, g = lane >> 4, pp = dir ? 63 - lane : lane;
      (void)pp; pv_n = *(const f32x4*)(pre + (size_t)lane * 4); bl_n = pres[0]; mw_n = pres[1];
      const bf16_t* kg = kc + ((size_t)s0.chunk * 4 + h) * 64 * 512 + (size_t)((wid >> 1) * 16 + tk) * 512 + (wid & 1) * 256 + g * 8;
#pragma unroll
      for (int j = 0; j < 8; ++j) kr[j] = *(const u32x4*)(kg + j * 32); }
    __syncthreads();
    for (int step = 0; step < 68; ++step) {
        int tid = tid0; asm volatile("" : "+v"(tid));
        const int lane = tid & 63, tk = lane & 15, g = lane >> 4;
        const ScanPos cur = scan_pos(step, dir, bl); const bool isctx = cur.isctx; const int rowbase = cur.rowbase;
        const bool has_next = step < 67; const ScanPos nxt = scan_pos(has_next ? step + 1 : step, dir, bl);
        const int pp = dir ? 63 - lane : lane;
        const u32x2 numi_c0 = numi_n[0], numi_c1 = numi_n[1];
        const float bcs = pv_n[0], cm = pv_n[1], ic = pv_n[2], blast = bl_n;
        const float mnew = fmaxf(blast + mstate, mw_n);
        const float decay = __expf(blast + mstate - mnew);
        const float ev = __expf(blast - bcs + ic - mnew);
        const float av = ic - bcs;
        const float Mx = fmaxf(mstate, cm);
        if (wid == 0) { (void)av; const float iwv = __expf(mstate - Mx); e_p[pp] = ev; iw_p[pp] = iwv; fin4[pp * 4] = iwv; fin4[pp * 4 + 2] = __expf(-(bcs + Mx)); fin4[lane * 4 + 1] = rs_n; ((LAS unsigned short*)ebf)[pp] = (unsigned short)(cvt_pk_bf16(ev, 0.f) & 0xffffu); }
        { const int sel = tk & 1, srow = (wid >> 1) * 16 + tk, dk0 = (wid & 1) * 256 + g * 8 + (sel ? 4 : 0);
          LAS unsigned char* kb = lds + L_KT + dk0 * KT_STRIDE + (srow >> 1) * 4;
          const unsigned selLo = sel ? 0x05040100u : 0x01000504u, selHi = sel ? 0x07060302u : 0x03020706u;
#pragma unroll
          for (int j = 0; j < 8; ++j) { const u32x4 d = kr[j];
              const unsigned send0 = sel ? d[0] : d[2], send1 = sel ? d[1] : d[3], keep0 = sel ? d[2] : d[0], keep1 = sel ? d[3] : d[1];
              const unsigned recv0 = (unsigned)__builtin_amdgcn_update_dpp(0, (int)send0, 0xB1, 0xF, 0xF, false), recv1 = (unsigned)__builtin_amdgcn_update_dpp(0, (int)send1, 0xB1, 0xF, 0xF, false);
              LAS unsigned char* kp = kb + j * 32 * KT_STRIDE;
              *(LAS unsigned*)(kp) = __builtin_amdgcn_perm(keep0, recv0, selLo); *(LAS unsigned*)(kp + KT_STRIDE) = __builtin_amdgcn_perm(keep0, recv0, selHi);
              *(LAS unsigned*)(kp + 2 * KT_STRIDE) = __builtin_amdgcn_perm(keep1, recv1, selLo); *(LAS unsigned*)(kp + 3 * KT_STRIDE) = __builtin_amdgcn_perm(keep1, recv1, selHi); } }
        if (step == 4) {
            const bf16_t* qg = qc + ((size_t)cur.chunk * 4 + h) * 64 * 512;
#pragma unroll
            for (int i = 0; i < 8; ++i) { const int t = wid * 8 + i;
                __builtin_amdgcn_global_load_lds((const unsigned*)(qg + (size_t)t * 512 + lane * 8), (LAS unsigned*)(lds + L_QS + t * QS_STRIDE), 16, 0, 0); }
        }
        asm volatile("s_waitcnt vmcnt(0)" ::: "memory");
        LDS_BAR();
        const bf16_t* vg = vtc + (((size_t)cur.chunk * 4 + h) * 512 + dvw + tk) * 64;
        const u32x4 v0 = *(const u32x4*)(vg + g * 8), v1 = *(const u32x4*)(vg + 32 + g * 8);
        if (has_next) { pv_n = *(const f32x4*)(pre + ((size_t)(step + 1) * 64 + lane) * 4); bl_n = pres[(step + 1) * 2]; mw_n = pres[(step + 1) * 2 + 1];
                        if (!nxt.isctx) { rs_n = RS[((size_t)(nxt.rowbase + lane) * 2 + dir) * 4 + h];
#pragma unroll
                            for (int m2 = 0; m2 < 2; ++m2) numi_n[m2] = *(const u32x2*)(hout + (size_t)(nxt.rowbase + (kh * 2 + m2) * 16 + 4 * g + (tk & 3)) * 2048 + h * 512 + dvw + (tk & ~3)); } }
        f32x4 O[4];
        if (!isctx) {
            { const int t = tid >> 3, part = tid & 7; float s = 0.f;
#pragma unroll
              for (int i = 0; i < 8; ++i) { const u32x4 w = *(const LAS u32x4*)(lds + L_QS + t * QS_STRIDE + (i * 64 + part * 8) * 2); const u32x4 nv = *(const LAS u32x4*)(nbf + i * 32 + part * 4);
                  s = dot2bf(w.x, nv.x, s); s = dot2bf(w.y, nv.y, s); s = dot2bf(w.z, nv.z, s); s = dot2bf(w.w, nv.w, s); }
              s += __builtin_bit_cast(float, __builtin_amdgcn_update_dpp(0, __builtin_bit_cast(int, s), 0xB1, 0xF, 0xF, true));
              s += __builtin_bit_cast(float, __builtin_amdgcn_update_dpp(0, __builtin_bit_cast(int, s), 0x4E, 0xF, 0xF, true));
              s += __builtin_bit_cast(float, __builtin_amdgcn_update_dpp(0, __builtin_bit_cast(int, s), 0x104, 0xF, 0xF, true));
              if (part == 0) qn[t] = s; }
#pragma unroll
            for (int mt = 0; mt < 4; ++mt) O[mt] = (f32x4){0.f, 0.f, 0.f, 0.f};
            { u32x4 aw[2][4];
#define QC_LOAD(buf, j_) do { _Pragma("unroll") for (int mt = 0; mt < 4; ++mt) aw[buf][mt] = *(const LAS u32x4*)(lds + L_QS + (mt * 16 + tk) * QS_STRIDE + ((kh * 8 + (j_)) * 32 + 8 * g) * 2); } while (0)
              QC_LOAD(0, 0);
#pragma unroll
              for (int j = 0; j < 8; ++j) {
                  if (j < 7) QC_LOAD((j + 1) & 1, j + 1);
                  u32x4 bw; bw.x = cvt_pk_bf16(C[2 * j][0], C[2 * j][1]); bw.y = cvt_pk_bf16(C[2 * j][2], C[2 * j][3]); bw.z = cvt_pk_bf16(C[2 * j + 1][0], C[2 * j + 1][1]); bw.w = cvt_pk_bf16(C[2 * j + 1][2], C[2 * j + 1][3]);
                  const bf16x8 bb = __builtin_bit_cast(bf16x8, bw);
                  __builtin_amdgcn_sched_barrier(0);
#pragma unroll
                  for (int mt = 0; mt < 4; ++mt) O[mt] = __builtin_amdgcn_mfma_f32_16x16x32_bf16(__builtin_bit_cast(bf16x8, aw[j & 1][mt]), bb, O[mt], 0, 0, 0);
                  __builtin_amdgcn_sched_barrier(0); }
#undef QC_LOAD
            }
        }
        LDS_BAR();
        if (has_next) {
            if (!nxt.isctx) { const bf16_t* qg = qc + ((size_t)nxt.chunk * 4 + h) * 64 * 512;
#pragma unroll
                for (int i = 0; i < 8; ++i) { const int t = wid * 8 + i;
                    __builtin_amdgcn_global_load_lds((const unsigned*)(qg + (size_t)t * 512 + lane * 8), (LAS unsigned*)(lds + L_QS + t * QS_STRIDE), 16, 0, 0); } }
            const bf16_t* kgn = kc + ((size_t)nxt.chunk * 4 + h) * 64 * 512 + (size_t)((wid >> 1) * 16 + tk) * 512 + (wid & 1) * 256 + g * 8;
#pragma unroll
            for (int j = 0; j < 8; ++j) kr[j] = *(const u32x4*)(kgn + j * 32);
        }
        if (!isctx) {
            float numi[8];
            numi[0] = bflo(numi_c0.x); numi[1] = bfhi(numi_c0.x); numi[2] = bflo(numi_c0.y); numi[3] = bfhi(numi_c0.y); numi[4] = bflo(numi_c1.x); numi[5] = bfhi(numi_c1.x); numi[6] = bflo(numi_c1.y); numi[7] = bfhi(numi_c1.y);
#pragma unroll
            for (int mt = 0; mt < 4; ++mt) { const f32x4 iw4 = *(const LAS f32x4*)(iw_p + mt * 16 + 4 * g); O[mt] = O[mt] * iw4; }
            LAS float* xw = (LAS float*)(lds + L_PS) + (dvg * 2 + kh) * 512 + lane * 8;
            const LAS float* xr = (const LAS float*)(lds + L_PS) + (dvg * 2 + (kh ^ 1)) * 512 + lane * 8;
            *(LAS f32x4*)xw = kh ? O[0] : O[2]; *(LAS f32x4*)(xw + 4) = kh ? O[1] : O[3];
            LDS_BAR();
            { const f32x4 xp0 = *(const LAS f32x4*)xr, xp1 = *(const LAS f32x4*)(xr + 4);
#pragma unroll
              for (int m2 = 0; m2 < 2; ++m2) { const int mt = kh * 2 + m2; const f32x4 own = kh ? O[2 + m2] : O[m2]; const f32x4 xp = m2 ? xp1 : xp0; const f32x4 qn4 = *(const LAS f32x4*)(qn + mt * 16 + 4 * g);
#pragma unroll
                  for (int i = 0; i < 4; ++i) { const int t = mt * 16 + 4 * g + i; const f32x4 f = *(const LAS f32x4*)(fin4 + t * 4); const float den = f[0] * qn4[i] + f[1];
                      const float hv = (own[i] + xp[i] + numi[m2 * 4 + i]) * __builtin_amdgcn_rcpf(fmaxf(fabsf(den), f[2]));
                      hout[(size_t)(rowbase + t) * 2048 + h * 512 + dvw + tk] = (bf16_t)(cvt_pk_bf16(hv, 0.f) & 0xffffu); } } }
        }
        { u32x4 w0, w1;
          { const f32x4 ea = *(const LAS f32x4*)(e_p + g * 8), eb = *(const LAS f32x4*)(e_p + g * 8 + 4), ec = *(const LAS f32x4*)(e_p + 32 + g * 8), ed = *(const LAS f32x4*)(e_p + 32 + g * 8 + 4);
            w0[0] = cvt_pk_bf16(bflo(v0[0]) * ea[0], bfhi(v0[0]) * ea[1]); w0[1] = cvt_pk_bf16(bflo(v0[1]) * ea[2], bfhi(v0[1]) * ea[3]);
            w0[2] = cvt_pk_bf16(bflo(v0[2]) * eb[0], bfhi(v0[2]) * eb[1]); w0[3] = cvt_pk_bf16(bflo(v0[3]) * eb[2], bfhi(v0[3]) * eb[3]);
            w1[0] = cvt_pk_bf16(bflo(v1[0]) * ec[0], bfhi(v1[0]) * ec[1]); w1[1] = cvt_pk_bf16(bflo(v1[1]) * ec[2], bfhi(v1[1]) * ec[3]);
            w1[2] = cvt_pk_bf16(bflo(v1[2]) * ed[0], bfhi(v1[2]) * ed[1]); w1[3] = cvt_pk_bf16(bflo(v1[3]) * ed[2], bfhi(v1[3]) * ed[3]); }
          const bf16x8 ve0 = __builtin_bit_cast(bf16x8, w0), ve1 = __builtin_bit_cast(bf16x8, w1);
          const LAS unsigned char* kbase = lds + L_KT + (kh * 256 + 8 * (tk >> 2) + (tk & 3)) * KT_STRIDE + g * 16;
          bf16x8 ka[2][2];
          ka[0][0] = *(const LAS bf16x8*)kbase; ka[0][1] = *(const LAS bf16x8*)(kbase + 64);
#pragma unroll
          for (int i = 0; i < 16; ++i) {
              if (i < 15) { const LAS unsigned char* kp = kbase + (32 * ((i + 1) >> 1) + 4 * ((i + 1) & 1)) * KT_STRIDE; ka[(i + 1) & 1][0] = *(const LAS bf16x8*)kp; ka[(i + 1) & 1][1] = *(const LAS bf16x8*)(kp + 64); }
              C[i] = C[i] * decay;
              __builtin_amdgcn_sched_barrier(0);
              C[i] = __builtin_amdgcn_mfma_f32_16x16x32_bf16(ka[i & 1][0], ve0, C[i], 0, 0, 0);
              C[i] = __builtin_amdgcn_mfma_f32_16x16x32_bf16(ka[i & 1][1], ve1, C[i], 0, 0, 0);
              __builtin_amdgcn_sched_barrier(0); } }
        { float sacc = 0.f; const LAS unsigned char* kp = lds + L_KT + tid * KT_STRIDE;
#pragma unroll
          for (int i = 0; i < 8; ++i) { const u32x4 w = *(const LAS u32x4*)(kp + i * 16); const u32x4 e4 = *(const LAS u32x4*)(ebf + i * 4);
              sacc = dot2bf(w.x, e4.x, sacc); sacc = dot2bf(w.y, e4.y, sacc); sacc = dot2bf(w.z, e4.z, sacc); sacc = dot2bf(w.w, e4.w, sacc); }
          nreg = decay * nreg + sacc; ((LAS unsigned short*)nbf)[tid] = (unsigned short)(cvt_pk_bf16(nreg, 0.f) & 0xffffu); }
        mstate = mnew;
        LDS_BAR();
    }
}

DI Sch mk_sch(int nM, int nN, int nsub, const void* A0, const void* B0, size_t a_tile, size_t b_tile, size_t a_sub, size_t b_sub, int a_mod = 0, int b_mod = 0) {
    Sch s; s.nM = nM; s.nN = nN; s.nsub = nsub; s.G = 256; s.c = blockIdx.x; s.A0 = (const char*)A0; s.B0 = (const char*)B0;
    s.a_tile = a_tile; s.b_tile = b_tile; s.a_sub = a_sub; s.b_sub = b_sub; s.a_sub2 = 0; s.a_mod = a_mod; s.b_mod = b_mod; return s;
}

__global__ void __launch_bounds__(512, 2) mega(Params p, int ph_lo, int ph_hi) {
    extern __shared__ __attribute__((aligned(16))) unsigned char smem[];
    LAS unsigned char* lds = (LAS unsigned char*)smem;
    cg::grid_group grid = cg::this_grid();
#ifdef PROBE
    unsigned long long tprev = 0, accA = 0, accB = 0;
#endif
    for (int ph = 0; ph < 30; ++ph) {
        if (ph > 0) { if (p.ws == nullptr) grid.sync();
                      unsigned gen = (unsigned)(ph - 1); grid_bar((unsigned*)(p.ws + S_BAR), gen); }
#ifdef PROBE
        { const unsigned long long tn = __builtin_amdgcn_s_memrealtime(); if (ph > 0) { if ((PROBE_MA >> (ph - 1)) & 1u) accA += tn - tprev; if ((PROBE_MB >> (ph - 1)) & 1u) accB += tn - tprev; } tprev = tn; }
        const float probe_b = (float)accB * 0.01f;
#else
        const float probe_b = 0.f;
#endif
        const float* mods = (const float*)(p.out + W_MODS);
        _Float16* hb = (_Float16*)(p.out + O_HB);
        unsigned char* ub = p.ws + S_UB;
#ifndef ONLY
#define EN(x) 1
#else
#define EN(x) ((x) == ONLY)
#endif
        switch (ph) {
        case 0: if (EN(0)) phase_prep(p, lds); break;
        case 1: if (EN(1)) phase_embed(p); break;
        case 2: if (EN(2)) { GemmCfg g{2048, 16, 2048, 16, 16}; Sch S = mk_sch(136, 6, 1, ub, p.out + W_ABIN, 256 * 2048, 256 * 2048, 0, 0);
                  EpiAbIn E{(bf16_t*)(p.ws + S_R1), (bf16_t*)(p.ws + S_R1 + 34 * MiB)}; gemm_phase(lds, g, S, E); } break;
        case 3: if (EN(3)) phase_poolconv(p, lds); break;
        case 4: if (EN(2)) { GemmCfg g{16, (unsigned)NR * 16u, 1024, 16, 8}; Sch S = mk_sch(136, 2, 1, p.ws + S_R1, p.out + W_POOL, 256 * 16, 256 * 1024, 0, 0);
                  EpiPool E{(bf16_t*)(p.ws + S_R2), p.in[10], p.in[11]}; gemm_phase(lds, g, S, E); } break;
        case 5: if (EN(2)) { GemmCfg g{2048, 16, 2048, 16, 16}; Sch S = mk_sch(136, 4, 1, p.ws + S_R2, p.out + W_ABOUT, 256 * 2048, 256 * 2048, 0, 0);
                  EpiRes E{hb, hb, mods + 2 * 1024, 0, nullptr, nullptr}; gemm_phase(lds, g, S, E); } break;
        case 6: if (EN(1)) phase_ln(p, hb, 0, 0, 0, 3, 0); break;
        case 7: if (EN(2)) { GemmCfg g{2048, 16, 2048, 16, 16}; Sch S = mk_sch(136, 22, 1, ub, p.out + W_FFNIN, 256 * 2048, 256 * 2048, 0, 0);
                  EpiFfnIn E{(bf16_t*)(p.ws + S_R3), 0}; gemm_phase(lds, g, S, E); } break;
        case 8: if (EN(2)) {
                  for (int cpart = 0; cpart < 2; ++cpart) {
                      GemmCfg g{FF * 2, 16, FF * 2, 16, cpart ? 22 : 44};
                      Sch S = mk_sch(cpart ? 4 : 64, 4, cpart ? 4 : 2, p.ws + S_R3 + (cpart ? (size_t)HLAT * FF * 2 : (size_t)0), p.out + W_FFNOUT, (size_t)256 * FF * 2, (size_t)256 * FF * 2,
                                     cpart ? (size_t)1408 * 2 : (size_t)HR * FF * 2, cpart ? (size_t)1408 * 2 : (size_t)0, cpart ? 2 : 0, cpart ? 2 : 0);
                      if (cpart) { S.a_sub2 = (size_t)HR * FF * 2; S.c = 255 - (int)blockIdx.x; }
                      EpiRes E{hb, hb, mods + (cpart ? 8 * 6144 : 0) + 5 * 1024, HR, cpart ? (float*)(p.ws + S_CPA) : (float*)nullptr, (float*)(p.ws + S_CPB)};
                      gemm_phase(lds, g, S, E); } } break;
        case 9: if (EN(1)) phase_ln(p, hb, 0, 1, 1, 0, 0, 0.f, (const float*)(p.ws + S_CPA), (const float*)(p.ws + S_CPB)); break;
        case 10: case 18: if (EN(2)) { const int hf = ph >= 18; GemmCfg g{2048, 16, 2048, 16, 16};
                  Sch S = mk_sch(68, 8, 1, ub + (size_t)hf * HR * 2048, p.out + W_MLIN, 256 * 2048, 256 * 2048, 0, 0);
                  EpiPlain E{(bf16_t*)(p.ws + S_R1), 2048}; gemm_phase(lds, g, S, E); } break;
        case 11: case 19: if (EN(4)) phase_mlconv(p, ph >= 19); break;
        case 12: case 20: if (EN(2)) {
                  phase_pre(p, ph >= 20);
                  { GemmCfg g{4096, 16, 1024, 16, 8}; Sch S = mk_sch(68, 2, 8, p.ws + S_R2, p.out + W_Q, 256 * 4096, 256 * 1024, 1024, 524288, 4, 0);
                    EpiQK E{(bf16_t*)(p.ws + S_R3), (bf16_t*)(p.ws + S_R4)}; gemm_phase(lds, g, S, E); }
                  { GemmCfg g{1024, 16, 4096, 16, 8}; Sch S = mk_sch(2, 68, 4, p.out + W_V, p.ws + S_R1, 256 * 1024, 256 * 4096, 524288, 1024);
                    S.c = 255 - (int)blockIdx.x;
                    EpiVT E{(bf16_t*)(p.ws + S_R5)}; gemm_phase(lds, g, S, E); } } break;
        case 13: case 21: if (EN(5)) phase_intra(p, lds); break;
        case 14: case 22: if (EN(5)) phase_scan(p, ph >= 22, lds); break;
        case 15: case 23: if (EN(2)) { const int hf = ph >= 23; GemmCfg g{2048, 16, 2048, 16, 16};
                  Sch S = mk_sch(64, 8, 1, ub + (size_t)hf * HR * 2048, p.out + W_MLIN + (size_t)2048 * 2048, 256 * 2048, 256 * 2048, 0, 0);
                  EpiPlain E{(bf16_t*)(p.ws + S_R3), 2048}; gemm_phase(lds, g, S, E); } break;
        case 16: case 24: if (EN(1)) phase_mlout(p); break;
        case 17: case 25: if (EN(2)) { const int hf = ph >= 25; GemmCfg g{4096, 16, 4096, 16, 32};
                  Sch S = mk_sch(64, 4, 1, p.ws + S_R2, p.out + W_MLOUT, 256 * 4096, 256 * 4096, 0, 0);
                  EpiRes E{hb + (size_t)hf * HR * 1024, hb + (size_t)hf * HR * 1024, mods + 9 * 6144 + 2 * 1024 + (size_t)hf * 4 * 6144, 0, nullptr, nullptr};
                  gemm_phase(lds, g, S, E); } break;
        case 26: if (EN(1)) phase_ln(p, hb, 1, 0, 1, 3, 1); break;
        case 27: if (EN(2)) { GemmCfg g{2048, 16, 2048, 16, 16}; Sch S = mk_sch(64, 22, 2, ub, p.out + W_FFNIN + 11534336, 256 * 2048, 256 * 2048, (size_t)HR * 2048, 0);
                  EpiFfnIn E{(bf16_t*)(p.ws + S_R1), HR}; gemm_phase(lds, g, S, E); } break;
        case 28: if (EN(2)) { GemmCfg g{FF * 2, 16, FF * 2, 16, 44}; Sch S = mk_sch(64, 4, 2, p.ws + S_R1, p.out + W_FFNOUT + 5767168, (size_t)256 * FF * 2, (size_t)256 * FF * 2, (size_t)HR * FF * 2, 0);
                  EpiRes E{hb, (_Float16*)(p.ws + S_R5), mods + 9 * 6144 + 5 * 1024, HR, nullptr, nullptr}; gemm_phase(lds, g, S, E); } break;
        case 29: if (EN(1)) phase_ln(p, (const _Float16*)(p.ws + S_R5), 1, 1, -1, 0, 2, probe_b); break;
        default: break;
        }
    }
#ifdef PROBE
    { const unsigned long long tn = __builtin_amdgcn_s_memrealtime(); if ((PROBE_MA >> 29) & 1u) accA += tn - tprev;
      __syncthreads(); if (blockIdx.x == 0 && threadIdx.x == 0) ((float*)p.out)[0] = (float)accA * 0.01f; }
#endif
}
constexpr int NPHASE = 30;

extern "C" void kernel_launch(void* const* d_in, const int* in_sizes, int n_in, void* d_out, int out_size, void* d_ws, size_t ws_size, hipStream_t stream) {
    static int grid = 0;
    if (grid == 0) {
        if (n_in != 30 || ws_size < WS_NEED) { fprintf(stderr, "kernel_launch: unexpected n_in %d or ws_size %zu (< %zu)\n", n_in, ws_size, (size_t)WS_NEED); grid = -1; return; }
        int dev = 0, cus = 0, per_cu = 0;
        hipGetDevice(&dev); hipDeviceGetAttribute(&cus, hipDeviceAttributeMultiprocessorCount, dev);
        if (hipFuncSetAttribute((const void*)mega, hipFuncAttributeMaxDynamicSharedMemorySize, LDS_BYTES) != hipSuccess) { fprintf(stderr, "hipFuncSetAttribute failed\n"); grid = -1; return; }
        hipOccupancyMaxActiveBlocksPerMultiprocessor(&per_cu, (const void*)mega, 512, LDS_BYTES);
        (void)hipGetLastError();
        grid = 256; if (cus != 256) fprintf(stderr, "kernel_launch: device reports %d CUs; this kernel is built for a 256-workgroup grid\n", cus);
        if (per_cu < 1) fprintf(stderr, "kernel_launch: occupancy query says %d blocks per CU\n", per_cu);
    }
    if (grid < 0) return;
    hipMemsetAsync((unsigned char*)d_ws + S_BAR, 0, 4096, stream);
    Params p{};
    for (int i = 0; i < 30; ++i) p.in[i] = (const float*)d_in[i];
    p.out = (unsigned char*)d_out; p.ws = (unsigned char*)d_ws;
    int lo = 0, hi = NPHASE;
    void* args[] = {&p, &lo, &hi};
    hipError_t e = hipLaunchCooperativeKernel((const void*)mega, dim3(grid), dim3(512), args, LDS_BYTES, stream);
    if (e != hipSuccess) fprintf(stderr, "cooperative launch failed: %s (grid %d)\n", hipGetErrorString(e), grid);
}
```

```cpp
#include <hip/hip_runtime.h>
#include <hip/hip_cooperative_groups.h>
#include <cstdio>
namespace cg = cooperative_groups;

#define LAS __attribute__((address_space(3)))
#define DI __device__ __forceinline__
typedef unsigned short bf16_t;
typedef short bf16x8 __attribute__((ext_vector_type(8)));
typedef float f32x4 __attribute__((ext_vector_type(4)));
typedef unsigned u32x4 __attribute__((ext_vector_type(4)));
typedef unsigned u32x2 __attribute__((ext_vector_type(2)));
typedef _Float16 f16x8 __attribute__((ext_vector_type(8)));
typedef __bf16 bf16x2 __attribute__((ext_vector_type(2)));

constexpr int DM = 1024, NB = 8, SEQ = 4096, CTXL = 256, NR = 34816, HR = 17408, HLAT = 16384;
constexpr int FF = 2816, EIN = 2048, DH = 512;
constexpr float ALPHA = 1.41421356237f, LNEPS = 1e-5f, KSCALE = 0.04419417382f;
constexpr size_t MiB = 1048576;
constexpr size_t O_HB = 0, O_W = 68 * MiB;
constexpr size_t W_ABIN = O_W, W_POOL = W_ABIN + 3145728, W_ABOUT = W_POOL + 524288, W_FFNIN = W_ABOUT + 2097152  ,
                 W_FFNOUT = W_FFNIN + 2 * 11534336  , W_MLIN = W_FFNOUT + 2 * 5767168, W_Q = W_MLIN + 8388608, W_K = W_Q + 2097152,
                 W_V = W_K + 2097152, W_MLOUT = W_V + 2097152, W_AQK = W_MLOUT + 4194304, W_AV = W_AQK + 65536, W_MODS = W_AV + 65536,
                 W_END = W_MODS + 442368;
static_assert(W_END <= 128 * MiB, "weights region");
constexpr size_t RS = 68 * MiB;
constexpr size_t S_UB = 0, S_R1 = RS, S_R2 = 2 * RS, S_R3 = 3 * RS, S_R4 = 4 * RS, S_R5 = 5 * RS, S_R6 = 6 * RS, S_MISC = 7 * RS;
constexpr size_t S_GATES = S_MISC, S_BAR = S_MISC + 4 * MiB, S_RS = S_MISC + 5 * MiB, S_PRE = S_MISC + 8 * MiB, S_CPA = S_MISC + 12 * MiB, S_CPB = S_MISC + 20 * MiB;
static_assert(S_CPB + 8 * MiB <= 512 * MiB, "workspace");
constexpr int PRE_V = 32 * 68 * 256;
constexpr size_t WS_NEED = S_PRE + (size_t)(PRE_V + 32 * 68 * 2) * 4;
static_assert(WS_NEED <= 512 * MiB, "workspace");

constexpr int LDS_BYTES = 160 * 1024;

struct Params {
    const float* in[30];
    unsigned char* out;
    unsigned char* ws;
};

DI unsigned cvt_pk_bf16(float lo, float hi) { unsigned r; asm("v_cvt_pk_bf16_f32 %0, %1, %2\n\ts_nop 1" : "=v"(r) : "v"(lo), "v"(hi)); return r; }
DI int opaque_tid() { int t = threadIdx.x; asm volatile("" : "+v"(t)); return t; }
#define TIDX opaque_tid()
DI unsigned cvt_pk_bf16_mfma(float lo, float hi) { unsigned r; asm volatile("s_nop 7\n\ts_nop 7\n\tv_cvt_pk_bf16_f32 %0, %1, %2\n\ts_nop 1" : "=v"(r) : "v"(lo), "v"(hi)); return r; }
DI float bf2f(unsigned short b) { return __uint_as_float(((unsigned)b) << 16); }
DI float dot2bf(unsigned a, unsigned b, float c) { return __builtin_amdgcn_fdot2_f32_bf16(__builtin_bit_cast(bf16x2, a), __builtin_bit_cast(bf16x2, b), c, false); }
DI float bflo(unsigned w) { return __uint_as_float(w << 16); }
DI float bfhi(unsigned w) { return __uint_as_float(w & 0xffff0000u); }
DI float sigmoidf_(float x) { return __builtin_amdgcn_rcpf(1.0f + __expf(-x)); }
DI float siluf_(float x) { return x * __builtin_amdgcn_rcpf(1.0f + __expf(-x)); }
DI float wave_sum(float v) {
#pragma unroll
    for (int o = 32; o >= 1; o >>= 1) v += __shfl_xor(v, o);
    return v;
}
DI float wave_max(float v) {
#pragma unroll
    for (int o = 32; o >= 1; o >>= 1) v = fmaxf(v, __shfl_xor(v, o));
    return v;
}
DI int row_bm(int R) { const int hf = R >= HR ? 1 : 0; const int r = R - hf * HR; return r < HLAT ? hf * 4 + (r >> 12) : 8; }
DI const float* row_src(const Params& p, int R) {
    const int hf = R >= HR ? 1 : 0; const int r = R - hf * HR;
    if (r < HLAT) return p.in[0] + ((size_t)(hf * 4 + (r >> 12)) * SEQ + (r & 4095)) * DM;
    const int rc = r - HLAT; return p.in[2] + ((size_t)(hf * 4 + (rc >> 8)) * CTXL + (rc & 255)) * DM;
}

DI void grid_bar(unsigned* ctr, unsigned& gen) {
    asm volatile("s_waitcnt vmcnt(0)" ::: "memory");
    __syncthreads();
    gen += 1;
    if (threadIdx.x == 0) {
        __builtin_amdgcn_fence(__ATOMIC_RELEASE, "agent");
        asm volatile("s_waitcnt vmcnt(0)" ::: "memory");
        unsigned* grp = ctr + 64 * (1 + (blockIdx.x & 7));
        const unsigned old = __hip_atomic_fetch_add(grp, 1u, __ATOMIC_RELAXED, __HIP_MEMORY_SCOPE_AGENT);
        if (old + 1u == gen * (gridDim.x >> 3)) __hip_atomic_fetch_add(ctr, 1u, __ATOMIC_RELAXED, __HIP_MEMORY_SCOPE_AGENT);
        const unsigned target = gen * 8u;
        while (__hip_atomic_load(ctr, __ATOMIC_RELAXED, __HIP_MEMORY_SCOPE_AGENT) < target) __builtin_amdgcn_s_sleep(2);
        __builtin_amdgcn_fence(__ATOMIC_ACQUIRE, "agent");
        asm volatile("s_waitcnt vmcnt(0)" ::: "memory");
    }
    __syncthreads();
}

constexpr int BM = 256, BK = 64, HALF = 128, HTB = HALF * BK * 2;
DI int lds_byte(int r, int c) { const int st = (r >> 4) * 2 + (c >> 5), rr = r & 15, cc = c & 31, ob = rr * 64 + cc * 2; return st * 1024 + (ob ^ (((ob >> 9) & 1) << 5)); }
DI void stage_rc(int b, int& R, int& C) { const int st = b / 1024, sb = b % 1024, swz = sb ^ (((sb >> 9) & 1) << 5); R = (st >> 1) * 16 + swz / 64; C = (st & 1) * 32 + (swz % 64) / 2; }
DI int perm32(int rho) { const int n = rho >> 4, i = rho & 15; return 8 * (i >> 2) + 4 * n + (i & 3); }

struct Unit { const char* a; const char* b; int pm, pn, sub; };
struct GemmCfg { unsigned a_rs, a_cs, b_rs, b_cs; int nt; };
struct Sch {
    int nM, nN, nsub, G, c;
    const char* A0; const char* B0;
    size_t a_tile, b_tile, a_sub, b_sub, a_sub2; int a_mod, b_mod;
    DI bool next(int i, Unit& u) const {
        const long L = (long)i * G + c; const int per = nM * nN, nwg = per * nsub; if (L >= nwg) return false;
        int wgid = (int)L; { const int q = nwg / 8, r = nwg % 8, xcd = wgid % 8, off = wgid / 8; wgid = (xcd < r ? xcd * (q + 1) : r * (q + 1) + (xcd - r) * q) + off; }
        const int sub = wgid / per; wgid -= sub * per;
        const int nig = 8 * nN, gid = wgid / nig, fm = gid * 8, gsz = (nM - fm) < 8 ? (nM - fm) : 8;
        u.pm = fm + ((wgid % nig) % gsz); u.pn = (wgid % nig) / gsz; u.sub = sub;
        u.a = A0 + (size_t)u.pm * a_tile + (size_t)(a_mod ? sub % a_mod : sub) * a_sub + (size_t)(a_mod ? sub / a_mod : 0) * a_sub2;
        u.b = B0 + (size_t)u.pn * b_tile + (size_t)(b_mod ? sub % b_mod : sub) * b_sub;
        return true;
    }
};

template <class Epi>
DI void gemm_phase(LAS unsigned char* lds, const GemmCfg g, const Sch& S, const Epi& E) {
    const int tid = TIDX, wid = __builtin_amdgcn_readfirstlane(tid >> 6), lane = tid & 63, wr = wid >> 2, wc = wid & 3, fr = lane & 15, fq = lane >> 4;
    const int nt = g.nt;
    unsigned voffA[2], voffB[2];
#pragma unroll
    for (int i = 0; i < 2; ++i) { int R, C; stage_rc(tid * 16 + i * 8192, R, C); const int Rb = (R & ~31) + perm32(R & 31);
        voffA[i] = (unsigned)R * g.a_rs + (unsigned)(C >> 3) * g.a_cs; voffB[i] = (unsigned)Rb * g.b_rs + (unsigned)(C >> 3) * g.b_cs; }
    const size_t kstepA = (size_t)8 * g.a_cs, kstepB = (size_t)8 * g.b_cs, hstepA = (size_t)HALF * g.a_rs, hstepB = (size_t)HALF * g.b_rs;
    const unsigned ldsw = (unsigned)wid * 1024u;
    const int aoff = lds_byte(wr * 64 + fr, fq * 8), boff = lds_byte(wc * 32 + fr, fq * 8);
#define G_SA(b, h) (((b) * 2 + (h)) * HTB)
#define G_SB(b, h) ((4 + (b) * 2 + (h)) * HTB)
#define G_STAGE(bufoff, gbase, voff) do { _Pragma("unroll") for (int _i = 0; _i < 2; ++_i) \
        __builtin_amdgcn_global_load_lds((const unsigned*)((const char*)(gbase) + (voff)[_i]), (LAS unsigned*)(lds + (bufoff) + ldsw + _i * 8192), 16, 0, 0); } while (0)
#define G_LDA(dst, b, h) do { _Pragma("unroll") for (int m = 0; m < 4; ++m) _Pragma("unroll") for (int k = 0; k < 2; ++k) dst[m][k] = *(const LAS bf16x8*)(lds + G_SA(b, h) + aoff + m * 2048 + k * 1024); } while (0)
#define G_LDB(dst, b, h) do { _Pragma("unroll") for (int n = 0; n < 2; ++n) _Pragma("unroll") for (int k = 0; k < 2; ++k) dst[n][k] = *(const LAS bf16x8*)(lds + G_SB(b, h) + boff + n * 2048 + k * 1024); } while (0)
#define G_MMA(ai, bj, At, Bt) do { __builtin_amdgcn_s_setprio(1); _Pragma("unroll") for (int m = 0; m < 4; ++m) _Pragma("unroll") for (int n = 0; n < 2; ++n) _Pragma("unroll") for (int k = 0; k < 2; ++k) \
        acc[ai][bj][m][n] = __builtin_amdgcn_mfma_f32_16x16x32_bf16(Bt[n][k], At[m][k], acc[ai][bj][m][n], 0, 0, 0); __builtin_amdgcn_s_setprio(0); } while (0)
#define G_WAIT_V(n) asm volatile("s_waitcnt vmcnt(" #n ")" ::: "memory")
#define G_WAIT_L(n) asm volatile("s_waitcnt lgkmcnt(" #n ")" ::: "memory")
#define G_BAR __builtin_amdgcn_s_barrier()
#define G_SCHED __builtin_amdgcn_sched_barrier(0)
    Unit cur, nxt; int ui = 0;
    if (!S.next(0, cur)) return;
    f32x4 acc[2][2][4][2];
#pragma unroll
    for (int a = 0; a < 2; ++a)
#pragma unroll
        for (int b = 0; b < 2; ++b)
#pragma unroll
            for (int m = 0; m < 4; ++m)
#pragma unroll
                for (int n = 0; n < 2; ++n) acc[a][b][m][n] = (f32x4){0.f, 0.f, 0.f, 0.f};
    bf16x8 At[4][2], B0[2][2], B1[2][2];
    const char* cA = cur.a; const char* cB = cur.b;
    G_STAGE(G_SB(0, 0), cB, voffB); G_STAGE(G_SA(0, 0), cA, voffA); G_STAGE(G_SB(0, 1), cB + hstepB, voffB); G_STAGE(G_SA(0, 1), cA + hstepA, voffA);
    if (wr == 1) G_BAR;
    G_WAIT_V(4); G_BAR;
    G_STAGE(G_SB(1, 0), cB + kstepB, voffB); G_STAGE(G_SA(1, 0), cA + kstepA, voffA); G_STAGE(G_SB(1, 1), cB + hstepB + kstepB, voffB);
    G_WAIT_V(6); G_BAR;
    for (;;) {
        const bool has_next = S.next(ui + 1, nxt);
        const char* nA = has_next ? nxt.a : cA; const char* nB = has_next ? nxt.b : cB;
        for (int t = 0; t < nt; t += 2) {
            const bool last = (t == nt - 2);
            const char* a1 = cA + (size_t)(t + 1) * kstepA;
            const char* a2 = last ? nA : cA + (size_t)(t + 2) * kstepA; const char* b2 = last ? nB : cB + (size_t)(t + 2) * kstepB;
            const char* a3 = a2 + kstepA; const char* b3 = b2 + kstepB;
            G_LDB(B0, 0, 0); G_SCHED; G_LDA(At, 0, 0); G_STAGE(G_SA(1, 1), a1 + hstepA, voffA);
            G_WAIT_L(8); G_BAR; G_WAIT_L(0); G_MMA(0, 0, At, B0); G_BAR; G_SCHED;
            G_LDB(B1, 0, 1); G_STAGE(G_SB(0, 0), b2, voffB);
            G_BAR; G_WAIT_L(0); G_MMA(0, 1, At, B1); G_BAR;
            G_LDA(At, 0, 1); G_STAGE(G_SA(0, 0), a2, voffA);
            G_BAR; G_WAIT_L(0); G_MMA(1, 0, At, B0); G_BAR; G_SCHED;
            G_STAGE(G_SB(0, 1), b2 + hstepB, voffB);
            G_WAIT_V(6); G_BAR; G_MMA(1, 1, At, B1); G_BAR;
            G_LDB(B0, 1, 0); G_SCHED; G_LDA(At, 1, 0); G_STAGE(G_SA(0, 1), a2 + hstepA, voffA);
            G_WAIT_L(8); G_BAR; G_WAIT_L(0); G_MMA(0, 0, At, B0); G_BAR; G_SCHED;
            G_LDB(B1, 1, 1); G_STAGE(G_SB(1, 0), b3, voffB);
            G_BAR; G_WAIT_L(0); G_MMA(0, 1, At, B1); G_BAR;
            G_LDA(At, 1, 1); G_STAGE(G_SA(1, 0), a3, voffA);
            G_BAR; G_WAIT_L(0); G_MMA(1, 0, At, B0); G_BAR; G_SCHED;
            G_STAGE(G_SB(1, 1), b3 + hstepB, voffB);
            G_WAIT_V(6); G_BAR; G_MMA(1, 1, At, B1); G_BAR;
        }
        E(acc, cur, wr, wc, fr, fq);
        if (!has_next) break;
#pragma unroll
        for (int a = 0; a < 2; ++a)
#pragma unroll
            for (int b = 0; b < 2; ++b)
#pragma unroll
                for (int m = 0; m < 4; ++m)
#pragma unroll
                    for (int n = 0; n < 2; ++n) acc[a][b][m][n] = (f32x4){0.f, 0.f, 0.f, 0.f};
        cur = nxt; cA = nA; cB = nB; ++ui;
    }
    G_WAIT_V(0);
    if (wr == 0) G_BAR;
    G_BAR;
#undef G_SA
#undef G_SB
#undef G_STAGE
#undef G_LDA
#undef G_LDB
#undef G_MMA
}

#define EPI_ARGS const f32x4 (&acc)[2][2][4][2], const Unit& u, int wr, int wc, int fr, int fq
DI u32x4 pack8(const f32x4 v0, const f32x4 v1) { u32x4 w; w.x = cvt_pk_bf16(v0[0], v0[1]); w.y = cvt_pk_bf16(v0[2], v0[3]); w.z = cvt_pk_bf16(v1[0], v1[1]); w.w = cvt_pk_bf16(v1[2], v1[3]); return w; }

struct EpiAbIn {
    bf16_t* aslab; bf16_t* glu;
    DI void operator()(EPI_ARGS) const {
        const int row0 = u.pm * BM + wr * 64 + fr;
#pragma unroll
        for (int ai = 0; ai < 2; ++ai)
#pragma unroll
            for (int m = 0; m < 4; ++m) { const int R = row0 + ai * HALF + m * 16;
                if (u.pn < 2) {
#pragma unroll
                    for (int bj = 0; bj < 2; ++bj) { const int col = u.pn * BM + bj * HALF + wc * 32 + 8 * fq;
                        *(u32x4*)(aslab + ((size_t)(col >> 3) * NR + R) * 8) = pack8(acc[ai][bj][m][0], acc[ai][bj][m][1]); }
                } else {
                    f32x4 g0, g1;
#pragma unroll
                    for (int j = 0; j < 4; ++j) { g0[j] = acc[ai][0][m][0][j] * sigmoidf_(acc[ai][1][m][0][j]); g1[j] = acc[ai][0][m][1][j] * sigmoidf_(acc[ai][1][m][1][j]); }
                    *(u32x4*)(glu + (size_t)R * 512 + (u.pn - 2) * 128 + wc * 32 + 8 * fq) = pack8(g0, g1);
                } }
    }
};
struct EpiPool {
    bf16_t* ycat; const float* pb; const float* ps;
    DI void operator()(EPI_ARGS) const {
        const int row0 = u.pm * BM + wr * 64 + fr;
#pragma unroll
        for (int bj = 0; bj < 2; ++bj) { const int col = u.pn * BM + bj * HALF + wc * 32 + 8 * fq;
            const f32x4 b0 = *(const f32x4*)(pb + col), b1 = *(const f32x4*)(pb + col + 4), s0 = *(const f32x4*)(ps + col), s1 = *(const f32x4*)(ps + col + 4);
#pragma unroll
            for (int ai = 0; ai < 2; ++ai)
#pragma unroll
                for (int m = 0; m < 4; ++m) { const int R = row0 + ai * HALF + m * 16;
                    *(u32x4*)(ycat + (size_t)R * 1024 + col) = pack8((acc[ai][bj][m][0] + b0) * s0, (acc[ai][bj][m][1] + b1) * s1); } }
    }
};
struct EpiRes {
    const _Float16* src; _Float16* dst; const float* gate; int row_sub; float* pa; float* pb;
    DI void operator()(EPI_ARGS) const {
        if (pa != nullptr) {
            float* pd = (u.sub & 1) ? pb : pa; const int prow = (u.sub >> 1) * 1024 + u.pm * BM + wr * 64 + fr;
#pragma unroll
            for (int bj = 0; bj < 2; ++bj) { const int col = u.pn * BM + bj * HALF + wc * 32 + 8 * fq;
                const f32x4 g0 = *(const f32x4*)(gate + col), g1 = *(const f32x4*)(gate + col + 4);
#pragma unroll
                for (int ai = 0; ai < 2; ++ai)
#pragma unroll
                    for (int m = 0; m < 4; ++m) { float* o = pd + (size_t)(prow + ai * HALF + m * 16) * 1024 + col;
                        *(f32x4*)o = acc[ai][bj][m][0] * g0; *(f32x4*)(o + 4) = acc[ai][bj][m][1] * g1; } }
            return; }
        const int row0 = u.sub * row_sub + u.pm * BM + wr * 64 + fr;
#pragma unroll
        for (int ai = 0; ai < 2; ++ai)
#pragma unroll
            for (int m = 0; m < 4; ++m) { const int R = row0 + ai * HALF + m * 16; const float* gp = gate + (size_t)row_bm(R) * 6144;
#pragma unroll
                for (int bj = 0; bj < 2; ++bj) { const int col = u.pn * BM + bj * HALF + wc * 32 + 8 * fq;
                    const f32x4 g0 = *(const f32x4*)(gp + col), g1 = *(const f32x4*)(gp + col + 4);
                    const f16x8 hv = *(const f16x8*)(src + (size_t)R * 1024 + col); f16x8 o;
#pragma unroll
                    for (int j = 0; j < 4; ++j) { o[j] = (_Float16)(ALPHA * (float)hv[j] + g0[j] * acc[ai][bj][m][0][j]); o[4 + j] = (_Float16)(ALPHA * (float)hv[4 + j] + g1[j] * acc[ai][bj][m][1][j]); }
                    *(f16x8*)(dst + (size_t)R * 1024 + col) = o; } }
    }
};
struct EpiFfnIn {
    bf16_t* hid; int row_sub;
    DI void operator()(EPI_ARGS) const {
        const int row0 = u.sub * row_sub + u.pm * BM + wr * 64 + fr;
#pragma unroll
        for (int ai = 0; ai < 2; ++ai)
#pragma unroll
            for (int m = 0; m < 4; ++m) { const int R = row0 + ai * HALF + m * 16; f32x4 g0, g1;
#pragma unroll
                for (int j = 0; j < 4; ++j) { g0[j] = siluf_(acc[ai][0][m][0][j]) * acc[ai][1][m][0][j]; g1[j] = siluf_(acc[ai][0][m][1][j]) * acc[ai][1][m][1][j]; }
                *(u32x4*)(hid + (size_t)R * FF + u.pn * 128 + wc * 32 + 8 * fq) = pack8(g0, g1); }
    }
};
struct EpiPlain {
    bf16_t* out; int ld;
    DI void operator()(EPI_ARGS) const {
        const int row0 = u.pm * BM + wr * 64 + fr;
#pragma unroll
        for (int ai = 0; ai < 2; ++ai)
#pragma unroll
            for (int m = 0; m < 4; ++m) { const int R = row0 + ai * HALF + m * 16;
#pragma unroll
                for (int bj = 0; bj < 2; ++bj) { const int col = u.pn * BM + bj * HALF + wc * 32 + 8 * fq;
                    *(u32x4*)(out + (size_t)R * ld + col) = pack8(acc[ai][bj][m][0], acc[ai][bj][m][1]); } }
    }
};
struct EpiQK {
    bf16_t* q; bf16_t* k;
    DI void operator()(EPI_ARGS) const {
        const int which = u.sub >> 2, h = u.sub & 3; bf16_t* dst = which ? k : q; const float sc = which ? KSCALE : 1.0f;
        const int row0 = u.pm * BM + wr * 64 + fr;
#pragma unroll
        for (int ai = 0; ai < 2; ++ai)
#pragma unroll
            for (int m = 0; m < 4; ++m) { const int r = row0 + ai * HALF + m * 16; bf16_t* rp = dst + (((size_t)(r >> 6) * 4 + h) * 64 + (r & 63)) * 512;
#pragma unroll
                for (int bj = 0; bj < 2; ++bj) { const int col = u.pn * BM + bj * HALF + wc * 32 + 8 * fq;
                    *(u32x4*)(rp + col) = pack8(acc[ai][bj][m][0] * sc, acc[ai][bj][m][1] * sc); } }
    }
};
struct EpiVT {
    bf16_t* vt;
    DI void operator()(EPI_ARGS) const {
        const int h = u.sub; const int row0 = u.pm * BM + wr * 64 + fr;
#pragma unroll
        for (int ai = 0; ai < 2; ++ai)
#pragma unroll
            for (int m = 0; m < 4; ++m) { const int dv = row0 + ai * HALF + m * 16;
#pragma unroll
                for (int bj = 0; bj < 2; ++bj) { const int r = u.pn * BM + bj * HALF + wc * 32 + 8 * fq;
                    *(u32x4*)(vt + (((size_t)(r >> 6) * 4 + h) * 512 + dv) * 64 + (r & 63)) = pack8(acc[ai][bj][m][0], acc[ai][bj][m][1]); } }
    }
};

struct TJob { const float* src; bf16_t* dst; int K, N, sld, dld, map, ntile; };
DI int srccol(int map, int n) {
    if (map == 1) { if (n < 512) return n; const int j = (n - 512) >> 8, w = (n - 512) & 255; return w < 128 ? 512 + 128 * j + w : 1024 + 128 * j + (w - 128); }
    if (map == 2) { const int j = n >> 8, w = n & 255; return w < 128 ? 128 * j + w : FF + 128 * j + (w - 128); }
    return n;
}
constexpr int NJOB = 24;
DI TJob get_job(const Params& p, int j) {
    TJob t; bf16_t* W = (bf16_t*)p.out; t.map = 0;
    if (j == 0) { t.src = p.in[8]; t.dst = (bf16_t*)(p.out + W_ABIN); t.K = 1024; t.N = 1536; t.sld = 1536; t.dld = 1024; t.map = 1; }
    else if (j == 1) { t.src = p.in[16]; t.dst = (bf16_t*)(p.out + W_ABOUT); t.K = 1024; t.N = 1024; t.sld = 1024; t.dld = 1024; }
    else if (j < 4) { const int l = j - 2; t.src = p.in[28] + (size_t)l * 1024 * 5632; t.dst = (bf16_t*)(p.out + W_FFNIN + (size_t)l * 11534336); t.K = 1024; t.N = 5632; t.sld = 5632; t.dld = 1024; t.map = 2; }
    else if (j < 6) { const int l = j - 4; t.src = p.in[29] + (size_t)l * FF * 1024; t.dst = (bf16_t*)(p.out + W_FFNOUT + (size_t)l * 5767168); t.K = FF; t.N = 1024; t.sld = 1024; t.dld = FF; }
    else if (j == 6) { t.src = p.in[17]; t.dst = (bf16_t*)(p.out + W_MLIN); t.K = 1024; t.N = 4096; t.sld = 4096; t.dld = 1024; }
    else if (j < 19) { const int w = (j - 7) >> 2, h = (j - 7) & 3; t.src = p.in[w == 0 ? 20 : (w == 1 ? 21 : 22)] + (size_t)h * 512 * 512; t.dst = (bf16_t*)(p.out + W_Q + (size_t)w * 2097152) + (size_t)h * 512 * 512; t.K = 512; t.N = 512; t.sld = 512; t.dld = 512; }
    else if (j == 19) { t.src = p.in[27]; t.dst = (bf16_t*)(p.out + W_MLOUT); t.K = 2048; t.N = 1024; t.sld = 1024; t.dld = 2048; }
    else { const int g = j - 20; t.src = p.in[9] + (size_t)g * 128 * 128; t.dst = (bf16_t*)(p.out + W_POOL) + (size_t)g * 128 * 512 + g * 128; t.K = 128; t.N = 128; t.sld = 128; t.dld = 512; }
    (void)W; t.ntile = (t.K / 64) * (t.N / 64); return t;
}
__device__ void phase_prep(const Params& p, LAS unsigned char* lds) {
    const int tid = TIDX, G = 256;
    LAS float* tile = (LAS float*)lds;
    int base = 0;
    for (int j = 0; j < NJOB; ++j) {
        const TJob t = get_job(p, j); const int nkt = t.K / 64;
        for (int ti = blockIdx.x - base; ti < t.ntile; ti += G) { if (ti < 0) continue;
            const int kt = ti % nkt, nt_ = ti / nkt, k0 = kt * 64, n0 = nt_ * 64, sc0 = srccol(t.map, n0);
            const int i = tid >> 6, jj = tid & 63;
#pragma unroll
            for (int rr = 0; rr < 8; ++rr) tile[(i * 8 + rr) * 65 + jj] = t.src[(size_t)(k0 + i * 8 + rr) * t.sld + sc0 + jj];
            __syncthreads();
#pragma unroll
            for (int rr = 0; rr < 8; ++rr) { const int n = i * 8 + rr; t.dst[(size_t)(n0 + n) * t.dld + k0 + jj] = (bf16_t)(cvt_pk_bf16(tile[jj * 65 + n], 0.f) & 0xffffu); }
            __syncthreads();
        }
        base += t.ntile; while (base >= G) base -= G;
    }
    { bf16_t* wp = (bf16_t*)(p.out + W_POOL);
      for (int i = blockIdx.x * 512 + tid; i < 512 * 512; i += G * 512) { const int n = i >> 9, k = i & 511; if ((n >> 7) != (k >> 7)) wp[i] = 0; } }
    { LAS float* sc = (LAS float*)lds;
      LAS float* red = (LAS float*)(lds + 9 * 1024 * 4);
      __syncthreads();
      for (int i = tid; i < 9 * 1024; i += 512) { const float v = i < 8192 ? p.in[1][i] : p.in[3][i - 8192]; sc[i] = siluf_(v); }
      __syncthreads();
      float* mods = (float*)(p.out + W_MODS);
      for (int job = blockIdx.x; job < 96; job += G) {
          const int l = job / 48, nb = job % 48, col = nb * 128 + (tid & 127), kq = tid >> 7;
          const float* w = p.in[4] + (size_t)l * 1024 * 6144 + col;
          float a[9];
#pragma unroll
          for (int b = 0; b < 9; ++b) a[b] = 0.f;
#pragma unroll 4
          for (int k = kq * 256; k < kq * 256 + 256; ++k) { const float wv = __builtin_nontemporal_load(w + (size_t)k * 6144);
#pragma unroll
              for (int b = 0; b < 9; ++b) a[b] += sc[b * 1024 + k] * wv; }
#pragma unroll
          for (int b = 0; b < 9; ++b) red[(kq * 9 + b) * 128 + (tid & 127)] = a[b];
          __syncthreads();
          for (int i = tid; i < 9 * 128; i += 512) { const int b = i >> 7, c = i & 127;
              mods[((size_t)l * 9 + b) * 6144 + nb * 128 + c] = red[(0 * 9 + b) * 128 + c] + red[(1 * 9 + b) * 128 + c] + red[(2 * 9 + b) * 128 + c] + red[(3 * 9 + b) * 128 + c] + p.in[5][(size_t)l * 6144 + nb * 128 + c]; }
          __syncthreads();
      } }
    { const int wave = (blockIdx.x * 512 + tid) >> 6, lane = tid & 63, nw = G * 8;
      bf16_t* aqk = (bf16_t*)(p.out + W_AQK); bf16_t* av = (bf16_t*)(p.out + W_AV);
      for (int job = wave; job < 4096; job += nw) {
          const int isv = job >> 11, hc = job & 2047, h = hc >> 9, c = hc & 511;
          float a[16];
#pragma unroll
          for (int g = 0; g < 16; ++g) a[g] = 0.f;
          const int npass = isv ? 1 : 2;
          for (int ps = 0; ps < npass; ++ps) {
              const int which = isv ? 2 : ps;
              const float* wrow = p.in[which == 0 ? 20 : (which == 1 ? 21 : 22)] + ((size_t)h * 512 + c) * 512 + lane * 8;
#pragma unroll
              for (int e = 0; e < 8; ++e) { const float wv = wrow[e]; const int ef = h * 512 + lane * 8 + e;
#pragma unroll
                  for (int z = 0; z < 2; ++z) { const float* gp = p.in[23] + (((size_t)z * 3 + which) * 2048 + ef) * 8;
#pragma unroll
                      for (int jx = 0; jx < 8; ++jx) a[z * 8 + jx] += wv * gp[jx]; } }
          }
#pragma unroll
          for (int g = 0; g < 16; ++g) { const float s = wave_sum(a[g]); if (lane == g) (isv ? av : aqk)[(size_t)g * 2048 + hc] = (bf16_t)(cvt_pk_bf16(s, 0.f) & 0xffffu); }
      } }
}

__device__ void phase_embed(const Params& p) {
    const int tid_ = TIDX; const int wave = (blockIdx.x * 512 + tid_) >> 6, lane = tid_ & 63, nw = 2048;
    const float* mods = (const float*)(p.out + W_MODS); _Float16* hb = (_Float16*)(p.out + O_HB); bf16_t* ub = (bf16_t*)(p.ws + S_UB);
    for (int R = wave; R < NR; R += nw) {
        const float* src = row_src(p, R); const float* mp = mods + (size_t)row_bm(R) * 6144;
#pragma unroll
        for (int i = 0; i < 2; ++i) { const int c = lane * 8 + i * 512;
            const f32x4 x0 = *(const f32x4*)(src + c), x1 = *(const f32x4*)(src + c + 4);
            const f32x4 sh0 = *(const f32x4*)(mp + c), sh1 = *(const f32x4*)(mp + c + 4), sc0 = *(const f32x4*)(mp + 1024 + c), sc1 = *(const f32x4*)(mp + 1024 + c + 4);
            f16x8 hv;
#pragma unroll
            for (int j = 0; j < 4; ++j) { hv[j] = (_Float16)x0[j]; hv[4 + j] = (_Float16)x1[j]; }
            *(f16x8*)(hb + (size_t)R * 1024 + c) = hv;
            *(u32x4*)(ub + (size_t)R * 1024 + c) = pack8(x0 * (sc0 + 1.0f) + sh0, x1 * (sc1 + 1.0f) + sh1); }
    }
}
__device__ void phase_ln(const Params& p, const _Float16* tsrc, int l, int which, int mod_l, int mod_idx, int mode, float probe_b = 0.f, const float* cpa = nullptr, const float* cpb = nullptr) {
    const int tid_ = TIDX; const int wave = (blockIdx.x * 512 + tid_) >> 6, lane = tid_ & 63, nw = 2048;
    const float* mods = (const float*)(p.out + W_MODS) + (size_t)(mod_l < 0 ? 0 : mod_l) * 9 * 6144; _Float16* hb = (_Float16*)(p.out + O_HB); bf16_t* ub = (bf16_t*)(p.ws + S_UB);
    const float* lg = p.in[6] + ((size_t)l * 2 + which) * 1024; const float* lb = p.in[7] + ((size_t)l * 2 + which) * 1024;
    f16x8 n0 = *(const f16x8*)(tsrc + (size_t)wave * 1024 + lane * 8), n1 = *(const f16x8*)(tsrc + (size_t)wave * 1024 + 512 + lane * 8);
    for (int R = wave; R < NR; R += nw) {
        const f16x8 t0 = n0, t1 = n1;
        if (R + nw < NR) { n0 = *(const f16x8*)(tsrc + (size_t)(R + nw) * 1024 + lane * 8); n1 = *(const f16x8*)(tsrc + (size_t)(R + nw) * 1024 + 512 + lane * 8); }
        const int hf = R >= HR ? 1 : 0, r = R - hf * HR; if (mode != 0 && r >= HLAT) continue;
        float x[16]; float s = 0.f;
#pragma unroll
        for (int j = 0; j < 8; ++j) { x[j] = (float)t0[j]; x[8 + j] = (float)t1[j]; }
        if (cpa != nullptr && r >= HLAT) {
            const size_t o = (size_t)(hf * 1024 + (r - HLAT)) * 1024 + lane * 8;
#pragma unroll
            for (int i = 0; i < 2; ++i) { const f32x4 a0 = *(const f32x4*)(cpa + o + i * 512), a1 = *(const f32x4*)(cpa + o + i * 512 + 4), b0 = *(const f32x4*)(cpb + o + i * 512), b1 = *(const f32x4*)(cpb + o + i * 512 + 4);
#pragma unroll
                for (int j = 0; j < 4; ++j) { x[i * 8 + j] = ALPHA * x[i * 8 + j] + (a0[j] + b0[j]); x[i * 8 + 4 + j] = ALPHA * x[i * 8 + 4 + j] + (a1[j] + b1[j]); } } }
#pragma unroll
        for (int j = 0; j < 16; ++j) s += x[j];
        const float mu = wave_sum(s) * (1.0f / 1024.0f); float q = 0.f;
#pragma unroll
        for (int j = 0; j < 16; ++j) { x[j] -= mu; q += x[j] * x[j]; }
        const float rstd = rsqrtf(wave_sum(q) * (1.0f / 1024.0f) + LNEPS);
        const float* mp = mods + (size_t)row_bm(R) * 6144;
#pragma unroll
        for (int i = 0; i < 2; ++i) { const int c = lane * 8 + i * 512;
            const f32x4 g0 = *(const f32x4*)(lg + c), g1 = *(const f32x4*)(lg + c + 4), b0 = *(const f32x4*)(lb + c), b1 = *(const f32x4*)(lb + c + 4);
            f32x4 h0, h1;
#pragma unroll
            for (int j = 0; j < 4; ++j) { h0[j] = x[i * 8 + j] * rstd * g0[j] + b0[j]; h1[j] = x[i * 8 + 4 + j] * rstd * g1[j] + b1[j]; }
            if (mode == 2) {
#ifdef PROBE
                if (hf == 1) { h0 += probe_b; h1 += probe_b; }
#endif
                float* o = (float*)p.out + ((size_t)(hf * 4 + (r >> 12)) * SEQ + (r & 4095)) * DM + c;
                *(f32x4*)o = h0; *(f32x4*)(o + 4) = h1;
            } else {
                f16x8 hv;
#pragma unroll
                for (int j = 0; j < 4; ++j) { hv[j] = (_Float16)h0[j]; hv[4 + j] = (_Float16)h1[j]; }
                *(f16x8*)(hb + (size_t)R * 1024 + c) = hv;
                const f32x4 sh0 = *(const f32x4*)(mp + mod_idx * 1024 + c), sh1 = *(const f32x4*)(mp + mod_idx * 1024 + c + 4);
                const f32x4 sc0 = *(const f32x4*)(mp + (mod_idx + 1) * 1024 + c), sc1 = *(const f32x4*)(mp + (mod_idx + 1) * 1024 + c + 4);
                *(u32x4*)(ub + (size_t)R * 1024 + c) = pack8(h0 * (sc0 + 1.0f) + sh0, h1 * (sc1 + 1.0f) + sh1);
            } }
    }
}

template <int W>
DI void box64(const float (&v)[64], LAS float* dst, int stride) {
#pragma unroll
    for (int t = 0; t < 64; ++t) { const int lo = t - W / 2 < 0 ? 0 : t - W / 2, hi = t + W - W / 2 > 64 ? 64 : t + W - W / 2; float s = 0.f;
#pragma unroll
        for (int j = lo; j < hi; ++j) s += v[j];
        dst[t * stride] = s * (1.0f / (float)(hi - lo)); }
}
template <int W>
DI void pool_lat_item(bf16_t* slab  , LAS float* buf) {
    const int tid = TIDX;
#pragma unroll
    for (int i = 0; i < 8; ++i) { const int t = tid + i * 512; const u32x4 w = *(const u32x4*)(slab + (size_t)t * 8); LAS float* d = buf + t * 8 + (t >> 6) * 8;
        *(LAS f32x4*)d = (f32x4){bflo(w.x), bfhi(w.x), bflo(w.y), bfhi(w.y)}; *(LAS f32x4*)(d + 4) = (f32x4){bflo(w.z), bfhi(w.z), bflo(w.w), bfhi(w.w)}; }
    __syncthreads();
    { const int c = tid >> 3, ch = tid & 7; float v[64];
#pragma unroll
      for (int r = 0; r < 64; ++r) v[r] = buf[r * 520 + c * 8 + ch];
      box64<W>(v, buf + c * 8 + ch, 520); }
    __syncthreads();
    { const int r = tid >> 3, ch = tid & 7; float v[64];
#pragma unroll
      for (int c = 0; c < 64; ++c) v[c] = buf[r * 520 + c * 8 + ch];
      box64<W>(v, buf + r * 520 + ch, 8); }
    __syncthreads();
#pragma unroll
    for (int i = 0; i < 8; ++i) { const int t = tid + i * 512; const u32x4 w = *(const u32x4*)(slab + (size_t)t * 8); const LAS float* d = buf + t * 8 + (t >> 6) * 8;
        const f32x4 p0 = *(const LAS f32x4*)d, p1 = *(const LAS f32x4*)(d + 4);
        const f32x4 s0 = (f32x4){bflo(w.x), bfhi(w.x), bflo(w.y), bfhi(w.y)}, s1 = (f32x4){bflo(w.z), bfhi(w.z), bflo(w.w), bfhi(w.w)};
        *(u32x4*)(slab + (size_t)t * 8) = pack8(p0 - s0, p1 - s1); }
    __syncthreads();
}
__device__ void phase_poolconv(const Params& p, LAS unsigned char* lds) {
    const int tid = TIDX, G = 256;
    bf16_t* aslab = (bf16_t*)(p.ws + S_R1); const bf16_t* glu = (const bf16_t*)(p.ws + S_R1 + 34 * MiB); bf16_t* ycat = (bf16_t*)(p.ws + S_R2);
    const int NPL = 512, NCV = 1088, NPC = 512;
    for (int it = blockIdx.x; it < NPL + NCV + NPC; it += G) {
        if (it < NPL) {
            const int b = it >> 6, sl = it & 63; const int R0 = (b >> 2) * HR + (b & 3) * SEQ;
            bf16_t* slab = aslab + ((size_t)sl * NR + R0) * 8; LAS float* buf = (LAS float*)lds;
            const int gi = sl >> 4;
            if (gi == 0) pool_lat_item<2>(slab, buf); else if (gi == 1) pool_lat_item<4>(slab, buf); else if (gi == 2) pool_lat_item<8>(slab, buf); else pool_lat_item<16>(slab, buf);
        } else if (it < NPL + NCV) {
            const int ci = it - NPL; int R0, len, t0;
            if (ci < 1024) { const int b = ci >> 7; R0 = (b >> 2) * HR + (b & 3) * SEQ; len = SEQ; t0 = (ci & 127) * 32; }
            else { const int cj = ci - 1024, b = cj >> 3; R0 = (b >> 2) * HR + HLAT + (b & 3) * CTXL; len = CTXL; t0 = (cj & 7) * 32; }
            LAS unsigned* gin = (LAS unsigned*)lds;
            LAS float* cout = (LAS float*)(lds + 62 * 1024);
            for (int i = tid; i < 62 * 64; i += 512) { const int rr = i >> 6, cc = i & 63, t = t0 - 15 + rr;
                u32x4 w = (u32x4){0u, 0u, 0u, 0u}; if (t >= 0 && t < len) w = *(const u32x4*)(glu + (size_t)(R0 + t) * 512 + cc * 8);
                *(LAS u32x4*)(gin + rr * 256 + cc * 4) = w; }
            __syncthreads();
            { const float* cw = p.in[12] + tid; float w[31];
#pragma unroll
              for (int j = 0; j < 31; ++j) w[j] = cw[j * 512];
              float a[32]; const float cb0 = p.in[13][tid];
#pragma unroll
              for (int t = 0; t < 32; ++t) a[t] = cb0;
              const LAS unsigned short* gs = (const LAS unsigned short*)gin + tid;
#pragma unroll
              for (int rr = 0; rr < 62; ++rr) { const float x = bf2f(gs[rr * 512]);
#pragma unroll
                  for (int t = 0; t < 32; ++t) { const int j = rr - t; if (j >= 0 && j < 31) a[t] += w[j] * x; } }
#pragma unroll
              for (int t = 0; t < 32; ++t) cout[t * 512 + tid] = a[t]; }
            __syncthreads();
            { const int wv = tid >> 6, lane = tid & 63;
              for (int tt = 0; tt < 4; ++tt) { const int t = wv * 4 + tt; const LAS float* rp = cout + t * 512 + lane * 8;
                  const f32x4 v0 = *(const LAS f32x4*)rp, v1 = *(const LAS f32x4*)(rp + 4);
                  float s = (v0[0] + v0[1]) + (v0[2] + v0[3]) + (v1[0] + v1[1]) + (v1[2] + v1[3]);
                  const float mu = wave_sum(s) * (1.0f / 512.0f); const f32x4 d0 = v0 - mu, d1 = v1 - mu;
                  float q = d0[0] * d0[0] + d0[1] * d0[1] + d0[2] * d0[2] + d0[3] * d0[3] + d1[0] * d1[0] + d1[1] * d1[1] + d1[2] * d1[2] + d1[3] * d1[3];
                  const float rstd = rsqrtf(wave_sum(q) * (1.0f / 512.0f) + LNEPS);
                  const float* ng = p.in[14] + lane * 8; const float* nb = p.in[15] + lane * 8; f32x4 y0, y1;
#pragma unroll
                  for (int j = 0; j < 4; ++j) { y0[j] = siluf_(d0[j] * rstd * ng[j] + nb[j]); y1[j] = siluf_(d1[j] * rstd * ng[4 + j] + nb[4 + j]); }
                  *(u32x4*)(ycat + (size_t)(R0 + t0 + t) * 1024 + 512 + lane * 8) = pack8(y0, y1); } }
            __syncthreads();
        } else {
            const int pi = it - NPL - NCV, b = pi >> 6, sl = pi & 63; const int R0 = (b >> 2) * HR + HLAT + (b & 3) * CTXL; const int W = 2 << (sl >> 4);
            bf16_t* slab = aslab + ((size_t)sl * NR + R0) * 8; LAS float* buf = (LAS float*)lds;
            if (tid < 256) { const u32x4 w = *(const u32x4*)(slab + (size_t)tid * 8);
                *(LAS f32x4*)(buf + tid * 8) = (f32x4){bflo(w.x), bfhi(w.x), bflo(w.y), bfhi(w.y)}; *(LAS f32x4*)(buf + tid * 8 + 4) = (f32x4){bflo(w.z), bfhi(w.z), bflo(w.w), bfhi(w.w)}; }
            __syncthreads();
            f32x4 d = (f32x4){0.f, 0.f, 0.f, 0.f}; const int t = tid >> 1, hc = (tid & 1) * 4;
            { const int lo = t - W / 2 < 0 ? 0 : t - W / 2, hi = t + W - W / 2 > 256 ? 256 : t + W - W / 2; f32x4 s = (f32x4){0.f, 0.f, 0.f, 0.f};
              for (int j = lo; j < hi; ++j) s += *(const LAS f32x4*)(buf + j * 8 + hc);
              d = s * (1.0f / (float)(hi - lo)) - *(const LAS f32x4*)(buf + t * 8 + hc); }
            u32x2 o; o.x = cvt_pk_bf16(d[0], d[1]); o.y = cvt_pk_bf16(d[2], d[3]);
            *(u32x2*)(slab + (size_t)t * 8 + hc) = o;
            __syncthreads();
        }
    }
}

__device__ void phase_mlconv(const Params& p, int hf) {
    const int tid_ = TIDX; const int wave = (blockIdx.x * 512 + tid_) >> 6, lane = tid_ & 63, nw = 2048, tk = lane & 15, g = lane >> 4;
    const bf16_t* xm = (const bf16_t*)(p.ws + S_R1); bf16_t* xc = (bf16_t*)(p.ws + S_R2); float* gates = (float*)(p.ws + S_GATES);
    const bf16_t* aqk = (const bf16_t*)(p.out + W_AQK); const bf16_t* av = (const bf16_t*)(p.out + W_AV);
    const float* cw = p.in[18]; const float* cb = p.in[19];
    (void)wave; (void)nw;
    for (int it = (tid_ >> 6) * 256 + (int)blockIdx.x; it < HR / 16; it += 2048) {
        const int r = it * 16 + tk; const int pos = r < HLAT ? (r & 4095) : ((r - HLAT) & 255), len = r < HLAT ? SEQ : CTXL;
        const bool hasp = pos > 0, hasn = pos < len - 1;
        f32x4 acc = (f32x4){0.f, 0.f, 0.f, 0.f};
#pragma unroll 2
        for (int ks = 0; ks < 64; ++ks) { const int c0 = ks * 32 + g * 8;
            const u32x4 z4 = (u32x4){0u, 0u, 0u, 0u};
            const u32x4 wc_ = *(const u32x4*)(xm + (size_t)r * 2048 + c0);
            const u32x4 wp = hasp ? *(const u32x4*)(xm + (size_t)(r - 1) * 2048 + c0) : z4;
            const u32x4 wn = hasn ? *(const u32x4*)(xm + (size_t)(r + 1) * 2048 + c0) : z4;
            float o[8];
            float w0v[8], w1v[8], w2v[8], bbv[8];
            { const f32x4 a0 = *(const f32x4*)(cw + c0), a1 = *(const f32x4*)(cw + c0 + 4), b0 = *(const f32x4*)(cw + 2048 + c0), b1 = *(const f32x4*)(cw + 2048 + c0 + 4);
              const f32x4 c0v = *(const f32x4*)(cw + 4096 + c0), c1v = *(const f32x4*)(cw + 4096 + c0 + 4), d0 = *(const f32x4*)(cb + c0), d1 = *(const f32x4*)(cb + c0 + 4);
#pragma unroll
              for (int e = 0; e < 4; ++e) { w0v[e] = a0[e]; w0v[4 + e] = a1[e]; w1v[e] = b0[e]; w1v[4 + e] = b1[e]; w2v[e] = c0v[e]; w2v[4 + e] = c1v[e]; bbv[e] = d0[e]; bbv[4 + e] = d1[e]; } }
#pragma unroll
            for (int j = 0; j < 4; ++j) { const unsigned a = wp[j], b = wc_[j], c = wn[j];
                o[2 * j] = siluf_(w0v[2 * j] * bflo(a) + w1v[2 * j] * bflo(b) + w2v[2 * j] * bflo(c) + bbv[2 * j]);
                o[2 * j + 1] = siluf_(w0v[2 * j + 1] * bfhi(a) + w1v[2 * j + 1] * bfhi(b) + w2v[2 * j + 1] * bfhi(c) + bbv[2 * j + 1]); }
            u32x4 xo; xo.x = cvt_pk_bf16(o[0], o[1]); xo.y = cvt_pk_bf16(o[2], o[3]); xo.z = cvt_pk_bf16(o[4], o[5]); xo.w = cvt_pk_bf16(o[6], o[7]);
            *(u32x4*)(xc + (size_t)r * 2048 + c0) = xo;
            const bf16x8 bq = *(const bf16x8*)(aqk + (size_t)tk * 2048 + c0), bv = *(const bf16x8*)(av + (size_t)tk * 2048 + c0);
            acc = __builtin_amdgcn_mfma_f32_16x16x32_bf16(__builtin_bit_cast(bf16x8, xo), bq, acc, 0, 0, 0);
            acc = __builtin_amdgcn_mfma_f32_16x16x32_bf16(__builtin_bit_cast(bf16x8, wc_), bv, acc, 0, 0, 0); }
        const float bg = p.in[24][tk];
#pragma unroll
        for (int i = 0; i < 4; ++i) { float v = acc[i] + bg; if ((tk & 7) >= 4) v = fminf(v, 0.f) - log1pf(__expf(-fabsf(v)));
            gates[((size_t)hf * HR + it * 16 + 4 * g + i) * 16 + tk] = v; }
    }
}

__device__ void phase_mlout(const Params& p) {
    const int tid_ = TIDX; const int wave = (blockIdx.x * 512 + tid_) >> 6, lane = tid_ & 63, nw = 2048;
    const bf16_t* hfw = (const bf16_t*)(p.ws + S_R1); const bf16_t* hbw = (const bf16_t*)(p.ws + S_R6); bf16_t* xc = (bf16_t*)(p.ws + S_R2); const bf16_t* z = (const bf16_t*)(p.ws + S_R3);
    const float* ng = p.in[25]; const float* sk = p.in[26];
    for (int r0 = wave * 4; r0 < HLAT; r0 += nw * 4) {
#pragma unroll 1
        for (int hh = 0; hh < 4; ++hh) { const int c = hh * 512 + lane * 8;
            float st[4][8];
#pragma unroll
            for (int b = 0; b < 4; ++b) { const size_t o = (size_t)(r0 + b) * 2048 + c; const u32x4 av = *(const u32x4*)(hfw + o), bv = *(const u32x4*)(hbw + o);
#pragma unroll
                for (int j = 0; j < 4; ++j) { st[b][2 * j] = bflo(av[j]) + bflo(bv[j]); st[b][2 * j + 1] = bfhi(av[j]) + bfhi(bv[j]); } }
            const f32x4 g0 = *(const f32x4*)(ng + c), g1 = *(const f32x4*)(ng + c + 4), k0 = *(const f32x4*)(sk + c), k1 = *(const f32x4*)(sk + c + 4);
#pragma unroll
            for (int a = 0; a < 4; ++a) { const size_t o = (size_t)(r0 + a) * 2048 + c; const u32x4 xw = *(const u32x4*)(xc + o), zw = *(const u32x4*)(z + o);
                float x[8]; float s = 0.f;
#pragma unroll
                for (int q = 0; q < 2; ++q)
#pragma unroll
                    for (int b = 0; b < 4; ++b) { x[4 * q + b] = st[b][4 * q + a]; s += x[4 * q + b]; }
                const float mu = wave_sum(s) * (1.0f / 512.0f); float qq = 0.f;
#pragma unroll
                for (int j = 0; j < 8; ++j) { x[j] -= mu; qq += x[j] * x[j]; }
                const float rstd = rsqrtf(wave_sum(qq) * (1.0f / 512.0f) + LNEPS);
                float y[8];
#pragma unroll
                for (int j = 0; j < 4; ++j) { const float gA = j < 2 ? g0[2 * j] : g1[2 * j - 4], gB = j < 2 ? g0[2 * j + 1] : g1[2 * j - 3], sA = j < 2 ? k0[2 * j] : k1[2 * j - 4], sB = j < 2 ? k0[2 * j + 1] : k1[2 * j - 3];
                    y[2 * j] = (x[2 * j] * rstd * gA + sA * bflo(xw[j])) * siluf_(bflo(zw[j]));
                    y[2 * j + 1] = (x[2 * j + 1] * rstd * gB + sB * bfhi(xw[j])) * siluf_(bfhi(zw[j])); }
                u32x4 w; w.x = cvt_pk_bf16(y[0], y[1]); w.y = cvt_pk_bf16(y[2], y[3]); w.z = cvt_pk_bf16(y[4], y[5]); w.w = cvt_pk_bf16(y[6], y[7]);
                *(u32x4*)(xc + o) = w; } }
    }
}

constexpr int QS_STRIDE = 1040, KT_STRIDE = 144, PS_STRIDE = 144;
constexpr int L_QS = 0, L_KT = 64 * QS_STRIDE  , L_PS = L_KT + 512 * KT_STRIDE  , PS_HALF = 64 * PS_STRIDE  , L_VEC = L_PS + 2 * PS_HALF  ;
static_assert(L_VEC + 3840 <= LDS_BYTES, "scan LDS");
#define LDS_BAR() asm volatile("s_waitcnt lgkmcnt(0)\n\ts_barrier" ::: "memory")
struct ScanPos { int chunk, rowbase; bool isctx; };
DI ScanPos scan_pos(int step, int dir, int bl) {
    ScanPos sp; sp.isctx = step < 4; const int ci = sp.isctx ? step : step - 4, nchunk = sp.isctx ? 4 : 64;
    const int cn = dir ? nchunk - 1 - ci : ci;
    sp.chunk = sp.isctx ? 256 + bl * 4 + cn : bl * 64 + cn;
    sp.rowbase = sp.isctx ? HLAT + bl * CTXL + cn * 64 : bl * SEQ + cn * 64;
    return sp;
}
__device__ void phase_pre(const Params& p, int hf) {
    const int tid_ = TIDX; const int wave = (blockIdx.x * 512 + tid_) >> 6, lane = tid_ & 63;
    const float* gates = (const float*)(p.ws + S_GATES) + (size_t)hf * HR * 16; float* pre = (float*)(p.ws + S_PRE);
    for (int job = wave; job < 32 * 68; job += 2048) { const int combo = job / 68, c = job - combo * 68, dir = combo & 1, h = (combo >> 1) & 3, bl = combo >> 3;
        const ScanPos sp = scan_pos(c, dir, bl); const int pp = dir ? 63 - lane : lane;
        const float ic = gates[(size_t)(sp.rowbase + pp) * 16 + dir * 8 + h], fc = gates[(size_t)(sp.rowbase + pp) * 16 + dir * 8 + 4 + h];
        float bcs = fc;
#pragma unroll
        for (int o = 1; o < 64; o <<= 1) { const float t = __shfl_up(bcs, o); if (lane >= o) bcs += t; }
        const float blast = __shfl(bcs, 63); const float mw = wave_max(blast - bcs + ic);
        float cm = ic - bcs;
#pragma unroll
        for (int o = 1; o < 64; o <<= 1) { const float t = __shfl_up(cm, o); if (lane >= o) cm = fmaxf(cm, t); }
        *(f32x4*)(pre + ((size_t)job * 64 + lane) * 4) = (f32x4){bcs, cm, ic, 0.f};
        if (lane == 0) { pre[PRE_V + job * 2] = blast; pre[PRE_V + job * 2 + 1] = mw; } }
}
__device__ void phase_intra(const Params& p, LAS unsigned char* lds) {
    const int tid = TIDX, wid = __builtin_amdgcn_readfirstlane(tid >> 6), lane = tid & 63, tk = lane & 15, g = lane >> 4;
    const bf16_t* qc = (const bf16_t*)(p.ws + S_R3); const bf16_t* kc = (const bf16_t*)(p.ws + S_R4); const bf16_t* vtc = (const bf16_t*)(p.ws + S_R5);
    const float* pre = (const float*)(p.ws + S_PRE); float* RS = (float*)(p.ws + S_RS);
    LAS float* A_ = (LAS float*)(lds + 2 * PS_HALF);
    LAS float* M_ = A_ + 128; LAS float* rsl = A_ + 256;
    for (int item = blockIdx.x; item < 1024; item += 256) {
        const int bl = item >> 8, h = (item >> 6) & 3, cn = item & 63; const int chunk = bl * 64 + cn, rowbase = bl * SEQ + cn * 64;
        if (wid < 2) { const int d = wid, combo = d + 2 * h + 8 * bl, kq = d ? 63 - cn : cn;
            const float* sc = pre + PRE_V + (size_t)combo * 68 * 2;
            float m4 = 0.f;
#pragma unroll
            for (int k = 0; k < 4; ++k) m4 = fmaxf(sc[k * 2] + m4, sc[k * 2 + 1]);
            float B = sc[(4 + lane) * 2], W = sc[(4 + lane) * 2 + 1];
#pragma unroll
            for (int o = 1; o < 64; o <<= 1) { const float Bp = __shfl_up(B, o), Wp = __shfl_up(W, o); if (lane >= o) { W = fmaxf(Wp + B, W); B = Bp + B; } }
            const float mafter = fmaxf(m4 + B, W); const float mprev = __shfl(mafter, kq > 0 ? kq - 1 : 0); const float mstart = kq > 0 ? mprev : m4;
            const f32x4 pv = *(const f32x4*)(pre + (((size_t)combo * 68 + 4 + kq) * 64 + lane) * 4); const int pp = d ? 63 - lane : lane;
            A_[d * 64 + pp] = pv[2] - pv[0]; M_[d * 64 + pp] = fmaxf(mstart, pv[1]); rsl[d * 64 + lane] = 0.f; }
        __syncthreads();
        {
            const int st = wid >> 1, tt0 = 2 * (wid & 1); f32x4 S0 = (f32x4){0.f, 0.f, 0.f, 0.f}, S1 = S0;
            const bf16_t* ka = kc + ((size_t)chunk * 4 + h) * 64 * 512 + (size_t)(st * 16 + tk) * 512 + g * 8;
            const bf16_t* qa = qc + ((size_t)chunk * 4 + h) * 64 * 512 + (size_t)(tt0 * 16 + tk) * 512 + g * 8;
#pragma unroll 8
            for (int kk = 0; kk < 16; ++kk) { const bf16x8 a = *(const bf16x8*)(ka + kk * 32), b0 = *(const bf16x8*)(qa + kk * 32), b1 = *(const bf16x8*)(qa + 16 * 512 + kk * 32);
                S0 = __builtin_amdgcn_mfma_f32_16x16x32_bf16(a, b0, S0, 0, 0, 0); S1 = __builtin_amdgcn_mfma_f32_16x16x32_bf16(a, b1, S1, 0, 0, 0); }
#pragma unroll
            for (int d = 0; d < 2; ++d)
#pragma unroll
                for (int x = 0; x < 2; ++x) { const int t = (tt0 + x) * 16 + tk; const float Mt = M_[d * 64 + t]; const f32x4 Sv = x ? S1 : S0; float pv[4]; float psum = 0.f;
#pragma unroll
                    for (int i = 0; i < 4; ++i) { const int sx = st * 16 + 4 * g + i; const bool ok = d ? (sx >= t) : (sx <= t);
                        const float dd = ok ? __expf(A_[d * 64 + sx] - Mt) : 0.f; pv[i] = Sv[i] * dd; psum += pv[i]; }
                    u32x2 w; w.x = cvt_pk_bf16(pv[0], pv[1]); w.y = cvt_pk_bf16(pv[2], pv[3]);
                    *(LAS u32x2*)(lds + d * PS_HALF + t * PS_STRIDE + (st * 16 + 4 * g) * 2) = w;
                    (void)psum; } }
        __syncthreads();
        {
            u32x4 va[4][2];
#pragma unroll
            for (int mi = 0; mi < 4; ++mi) { const bf16_t* vg = vtc + (((size_t)chunk * 4 + h) * 512 + wid * 64 + mi * 16 + tk) * 64; va[mi][0] = *(const u32x4*)(vg + g * 8); va[mi][1] = *(const u32x4*)(vg + 32 + g * 8); }
#pragma unroll
            for (int d = 0; d < 2; ++d) { bf16_t* hout = (bf16_t*)(p.ws + (d ? S_R6 : S_R1));
#pragma unroll
                for (int ni = 0; ni < 4; ++ni) { const bf16x8 pb0 = *(const LAS bf16x8*)(lds + d * PS_HALF + (ni * 16 + tk) * PS_STRIDE + (g * 8) * 2), pb1 = *(const LAS bf16x8*)(lds + d * PS_HALF + (ni * 16 + tk) * PS_STRIDE + (32 + g * 8) * 2);
#pragma unroll
                    for (int mi = 0; mi < 4; ++mi) { f32x4 acc = (f32x4){0.f, 0.f, 0.f, 0.f};
                        acc = __builtin_amdgcn_mfma_f32_16x16x32_bf16(pb0, __builtin_bit_cast(bf16x8, va[mi][0]), acc, 0, 0, 0);
                        acc = __builtin_amdgcn_mfma_f32_16x16x32_bf16(pb1, __builtin_bit_cast(bf16x8, va[mi][1]), acc, 0, 0, 0);
                        u32x2 w; w.x = cvt_pk_bf16_mfma(acc[0], acc[1]); w.y = cvt_pk_bf16_mfma(acc[2], acc[3]);
                        *(u32x2*)(hout + (size_t)(rowbase + ni * 16 + 4 * g + (tk & 3)) * 2048 + h * 512 + wid * 64 + mi * 16 + (tk & ~3)) = w; } } } }
        if (tid < 128) { const int d = tid >> 6, t = tid & 63; float sum = 0.f;
#pragma unroll
            for (int i = 0; i < 8; ++i) { const u32x4 w = *(const LAS u32x4*)(lds + d * PS_HALF + t * PS_STRIDE + i * 16); sum += (bflo(w.x) + bfhi(w.x)) + (bflo(w.y) + bfhi(w.y)) + (bflo(w.z) + bfhi(w.z)) + (bflo(w.w) + bfhi(w.w)); }
            RS[((size_t)(rowbase + t) * 2 + d) * 4 + h] = sum; }
        __syncthreads();
    }
}

__device__ void phase_scan(const Params& p, int hf, LAS unsigned char* lds) {
    const int tid0 = TIDX, wid = __builtin_amdgcn_readfirstlane(tid0 >> 6);
    const int wg = blockIdx.x, vs = wg >> 5, dir = wg & 1, h = (wg >> 1) & 3, bl = (wg >> 3) & 3;
    const int dvg = wid & 3, kh = wid >> 2;
    const bf16_t* qc = (const bf16_t*)(p.ws + S_R3); const bf16_t* kc = (const bf16_t*)(p.ws + S_R4); const bf16_t* vtc = (const bf16_t*)(p.ws + S_R5);
    bf16_t* hout = (bf16_t*)(p.ws + (dir ? S_R6 : S_R1));
    (void)hf;
    LAS float* vec = (LAS float*)(lds + L_VEC);
    LAS float* fin4 = vec  , *e_p = vec + 256, *iw_p = vec + 320, *qn = vec + 384;
    LAS unsigned* nbf = (LAS unsigned*)(vec + 448);
    LAS unsigned* ebf = (LAS unsigned*)(vec + 704);
    f32x4 C[16];
#pragma unroll
    for (int i = 0; i < 16; ++i) C[i] = (f32x4){0.f, 0.f, 0.f, 0.f};
    float nreg = 0.f; ((LAS unsigned short*)nbf)[tid0] = 0;
    float mstate = 0.f;
    const int dvw = vs * 64 + dvg * 16;
    const int combo = wg & 31; const float* pre = (const float*)(p.ws + S_PRE) + (size_t)combo * 68 * 256; const float* pres = (const float*)(p.ws + S_PRE) + PRE_V + (size_t)combo * 68 * 2;
    const float* RS = (const float*)(p.ws + S_RS);
    f32x4 pv_n; float bl_n, mw_n, rs_n = 0.f; u32x2 numi_n[2] = {(u32x2){0u, 0u}, (u32x2){0u, 0u}}; u32x4 kr[8];
    { const ScanPos s0 = scan_pos(0, dir, bl); const int lane = tid0 & 63, tk = lane & 15, g = lane >> 4, pp = dir ? 63 - lane : lane;
      (void)pp; pv_n = *(const f32x4*)(pre + (size_t)lane * 4); bl_n = pres[0]; mw_n = pres[1];
      const bf16_t* kg = kc + ((size_t)s0.chunk * 4 + h) * 64 * 512 + (size_t)((wid >> 1) * 16 + tk) * 512 + (wid & 1) * 256 + g * 8;
#pragma unroll
      for (int j = 0; j < 8; ++j) kr[j] = *(const u32x4*)(kg + j * 32); }
    __syncthreads();
    for (int step = 0; step < 68; ++step) {
        int tid = tid0; asm volatile("" : "+v"(tid));
        const int lane = tid & 63, tk = lane & 15, g = lane >> 4;
        const ScanPos cur = scan_pos(step, dir, bl); const bool isctx = cur.isctx; const int rowbase = cur.rowbase;
        const bool has_next = step < 67; const ScanPos nxt = scan_pos(has_next ? step + 1 : step, dir, bl);
        const int pp = dir ? 63 - lane : lane;
        const u32x2 numi_c0 = numi_n[0], numi_c1 = numi_n[1];
        const float bcs = pv_n[0], cm = pv_n[1], ic = pv_n[2], blast = bl_n;
        const float mnew = fmaxf(blast + mstate, mw_n);
        const float decay = __expf(blast + mstate - mnew);
        const float ev = __expf(blast - bcs + ic - mnew);
        const float av = ic - bcs;
        const float Mx = fmaxf(mstate, cm);
        if (wid == 0) { (void)av; const float iwv = __expf(mstate - Mx); e_p[pp] = ev; iw_p[pp] = iwv; fin4[pp * 4] = iwv; fin4[pp * 4 + 2] = __expf(-(bcs + Mx)); fin4[lane * 4 + 1] = rs_n; ((LAS unsigned short*)ebf)[pp] = (unsigned short)(cvt_pk_bf16(ev, 0.f) & 0xffffu); }
        { const int sel = tk & 1, srow = (wid >> 1) * 16 + tk, dk0 = (wid & 1) * 256 + g * 8 + (sel ? 4 : 0);
          LAS unsigned char* kb = lds + L_KT + dk0 * KT_STRIDE + (srow >> 1) * 4;
          const unsigned selLo = sel ? 0x05040100u : 0x01000504u, selHi = sel ? 0x07060302u : 0x03020706u;
#pragma unroll
          for (int j = 0; j < 8; ++j) { const u32x4 d = kr[j];
              const unsigned send0 = sel ? d[0] : d[2], send1 = sel ? d[1] : d[3], keep0 = sel ? d[2] : d[0], keep1 = sel ? d[3] : d[1];
              const unsigned recv0 = (unsigned)__builtin_amdgcn_update_dpp(0, (int)send0, 0xB1, 0xF, 0xF, false), recv1 = (unsigned)__builtin_amdgcn_update_dpp(0, (int)send1, 0xB1, 0xF, 0xF, false);
              LAS unsigned char* kp = kb + j * 32 * KT_STRIDE;
              *(LAS unsigned*)(kp) = __builtin_amdgcn_perm(keep0, recv0, selLo); *(LAS unsigned*)(kp + KT_STRIDE) = __builtin_amdgcn_perm(keep0, recv0, selHi);
              *(LAS unsigned*)(kp + 2 * KT_STRIDE) = __builtin_amdgcn_perm(keep1, recv1, selLo); *(LAS unsigned*)(kp + 3 * KT_STRIDE) = __builtin_amdgcn_perm(keep1, recv1, selHi); } }
        if (step == 4) {
            const bf16_t* qg = qc + ((size_t)cur.chunk * 4 + h) * 64 * 512;
#pragma unroll
            for (int i = 0; i < 8; ++i) { const int t = wid * 8 + i;
                __builtin_amdgcn_global_load_lds((const unsigned*)(qg + (size_t)t * 512 + lane * 8), (LAS unsigned*)(lds + L_QS + t * QS_STRIDE), 16, 0, 0); }
        }
        asm volatile("s_waitcnt vmcnt(0)" ::: "memory");
        LDS_BAR();
        const bf16_t* vg = vtc + (((size_t)cur.chunk * 4 + h) * 512 + dvw + tk) * 64;
        const u32x4 v0 = *(const u32x4*)(vg + g * 8), v1 = *(const u32x4*)(vg + 32 + g * 8);
        if (has_next) { pv_n = *(const f32x4*)(pre + ((size_t)(step + 1) * 64 + lane) * 4); bl_n = pres[(step + 1) * 2]; mw_n = pres[(step + 1) * 2 + 1];
                        if (!nxt.isctx) { rs_n = RS[((size_t)(nxt.rowbase + lane) * 2 + dir) * 4 + h];
#pragma unroll
                            for (int m2 = 0; m2 < 2; ++m2) numi_n[m2] = *(const u32x2*)(hout + (size_t)(nxt.rowbase + (kh * 2 + m2) * 16 + 4 * g + (tk & 3)) * 2048 + h * 512 + dvw + (tk & ~3)); } }
        f32x4 O[4];
        if (!isctx) {
            { const int t = tid >> 3, part = tid & 7; float s = 0.f;
#pragma unroll
              for (int i = 0; i < 8; ++i) { const u32x4 w = *(const LAS u32x4*)(lds + L_QS + t * QS_STRIDE + (i * 64 + part * 8) * 2); const u32x4 nv = *(const LAS u32x4*)(nbf + i * 32 + part * 4);
                  s = dot2bf(w.x, nv.x, s); s = dot2bf(w.y, nv.y, s); s = dot2bf(w.z, nv.z, s); s = dot2bf(w.w, nv.w, s); }
              s += __builtin_bit_cast(float, __builtin_amdgcn_update_dpp(0, __builtin_bit_cast(int, s), 0xB1, 0xF, 0xF, true));
              s += __builtin_bit_cast(float, __builtin_amdgcn_update_dpp(0, __builtin_bit_cast(int, s), 0x4E, 0xF, 0xF, true));
              s += __builtin_bit_cast(float, __builtin_amdgcn_update_dpp(0, __builtin_bit_cast(int, s), 0x104, 0xF, 0xF, true));
              if (part == 0) qn[t] = s; }
#pragma unroll
            for (int mt = 0; mt < 4; ++mt) O[mt] = (f32x4){0.f, 0.f, 0.f, 0.f};
            { u32x4 aw[2][4];
#define QC_LOAD(buf, j_) do { _Pragma("unroll") for (int mt = 0; mt < 4; ++mt) aw[buf][mt] = *(const LAS u32x4*)(lds + L_QS + (mt * 16 + tk) * QS_STRIDE + ((kh * 8 + (j_)) * 32 + 8 * g) * 2); } while (0)
              QC_LOAD(0, 0);
#pragma unroll
              for (int j = 0; j < 8; ++j) {
                  if (j < 7) QC_LOAD((j + 1) & 1, j + 1);
                  u32x4 bw; bw.x = cvt_pk_bf16(C[2 * j][0], C[2 * j][1]); bw.y = cvt_pk_bf16(C[2 * j][2], C[2 * j][3]); bw.z = cvt_pk_bf16(C[2 * j + 1][0], C[2 * j + 1][1]); bw.w = cvt_pk_bf16(C[2 * j + 1][2], C[2 * j + 1][3]);
                  const bf16x8 bb = __builtin_bit_cast(bf16x8, bw);
                  __builtin_amdgcn_sched_barrier(0);
#pragma unroll
                  for (int mt = 0; mt < 4; ++mt) O[mt] = __builtin_amdgcn_mfma_f32_16x16x32_bf16(__builtin_bit_cast(bf16x8, aw[j & 1][mt]), bb, O[mt], 0, 0, 0);
                  __builtin_amdgcn_sched_barrier(0); }
#undef QC_LOAD
            }
        }
        LDS_BAR();
        if (has_next) {
            if (!nxt.isctx) { const bf16_t* qg = qc + ((size_t)nxt.chunk * 4 + h) * 64 * 512;
#pragma unroll
                for (int i = 0; i < 8; ++i) { const int t = wid * 8 + i;
                    __builtin_amdgcn_global_load_lds((const unsigned*)(qg + (size_t)t * 512 + lane * 8), (LAS unsigned*)(lds + L_QS + t * QS_STRIDE), 16, 0, 0); } }
            const bf16_t* kgn = kc + ((size_t)nxt.chunk * 4 + h) * 64 * 512 + (size_t)((wid >> 1) * 16 + tk) * 512 + (wid & 1) * 256 + g * 8;
#pragma unroll
            for (int j = 0; j < 8; ++j) kr[j] = *(const u32x4*)(kgn + j * 32);
        }
        if (!isctx) {
            float numi[8];
            numi[0] = bflo(numi_c0.x); numi[1] = bfhi(numi_c0.x); numi[2] = bflo(numi_c0.y); numi[3] = bfhi(numi_c0.y); numi[4] = bflo(numi_c1.x); numi[5] = bfhi(numi_c1.x); numi[6] = bflo(numi_c1.y); numi[7] = bfhi(numi_c1.y);
#pragma unroll
            for (int mt = 0; mt < 4; ++mt) { const f32x4 iw4 = *(const LAS f32x4*)(iw_p + mt * 16 + 4 * g); O[mt] = O[mt] * iw4; }
            LAS float* xw = (LAS float*)(lds + L_PS) + (dvg * 2 + kh) * 512 + lane * 8;
            const LAS float* xr = (const LAS float*)(lds + L_PS) + (dvg * 2 + (kh ^ 1)) * 512 + lane * 8;
            *(LAS f32x4*)xw = kh ? O[0] : O[2]; *(LAS f32x4*)(xw + 4) = kh ? O[1] : O[3];
            LDS_BAR();
            { const f32x4 xp0 = *(const LAS f32x4*)xr, xp1 = *(const LAS f32x4*)(xr + 4);
#pragma unroll
              for (int m2 = 0; m2 < 2; ++m2) { const int mt = kh * 2 + m2; const f32x4 own = kh ? O[2 + m2] : O[m2]; const f32x4 xp = m2 ? xp1 : xp0; const f32x4 qn4 = *(const LAS f32x4*)(qn + mt * 16 + 4 * g);
                  float hv[4];
#pragma unroll
                  for (int i = 0; i < 4; ++i) { const int t = mt * 16 + 4 * g + i; const f32x4 f = *(const LAS f32x4*)(fin4 + t * 4); const float den = f[0] * qn4[i] + f[1];
                      hv[i] = (own[i] + xp[i] + numi[m2 * 4 + i]) * __builtin_amdgcn_rcpf(fmaxf(fabsf(den), f[2])); }
                  u32x2 hw; hw.x = cvt_pk_bf16(hv[0], hv[1]); hw.y = cvt_pk_bf16(hv[2], hv[3]);
                  *(u32x2*)(hout + (size_t)(rowbase + mt * 16 + 4 * g + (tk & 3)) * 2048 + h * 512 + dvw + (tk & ~3)) = hw; } }
        }
        { u32x4 w0, w1;
          { const f32x4 ea = *(const LAS f32x4*)(e_p + g * 8), eb = *(const LAS f32x4*)(e_p + g * 8 + 4), ec = *(const LAS f32x4*)(e_p + 32 + g * 8), ed = *(const LAS f32x4*)(e_p + 32 + g * 8 + 4);
            w0[0] = cvt_pk_bf16(bflo(v0[0]) * ea[0], bfhi(v0[0]) * ea[1]); w0[1] = cvt_pk_bf16(bflo(v0[1]) * ea[2], bfhi(v0[1]) * ea[3]);
            w0[2] = cvt_pk_bf16(bflo(v0[2]) * eb[0], bfhi(v0[2]) * eb[1]); w0[3] = cvt_pk_bf16(bflo(v0[3]) * eb[2], bfhi(v0[3]) * eb[3]);
            w1[0] = cvt_pk_bf16(bflo(v1[0]) * ec[0], bfhi(v1[0]) * ec[1]); w1[1] = cvt_pk_bf16(bflo(v1[1]) * ec[2], bfhi(v1[1]) * ec[3]);
            w1[2] = cvt_pk_bf16(bflo(v1[2]) * ed[0], bfhi(v1[2]) * ed[1]); w1[3] = cvt_pk_bf16(bflo(v1[3]) * ed[2], bfhi(v1[3]) * ed[3]); }
          const bf16x8 ve0 = __builtin_bit_cast(bf16x8, w0), ve1 = __builtin_bit_cast(bf16x8, w1);
          const LAS unsigned char* kbase = lds + L_KT + (kh * 256 + 8 * (tk >> 2) + (tk & 3)) * KT_STRIDE + g * 16;
          bf16x8 ka[2][2];
          ka[0][0] = *(const LAS bf16x8*)kbase; ka[0][1] = *(const LAS bf16x8*)(kbase + 64);
#pragma unroll
          for (int i = 0; i < 16; ++i) {
              if (i < 15) { const LAS unsigned char* kp = kbase + (32 * ((i + 1) >> 1) + 4 * ((i + 1) & 1)) * KT_STRIDE; ka[(i + 1) & 1][0] = *(const LAS bf16x8*)kp; ka[(i + 1) & 1][1] = *(const LAS bf16x8*)(kp + 64); }
              C[i] = C[i] * decay;
              __builtin_amdgcn_sched_barrier(0);
              C[i] = __builtin_amdgcn_mfma_f32_16x16x32_bf16(ka[i & 1][0], ve0, C[i], 0, 0, 0);
              C[i] = __builtin_amdgcn_mfma_f32_16x16x32_bf16(ka[i & 1][1], ve1, C[i], 0, 0, 0);
              __builtin_amdgcn_sched_barrier(0); } }
        { float sacc = 0.f; const LAS unsigned char* kp = lds + L_KT + tid * KT_STRIDE;
#pragma unroll
          for (int i = 0; i < 8; ++i) { const u32x4 w = *(const LAS u32x4*)(kp + i * 16); const u32x4 e4 = *(const LAS u32x4*)(ebf + i * 4);
              sacc = dot2bf(w.x, e4.x, sacc); sacc = dot2bf(w.y, e4.y, sacc); sacc = dot2bf(w.z, e4.z, sacc); sacc = dot2bf(w.w, e4.w, sacc); }
          nreg = decay * nreg + sacc; ((LAS unsigned short*)nbf)[tid] = (unsigned short)(cvt_pk_bf16(nreg, 0.f) & 0xffffu); }
        mstate = mnew;
        LDS_BAR();
    }
}

DI Sch mk_sch(int nM, int nN, int nsub, const void* A0, const void* B0, size_t a_tile, size_t b_tile, size_t a_sub, size_t b_sub, int a_mod = 0, int b_mod = 0) {
    Sch s; s.nM = nM; s.nN = nN; s.nsub = nsub; s.G = 256; s.c = blockIdx.x; s.A0 = (const char*)A0; s.B0 = (const char*)B0;
    s.a_tile = a_tile; s.b_tile = b_tile; s.a_sub = a_sub; s.b_sub = b_sub; s.a_sub2 = 0; s.a_mod = a_mod; s.b_mod = b_mod; return s;
}

__global__ void __launch_bounds__(512, 2) mega(Params p, int ph_lo, int ph_hi) {
    extern __shared__ __attribute__((aligned(16))) unsigned char smem[];
    LAS unsigned char* lds = (LAS unsigned char*)smem;
    cg::grid_group grid = cg::this_grid();
#ifdef PROBE
    unsigned long long tprev = 0, accA = 0, accB = 0;
#endif
    for (int ph = 0; ph < 30; ++ph) {
        if (ph > 0) { if (p.ws == nullptr) grid.sync();
                      unsigned gen = (unsigned)(ph - 1); grid_bar((unsigned*)(p.ws + S_BAR), gen); }
#ifdef PROBE
        { const unsigned long long tn = __builtin_amdgcn_s_memrealtime(); if (ph > 0) { if ((PROBE_MA >> (ph - 1)) & 1u) accA += tn - tprev; if ((PROBE_MB >> (ph - 1)) & 1u) accB += tn - tprev; } tprev = tn; }
        const float probe_b = (float)accB * 0.01f;
#else
        const float probe_b = 0.f;
#endif
        const float* mods = (const float*)(p.out + W_MODS);
        _Float16* hb = (_Float16*)(p.out + O_HB);
        unsigned char* ub = p.ws + S_UB;
#ifndef ONLY
#define EN(x) 1
#else
#define EN(x) ((x) == ONLY)
#endif
        switch (ph) {
        case 0: if (EN(0)) phase_prep(p, lds); break;
        case 1: if (EN(1)) phase_embed(p); break;
        case 2: if (EN(2)) { GemmCfg g{2048, 16, 2048, 16, 16}; Sch S = mk_sch(136, 6, 1, ub, p.out + W_ABIN, 256 * 2048, 256 * 2048, 0, 0);
                  EpiAbIn E{(bf16_t*)(p.ws + S_R1), (bf16_t*)(p.ws + S_R1 + 34 * MiB)}; gemm_phase(lds, g, S, E); } break;
        case 3: if (EN(3)) phase_poolconv(p, lds); break;
        case 4: if (EN(2)) { GemmCfg g{16, (unsigned)NR * 16u, 1024, 16, 8}; Sch S = mk_sch(136, 2, 1, p.ws + S_R1, p.out + W_POOL, 256 * 16, 256 * 1024, 0, 0);
                  EpiPool E{(bf16_t*)(p.ws + S_R2), p.in[10], p.in[11]}; gemm_phase(lds, g, S, E); } break;
        case 5: if (EN(2)) { GemmCfg g{2048, 16, 2048, 16, 16}; Sch S = mk_sch(136, 4, 1, p.ws + S_R2, p.out + W_ABOUT, 256 * 2048, 256 * 2048, 0, 0);
                  EpiRes E{hb, hb, mods + 2 * 1024, 0, nullptr, nullptr}; gemm_phase(lds, g, S, E); } break;
        case 6: if (EN(1)) phase_ln(p, hb, 0, 0, 0, 3, 0); break;
        case 7: if (EN(2)) { GemmCfg g{2048, 16, 2048, 16, 16}; Sch S = mk_sch(136, 22, 1, ub, p.out + W_FFNIN, 256 * 2048, 256 * 2048, 0, 0);
                  EpiFfnIn E{(bf16_t*)(p.ws + S_R3), 0}; gemm_phase(lds, g, S, E); } break;
        case 8: if (EN(2)) {
                  for (int cpart = 0; cpart < 2; ++cpart) {
                      GemmCfg g{FF * 2, 16, FF * 2, 16, cpart ? 22 : 44};
                      Sch S = mk_sch(cpart ? 4 : 64, 4, cpart ? 4 : 2, p.ws + S_R3 + (cpart ? (size_t)HLAT * FF * 2 : (size_t)0), p.out + W_FFNOUT, (size_t)256 * FF * 2, (size_t)256 * FF * 2,
                                     cpart ? (size_t)1408 * 2 : (size_t)HR * FF * 2, cpart ? (size_t)1408 * 2 : (size_t)0, cpart ? 2 : 0, cpart ? 2 : 0);
                      if (cpart) { S.a_sub2 = (size_t)HR * FF * 2; S.c = 255 - (int)blockIdx.x; }
                      EpiRes E{hb, hb, mods + (cpart ? 8 * 6144 : 0) + 5 * 1024, HR, cpart ? (float*)(p.ws + S_CPA) : (float*)nullptr, (float*)(p.ws + S_CPB)};
                      gemm_phase(lds, g, S, E); } } break;
        case 9: if (EN(1)) phase_ln(p, hb, 0, 1, 1, 0, 0, 0.f, (const float*)(p.ws + S_CPA), (const float*)(p.ws + S_CPB)); break;
        case 10: case 18: if (EN(2)) { const int hf = ph >= 18; GemmCfg g{2048, 16, 2048, 16, 16};
                  Sch S = mk_sch(68, 8, 1, ub + (size_t)hf * HR * 2048, p.out + W_MLIN, 256 * 2048, 256 * 2048, 0, 0);
                  EpiPlain E{(bf16_t*)(p.ws + S_R1), 2048}; gemm_phase(lds, g, S, E); } break;
        case 11: case 19: if (EN(4)) phase_mlconv(p, ph >= 19); break;
        case 12: case 20: if (EN(2)) {
                  phase_pre(p, ph >= 20);
                  { GemmCfg g{4096, 16, 1024, 16, 8}; Sch S = mk_sch(68, 2, 8, p.ws + S_R2, p.out + W_Q, 256 * 4096, 256 * 1024, 1024, 524288, 4, 0);
                    EpiQK E{(bf16_t*)(p.ws + S_R3), (bf16_t*)(p.ws + S_R4)}; gemm_phase(lds, g, S, E); }
                  { GemmCfg g{1024, 16, 4096, 16, 8}; Sch S = mk_sch(2, 68, 4, p.out + W_V, p.ws + S_R1, 256 * 1024, 256 * 4096, 524288, 1024);
                    S.c = 255 - (int)blockIdx.x;
                    EpiVT E{(bf16_t*)(p.ws + S_R5)}; gemm_phase(lds, g, S, E); } } break;
        case 13: case 21: if (EN(5)) phase_intra(p, lds); break;
        case 14: case 22: if (EN(5)) phase_scan(p, ph >= 22, lds); break;
        case 15: case 23: if (EN(2)) { const int hf = ph >= 23; GemmCfg g{2048, 16, 2048, 16, 16};
                  Sch S = mk_sch(64, 8, 1, ub + (size_t)hf * HR * 2048, p.out + W_MLIN + (size_t)2048 * 2048, 256 * 2048, 256 * 2048, 0, 0);
                  EpiPlain E{(bf16_t*)(p.ws + S_R3), 2048}; gemm_phase(lds, g, S, E); } break;
        case 16: case 24: if (EN(1)) phase_mlout(p); break;
        case 17: case 25: if (EN(2)) { const int hf = ph >= 25; GemmCfg g{4096, 16, 4096, 16, 32};
                  Sch S = mk_sch(64, 4, 1, p.ws + S_R2, p.out + W_MLOUT, 256 * 4096, 256 * 4096, 0, 0);
                  EpiRes E{hb + (size_t)hf * HR * 1024, hb + (size_t)hf * HR * 1024, mods + 9 * 6144 + 2 * 1024 + (size_t)hf * 4 * 6144, 0, nullptr, nullptr};
                  gemm_phase(lds, g, S, E); } break;
        case 26: if (EN(1)) phase_ln(p, hb, 1, 0, 1, 3, 1); break;
        case 27: if (EN(2)) { GemmCfg g{2048, 16, 2048, 16, 16}; Sch S = mk_sch(64, 22, 2, ub, p.out + W_FFNIN + 11534336, 256 * 2048, 256 * 2048, (size_t)HR * 2048, 0);
                  EpiFfnIn E{(bf16_t*)(p.ws + S_R1), HR}; gemm_phase(lds, g, S, E); } break;
        case 28: if (EN(2)) { GemmCfg g{FF * 2, 16, FF * 2, 16, 44}; Sch S = mk_sch(64, 4, 2, p.ws + S_R1, p.out + W_FFNOUT + 5767168, (size_t)256 * FF * 2, (size_t)256 * FF * 2, (size_t)HR * FF * 2, 0);
                  EpiRes E{hb, (_Float16*)(p.ws + S_R5), mods + 9 * 6144 + 5 * 1024, HR, nullptr, nullptr}; gemm_phase(lds, g, S, E); } break;
        case 29: if (EN(1)) phase_ln(p, (const _Float16*)(p.ws + S_R5), 1, 1, -1, 0, 2, probe_b); break;
        default: break;
        }
    }
#ifdef PROBE
    { const unsigned long long tn = __builtin_amdgcn_s_memrealtime(); if ((PROBE_MA >> 29) & 1u) accA += tn - tprev;
      __syncthreads(); if (blockIdx.x == 0 && threadIdx.x == 0) ((float*)p.out)[0] = (float)accA * 0.01f; }
#endif
}
constexpr int NPHASE = 30;

extern "C" void kernel_launch(void* const* d_in, const int* in_sizes, int n_in, void* d_out, int out_size, void* d_ws, size_t ws_size, hipStream_t stream) {
    static int grid = 0;
    if (grid == 0) {
        if (n_in != 30 || ws_size < WS_NEED) { fprintf(stderr, "kernel_launch: unexpected n_in %d or ws_size %zu (< %zu)\n", n_in, ws_size, (size_t)WS_NEED); grid = -1; return; }
        int dev = 0, cus = 0, per_cu = 0;
        hipGetDevice(&dev); hipDeviceGetAttribute(&cus, hipDeviceAttributeMultiprocessorCount, dev);
        if (hipFuncSetAttribute((const void*)mega, hipFuncAttributeMaxDynamicSharedMemorySize, LDS_BYTES) != hipSuccess) { fprintf(stderr, "hipFuncSetAttribute failed\n"); grid = -1; return; }
        hipOccupancyMaxActiveBlocksPerMultiprocessor(&per_cu, (const void*)mega, 512, LDS_BYTES);
        (void)hipGetLastError();
        grid = 256; if (cus != 256) fprintf(stderr, "kernel_launch: device reports %d CUs; this kernel is built for a 256-workgroup grid\n", cus);
        if (per_cu < 1) fprintf(stderr, "kernel_launch: occupancy query says %d blocks per CU\n", per_cu);
    }
    if (grid < 0) return;
    hipMemsetAsync((unsigned char*)d_ws + S_BAR, 0, 4096, stream);
    Params p{};
    for (int i = 0; i < 30; ++i) p.in[i] = (const float*)d_in[i];
    p.out = (unsigned char*)d_out; p.ws = (unsigned char*)d_ws;
    int lo = 0, hi = NPHASE;
    void* args[] = {&p, &lo, &hi};
    hipError_t e = hipLaunchCooperativeKernel((const void*)mega, dim3(grid), dim3(512), args, LDS_BYTES, stream);
    if (e != hipSuccess) fprintf(stderr, "cooperative launch failed: %s (grid %d)\n", hipGetErrorString(e), grid);
}
```

```cpp
#include <hip/hip_runtime.h>
#include <hip/hip_cooperative_groups.h>
#include <cstdio>
namespace cg = cooperative_groups;

#define LAS __attribute__((address_space(3)))
#define DI __device__ __forceinline__
typedef unsigned short bf16_t;
typedef short bf16x8 __attribute__((ext_vector_type(8)));
typedef float f32x4 __attribute__((ext_vector_type(4)));
typedef unsigned u32x4 __attribute__((ext_vector_type(4)));
typedef unsigned u32x2 __attribute__((ext_vector_type(2)));
typedef _Float16 f16x8 __attribute__((ext_vector_type(8)));
typedef __bf16 bf16x2 __attribute__((ext_vector_type(2)));

constexpr int DM = 1024, NB = 8, SEQ = 4096, CTXL = 256, NR = 34816, HR = 17408, HLAT = 16384;
constexpr int FF = 2816, EIN = 2048, DH = 512;
constexpr float ALPHA = 1.41421356237f, LNEPS = 1e-5f, KSCALE = 0.04419417382f;
constexpr size_t MiB = 1048576;
constexpr size_t O_HB = 0, O_W = 68 * MiB;
constexpr size_t W_ABIN = O_W, W_POOL = W_ABIN + 3145728, W_ABOUT = W_POOL + 524288, W_FFNIN = W_ABOUT + 2097152  ,
                 W_FFNOUT = W_FFNIN + 2 * 11534336  , W_MLIN = W_FFNOUT + 2 * 5767168, W_Q = W_MLIN + 8388608, W_K = W_Q + 2097152,
                 W_V = W_K + 2097152, W_MLOUT = W_V + 2097152, W_AQK = W_MLOUT + 4194304, W_AV = W_AQK + 65536, W_MODS = W_AV + 65536,
                 W_END = W_MODS + 442368;
static_assert(W_END <= 128 * MiB, "weights region");
constexpr size_t RS = 68 * MiB;
constexpr size_t S_UB = 0, S_R1 = RS, S_R2 = 2 * RS, S_R3 = 3 * RS, S_R4 = 4 * RS, S_R5 = 5 * RS, S_R6 = 6 * RS, S_MISC = 7 * RS;
constexpr size_t S_GATES = S_MISC, S_BAR = S_MISC + 4 * MiB, S_RS = S_MISC + 5 * MiB, S_PRE = S_MISC + 8 * MiB, S_CPA = S_MISC + 12 * MiB, S_CPB = S_MISC + 20 * MiB;
static_assert(S_CPB + 8 * MiB <= 512 * MiB, "workspace");
constexpr int PRE_V = 32 * 68 * 256;
constexpr size_t WS_NEED = S_PRE + (size_t)(PRE_V + 32 * 68 * 2) * 4;
static_assert(WS_NEED <= 512 * MiB, "workspace");

constexpr int LDS_BYTES = 160 * 1024;

struct Params {
    const float* in[30];
    unsigned char* out;
    unsigned char* ws;
};

DI unsigned cvt_pk_bf16(float lo, float hi) { unsigned r; asm("v_cvt_pk_bf16_f32 %0, %1, %2\n\ts_nop 1" : "=v"(r) : "v"(lo), "v"(hi)); return r; }
DI int opaque_tid() { int t = threadIdx.x; asm volatile("" : "+v"(t)); return t; }
#define TIDX opaque_tid()
DI unsigned cvt_pk_bf16_mfma(float lo, float hi) { unsigned r; asm volatile("s_nop 7\n\ts_nop 7\n\tv_cvt_pk_bf16_f32 %0, %1, %2\n\ts_nop 1" : "=v"(r) : "v"(lo), "v"(hi)); return r; }
DI float bf2f(unsigned short b) { return __uint_as_float(((unsigned)b) << 16); }
DI float dot2bf(unsigned a, unsigned b, float c) { return __builtin_amdgcn_fdot2_f32_bf16(__builtin_bit_cast(bf16x2, a), __builtin_bit_cast(bf16x2, b), c, false); }
DI float bflo(unsigned w) { return __uint_as_float(w << 16); }
DI float bfhi(unsigned w) { return __uint_as_float(w & 0xffff0000u); }
DI float sigmoidf_(float x) { return __builtin_amdgcn_rcpf(1.0f + __expf(-x)); }
DI float siluf_(float x) { return x * __builtin_amdgcn_rcpf(1.0f + __expf(-x)); }
DI float wave_sum(float v) {
#pragma unroll
    for (int o = 32; o >= 1; o >>= 1) v += __shfl_xor(v, o);
    return v;
}
DI float wave_max(float v) {
#pragma unroll
    for (int o = 32; o >= 1; o >>= 1) v = fmaxf(v, __shfl_xor(v, o));
    return v;
}
DI int row_bm(int R) { const int hf = R >= HR ? 1 : 0; const int r = R - hf * HR; return r < HLAT ? hf * 4 + (r >> 12) : 8; }
DI const float* row_src(const Params& p, int R) {
    const int hf = R >= HR ? 1 : 0; const int r = R - hf * HR;
    if (r < HLAT) return p.in[0] + ((size_t)(hf * 4 + (r >> 12)) * SEQ + (r & 4095)) * DM;
    const int rc = r - HLAT; return p.in[2] + ((size_t)(hf * 4 + (rc >> 8)) * CTXL + (rc & 255)) * DM;
}

DI void grid_bar(unsigned* ctr, unsigned& gen) {
    asm volatile("s_waitcnt vmcnt(0)" ::: "memory");
    __syncthreads();
    gen += 1;
    if (threadIdx.x == 0) {
        __builtin_amdgcn_fence(__ATOMIC_RELEASE, "agent");
        asm volatile("s_waitcnt vmcnt(0)" ::: "memory");
        unsigned* grp = ctr + 64 * (1 + (blockIdx.x & 7));
        const unsigned old = __hip_atomic_fetch_add(grp, 1u, __ATOMIC_RELAXED, __HIP_MEMORY_SCOPE_AGENT);
        if (old + 1u == gen * (gridDim.x >> 3)) __hip_atomic_fetch_add(ctr, 1u, __ATOMIC_RELAXED, __HIP_MEMORY_SCOPE_AGENT);
        const unsigned target = gen * 8u;
        while (__hip_atomic_load(ctr, __ATOMIC_RELAXED, __HIP_MEMORY_SCOPE_AGENT) < target) __builtin_amdgcn_s_sleep(2);
        __builtin_amdgcn_fence(__ATOMIC_ACQUIRE, "agent");
        asm volatile("s_waitcnt vmcnt(0)" ::: "memory");
    }
    __syncthreads();
}

constexpr int BM = 256, BK = 64, HALF = 128, HTB = HALF * BK * 2;
DI int lds_byte(int r, int c) { const int st = (r >> 4) * 2 + (c >> 5), rr = r & 15, cc = c & 31, ob = rr * 64 + cc * 2; return st * 1024 + (ob ^ (((ob >> 9) & 1) << 5)); }
DI void stage_rc(int b, int& R, int& C) { const int st = b / 1024, sb = b % 1024, swz = sb ^ (((sb >> 9) & 1) << 5); R = (st >> 1) * 16 + swz / 64; C = (st & 1) * 32 + (swz % 64) / 2; }
DI int perm32(int rho) { const int n = rho >> 4, i = rho & 15; return 8 * (i >> 2) + 4 * n + (i & 3); }

struct Unit { const char* a; const char* b; int pm, pn, sub; };
struct GemmCfg { unsigned a_rs, a_cs, b_rs, b_cs; int nt; };
struct Sch {
    int nM, nN, nsub, G, c;
    const char* A0; const char* B0;
    size_t a_tile, b_tile, a_sub, b_sub, a_sub2; int a_mod, b_mod;
    DI bool next(int i, Unit& u) const {
        const long L = (long)i * G + c; const int per = nM * nN, nwg = per * nsub; if (L >= nwg) return false;
        int wgid = (int)L; { const int q = nwg / 8, r = nwg % 8, xcd = wgid % 8, off = wgid / 8; wgid = (xcd < r ? xcd * (q + 1) : r * (q + 1) + (xcd - r) * q) + off; }
        const int sub = wgid / per; wgid -= sub * per;
        const int nig = 8 * nN, gid = wgid / nig, fm = gid * 8, gsz = (nM - fm) < 8 ? (nM - fm) : 8;
        u.pm = fm + ((wgid % nig) % gsz); u.pn = (wgid % nig) / gsz; u.sub = sub;
        u.a = A0 + (size_t)u.pm * a_tile + (size_t)(a_mod ? sub % a_mod : sub) * a_sub + (size_t)(a_mod ? sub / a_mod : 0) * a_sub2;
        u.b = B0 + (size_t)u.pn * b_tile + (size_t)(b_mod ? sub % b_mod : sub) * b_sub;
        return true;
    }
};

template <class Epi>
DI void gemm_phase(LAS unsigned char* lds, const GemmCfg g, const Sch& S, const Epi& E) {
    const int tid = TIDX, wid = __builtin_amdgcn_readfirstlane(tid >> 6), lane = tid & 63, wr = wid >> 2, wc = wid & 3, fr = lane & 15, fq = lane >> 4;
    const int nt = g.nt;
    unsigned voffA[2], voffB[2];
#pragma unroll
    for (int i = 0; i < 2; ++i) { int R, C; stage_rc(tid * 16 + i * 8192, R, C); const int Rb = (R & ~31) + perm32(R & 31);
        voffA[i] = (unsigned)R * g.a_rs + (unsigned)(C >> 3) * g.a_cs; voffB[i] = (unsigned)Rb * g.b_rs + (unsigned)(C >> 3) * g.b_cs; }
    const size_t kstepA = (size_t)8 * g.a_cs, kstepB = (size_t)8 * g.b_cs, hstepA = (size_t)HALF * g.a_rs, hstepB = (size_t)HALF * g.b_rs;
    const unsigned ldsw = (unsigned)wid * 1024u;
    const int aoff = lds_byte(wr * 64 + fr, fq * 8), boff = lds_byte(wc * 32 + fr, fq * 8);
#define G_SA(b, h) (((b) * 2 + (h)) * HTB)
#define G_SB(b, h) ((4 + (b) * 2 + (h)) * HTB)
#define G_STAGE(bufoff, gbase, voff) do { _Pragma("unroll") for (int _i = 0; _i < 2; ++_i) \
        __builtin_amdgcn_global_load_lds((const unsigned*)((const char*)(gbase) + (voff)[_i]), (LAS unsigned*)(lds + (bufoff) + ldsw + _i * 8192), 16, 0, 0); } while (0)
#define G_LDA(dst, b, h) do { _Pragma("unroll") for (int m = 0; m < 4; ++m) _Pragma("unroll") for (int k = 0; k < 2; ++k) dst[m][k] = *(const LAS bf16x8*)(lds + G_SA(b, h) + aoff + m * 2048 + k * 1024); } while (0)
#define G_LDB(dst, b, h) do { _Pragma("unroll") for (int n = 0; n < 2; ++n) _Pragma("unroll") for (int k = 0; k < 2; ++k) dst[n][k] = *(const LAS bf16x8*)(lds + G_SB(b, h) + boff + n * 2048 + k * 1024); } while (0)
#define G_MMA(ai, bj, At, Bt) do { __builtin_amdgcn_s_setprio(1); _Pragma("unroll") for (int m = 0; m < 4; ++m) _Pragma("unroll") for (int n = 0; n < 2; ++n) _Pragma("unroll") for (int k = 0; k < 2; ++k) \
        acc[ai][bj][m][n] = __builtin_amdgcn_mfma_f32_16x16x32_bf16(Bt[n][k], At[m][k], acc[ai][bj][m][n], 0, 0, 0); __builtin_amdgcn_s_setprio(0); } while (0)
#define G_WAIT_V(n) asm volatile("s_waitcnt vmcnt(" #n ")" ::: "memory")
#define G_WAIT_L(n) asm volatile("s_waitcnt lgkmcnt(" #n ")" ::: "memory")
#define G_BAR __builtin_amdgcn_s_barrier()
#define G_SCHED __builtin_amdgcn_sched_barrier(0)
    Unit cur, nxt; int ui = 0;
    if (!S.next(0, cur)) return;
    f32x4 acc[2][2][4][2];
#pragma unroll
    for (int a = 0; a < 2; ++a)
#pragma unroll
        for (int b = 0; b < 2; ++b)
#pragma unroll
            for (int m = 0; m < 4; ++m)
#pragma unroll
                for (int n = 0; n < 2; ++n) acc[a][b][m][n] = (f32x4){0.f, 0.f, 0.f, 0.f};
    bf16x8 At[4][2], B0[2][2], B1[2][2];
    const char* cA = cur.a; const char* cB = cur.b;
    G_STAGE(G_SB(0, 0), cB, voffB); G_STAGE(G_SA(0, 0), cA, voffA); G_STAGE(G_SB(0, 1), cB + hstepB, voffB); G_STAGE(G_SA(0, 1), cA + hstepA, voffA);
    if (wr == 1) G_BAR;
    G_WAIT_V(4); G_BAR;
    G_STAGE(G_SB(1, 0), cB + kstepB, voffB); G_STAGE(G_SA(1, 0), cA + kstepA, voffA); G_STAGE(G_SB(1, 1), cB + hstepB + kstepB, voffB);
    G_WAIT_V(6); G_BAR;
    for (;;) {
        const bool has_next = S.next(ui + 1, nxt);
        const char* nA = has_next ? nxt.a : cA; const char* nB = has_next ? nxt.b : cB;
        for (int t = 0; t < nt; t += 2) {
            const bool last = (t == nt - 2);
            const char* a1 = cA + (size_t)(t + 1) * kstepA;
            const char* a2 = last ? nA : cA + (size_t)(t + 2) * kstepA; const char* b2 = last ? nB : cB + (size_t)(t + 2) * kstepB;
            const char* a3 = a2 + kstepA; const char* b3 = b2 + kstepB;
            G_LDB(B0, 0, 0); G_SCHED; G_LDA(At, 0, 0); G_STAGE(G_SA(1, 1), a1 + hstepA, voffA);
            G_WAIT_L(8); G_BAR; G_WAIT_L(0); G_MMA(0, 0, At, B0); G_BAR; G_SCHED;
            G_LDB(B1, 0, 1); G_STAGE(G_SB(0, 0), b2, voffB);
            G_BAR; G_WAIT_L(0); G_MMA(0, 1, At, B1); G_BAR;
            G_LDA(At, 0, 1); G_STAGE(G_SA(0, 0), a2, voffA);
            G_BAR; G_WAIT_L(0); G_MMA(1, 0, At, B0); G_BAR; G_SCHED;
            G_STAGE(G_SB(0, 1), b2 + hstepB, voffB);
            G_WAIT_V(6); G_BAR; G_MMA(1, 1, At, B1); G_BAR;
            G_LDB(B0, 1, 0); G_SCHED; G_LDA(At, 1, 0); G_STAGE(G_SA(0, 1), a2 + hstepA, voffA);
            G_WAIT_L(8); G_BAR; G_WAIT_L(0); G_MMA(0, 0, At, B0); G_BAR; G_SCHED;
            G_LDB(B1, 1, 1); G_STAGE(G_SB(1, 0), b3, voffB);
            G_BAR; G_WAIT_L(0); G_MMA(0, 1, At, B1); G_BAR;
            G_LDA(At, 1, 1); G_STAGE(G_SA(1, 0), a3, voffA);
            G_BAR; G_WAIT_L(0); G_MMA(1, 0, At, B0); G_BAR; G_SCHED;
            G_STAGE(G_SB(1, 1), b3 + hstepB, voffB);
            G_WAIT_V(6); G_BAR; G_MMA(1, 1, At, B1); G_BAR;
        }
        E(acc, cur, wr, wc, fr, fq);
        if (!has_next) break;
#pragma unroll
        for (int a = 0; a < 2; ++a)
#pragma unroll
            for (int b = 0; b < 2; ++b)
#pragma unroll
                for (int m = 0; m < 4; ++m)
#pragma unroll
                    for (int n = 0; n < 2; ++n) acc[a][b][m][n] = (f32x4){0.f, 0.f, 0.f, 0.f};
        cur = nxt; cA = nA; cB = nB; ++ui;
    }
    G_WAIT_V(0);
    if (wr == 0) G_BAR;
    G_BAR;
#undef G_SA
#undef G_SB
#undef G_STAGE
#undef G_LDA
#undef G_LDB
#undef G_MMA
}

#define EPI_ARGS const f32x4 (&acc)[2][2][4][2], const Unit& u, int wr, int wc, int fr, int fq
DI u32x4 pack8(const f32x4 v0, const f32x4 v1) { u32x4 w; w.x = cvt_pk_bf16(v0[0], v0[1]); w.y = cvt_pk_bf16(v0[2], v0[3]); w.z = cvt_pk_bf16(v1[0], v1[1]); w.w = cvt_pk_bf16(v1[2], v1[3]); return w; }

struct EpiAbIn {
    bf16_t* aslab; bf16_t* glu;
    DI void operator()(EPI_ARGS) const {
        const int row0 = u.pm * BM + wr * 64 + fr;
#pragma unroll
        for (int ai = 0; ai < 2; ++ai)
#pragma unroll
            for (int m = 0; m < 4; ++m) { const int R = row0 + ai * HALF + m * 16;
                if (u.pn < 2) {
#pragma unroll
                    for (int bj = 0; bj < 2; ++bj) { const int col = u.pn * BM + bj * HALF + wc * 32 + 8 * fq;
                        *(u32x4*)(aslab + ((size_t)(col >> 3) * NR + R) * 8) = pack8(acc[ai][bj][m][0], acc[ai][bj][m][1]); }
                } else {
                    f32x4 g0, g1;
#pragma unroll
                    for (int j = 0; j < 4; ++j) { g0[j] = acc[ai][0][m][0][j] * sigmoidf_(acc[ai][1][m][0][j]); g1[j] = acc[ai][0][m][1][j] * sigmoidf_(acc[ai][1][m][1][j]); }
                    *(u32x4*)(glu + (size_t)R * 512 + (u.pn - 2) * 128 + wc * 32 + 8 * fq) = pack8(g0, g1);
                } }
    }
};
struct EpiPool {
    bf16_t* ycat; const float* pb; const float* ps;
    DI void operator()(EPI_ARGS) const {
        const int row0 = u.pm * BM + wr * 64 + fr;
#pragma unroll
        for (int bj = 0; bj < 2; ++bj) { const int col = u.pn * BM + bj * HALF + wc * 32 + 8 * fq;
            const f32x4 b0 = *(const f32x4*)(pb + col), b1 = *(const f32x4*)(pb + col + 4), s0 = *(const f32x4*)(ps + col), s1 = *(const f32x4*)(ps + col + 4);
#pragma unroll
            for (int ai = 0; ai < 2; ++ai)
#pragma unroll
                for (int m = 0; m < 4; ++m) { const int R = row0 + ai * HALF + m * 16;
                    *(u32x4*)(ycat + (size_t)R * 1024 + col) = pack8((acc[ai][bj][m][0] + b0) * s0, (acc[ai][bj][m][1] + b1) * s1); } }
    }
};
struct EpiRes {
    const _Float16* src; _Float16* dst; const float* gate; int row_sub; float* pa; float* pb;
    DI void operator()(EPI_ARGS) const {
        if (pa != nullptr) {
            float* pd = (u.sub & 1) ? pb : pa; const int prow = (u.sub >> 1) * 1024 + u.pm * BM + wr * 64 + fr;
#pragma unroll
            for (int bj = 0; bj < 2; ++bj) { const int col = u.pn * BM + bj * HALF + wc * 32 + 8 * fq;
                const f32x4 g0 = *(const f32x4*)(gate + col), g1 = *(const f32x4*)(gate + col + 4);
#pragma unroll
                for (int ai = 0; ai < 2; ++ai)
#pragma unroll
                    for (int m = 0; m < 4; ++m) { float* o = pd + (size_t)(prow + ai * HALF + m * 16) * 1024 + col;
                        *(f32x4*)o = acc[ai][bj][m][0] * g0; *(f32x4*)(o + 4) = acc[ai][bj][m][1] * g1; } }
            return; }
        const int row0 = u.sub * row_sub + u.pm * BM + wr * 64 + fr;
#pragma unroll
        for (int ai = 0; ai < 2; ++ai)
#pragma unroll
            for (int m = 0; m < 4; ++m) { const int R = row0 + ai * HALF + m * 16; const float* gp = gate + (size_t)row_bm(R) * 6144;
#pragma unroll
                for (int bj = 0; bj < 2; ++bj) { const int col = u.pn * BM + bj * HALF + wc * 32 + 8 * fq;
                    const f32x4 g0 = *(const f32x4*)(gp + col), g1 = *(const f32x4*)(gp + col + 4);
                    const f16x8 hv = *(const f16x8*)(src + (size_t)R * 1024 + col); f16x8 o;
#pragma unroll
                    for (int j = 0; j < 4; ++j) { o[j] = (_Float16)(ALPHA * (float)hv[j] + g0[j] * acc[ai][bj][m][0][j]); o[4 + j] = (_Float16)(ALPHA * (float)hv[4 + j] + g1[j] * acc[ai][bj][m][1][j]); }
                    *(f16x8*)(dst + (size_t)R * 1024 + col) = o; } }
    }
};
struct EpiFfnIn {
    bf16_t* hid; int row_sub;
    DI void operator()(EPI_ARGS) const {
        const int row0 = u.sub * row_sub + u.pm * BM + wr * 64 + fr;
#pragma unroll
        for (int ai = 0; ai < 2; ++ai)
#pragma unroll
            for (int m = 0; m < 4; ++m) { const int R = row0 + ai * HALF + m * 16; f32x4 g0, g1;
#pragma unroll
                for (int j = 0; j < 4; ++j) { g0[j] = siluf_(acc[ai][0][m][0][j]) * acc[ai][1][m][0][j]; g1[j] = siluf_(acc[ai][0][m][1][j]) * acc[ai][1][m][1][j]; }
                *(u32x4*)(hid + (size_t)R * FF + u.pn * 128 + wc * 32 + 8 * fq) = pack8(g0, g1); }
    }
};
struct EpiPlain {
    bf16_t* out; int ld;
    DI void operator()(EPI_ARGS) const {
        const int row0 = u.pm * BM + wr * 64 + fr;
#pragma unroll
        for (int ai = 0; ai < 2; ++ai)
#pragma unroll
            for (int m = 0; m < 4; ++m) { const int R = row0 + ai * HALF + m * 16;
#pragma unroll
                for (int bj = 0; bj < 2; ++bj) { const int col = u.pn * BM + bj * HALF + wc * 32 + 8 * fq;
                    *(u32x4*)(out + (size_t)R * ld + col) = pack8(acc[ai][bj][m][0], acc[ai][bj][m][1]); } }
    }
};
struct EpiQK {
    bf16_t* q; bf16_t* k;
    DI void operator()(EPI_ARGS) const {
        const int which = u.sub >> 2, h = u.sub & 3; bf16_t* dst = which ? k : q; const float sc = which ? KSCALE : 1.0f;
        const int row0 = u.pm * BM + wr * 64 + fr;
#pragma unroll
        for (int ai = 0; ai < 2; ++ai)
#pragma unroll
            for (int m = 0; m < 4; ++m) { const int r = row0 + ai * HALF + m * 16; bf16_t* rp = dst + (((size_t)(r >> 6) * 4 + h) * 64 + (r & 63)) * 512;
#pragma unroll
                for (int bj = 0; bj < 2; ++bj) { const int col = u.pn * BM + bj * HALF + wc * 32 + 8 * fq;
                    *(u32x4*)(rp + col) = pack8(acc[ai][bj][m][0] * sc, acc[ai][bj][m][1] * sc); } }
    }
};
struct EpiVT {
    bf16_t* vt;
    DI void operator()(EPI_ARGS) const {
        const int h = u.sub; const int row0 = u.pm * BM + wr * 64 + fr;
#pragma unroll
        for (int ai = 0; ai < 2; ++ai)
#pragma unroll
            for (int m = 0; m < 4; ++m) { const int dv = row0 + ai * HALF + m * 16;
#pragma unroll
                for (int bj = 0; bj < 2; ++bj) { const int r = u.pn * BM + bj * HALF + wc * 32 + 8 * fq;
                    *(u32x4*)(vt + (((size_t)(r >> 6) * 4 + h) * 512 + dv) * 64 + (r & 63)) = pack8(acc[ai][bj][m][0], acc[ai][bj][m][1]); } }
    }
};

struct TJob { const float* src; bf16_t* dst; int K, N, sld, dld, map, ntile; };
DI int srccol(int map, int n) {
    if (map == 1) { if (n < 512) return n; const int j = (n - 512) >> 8, w = (n - 512) & 255; return w < 128 ? 512 + 128 * j + w : 1024 + 128 * j + (w - 128); }
    if (map == 2) { const int j = n >> 8, w = n & 255; return w < 128 ? 128 * j + w : FF + 128 * j + (w - 128); }
    return n;
}
constexpr int NJOB = 24;
DI TJob get_job(const Params& p, int j) {
    TJob t; bf16_t* W = (bf16_t*)p.out; t.map = 0;
    if (j == 0) { t.src = p.in[8]; t.dst = (bf16_t*)(p.out + W_ABIN); t.K = 1024; t.N = 1536; t.sld = 1536; t.dld = 1024; t.map = 1; }
    else if (j == 1) { t.src = p.in[16]; t.dst = (bf16_t*)(p.out + W_ABOUT); t.K = 1024; t.N = 1024; t.sld = 1024; t.dld = 1024; }
    else if (j < 4) { const int l = j - 2; t.src = p.in[28] + (size_t)l * 1024 * 5632; t.dst = (bf16_t*)(p.out + W_FFNIN + (size_t)l * 11534336); t.K = 1024; t.N = 5632; t.sld = 5632; t.dld = 1024; t.map = 2; }
    else if (j < 6) { const int l = j - 4; t.src = p.in[29] + (size_t)l * FF * 1024; t.dst = (bf16_t*)(p.out + W_FFNOUT + (size_t)l * 5767168); t.K = FF; t.N = 1024; t.sld = 1024; t.dld = FF; }
    else if (j == 6) { t.src = p.in[17]; t.dst = (bf16_t*)(p.out + W_MLIN); t.K = 1024; t.N = 4096; t.sld = 4096; t.dld = 1024; }
    else if (j < 19) { const int w = (j - 7) >> 2, h = (j - 7) & 3; t.src = p.in[w == 0 ? 20 : (w == 1 ? 21 : 22)] + (size_t)h * 512 * 512; t.dst = (bf16_t*)(p.out + W_Q + (size_t)w * 2097152) + (size_t)h * 512 * 512; t.K = 512; t.N = 512; t.sld = 512; t.dld = 512; }
    else if (j == 19) { t.src = p.in[27]; t.dst = (bf16_t*)(p.out + W_MLOUT); t.K = 2048; t.N = 1024; t.sld = 1024; t.dld = 2048; }
    else { const int g = j - 20; t.src = p.in[9] + (size_t)g * 128 * 128; t.dst = (bf16_t*)(p.out + W_POOL) + (size_t)g * 128 * 512 + g * 128; t.K = 128; t.N = 128; t.sld = 128; t.dld = 512; }
    (void)W; t.ntile = (t.K / 64) * (t.N / 64); return t;
}
__device__ void phase_prep(const Params& p, LAS unsigned char* lds) {
    const int tid = TIDX, G = 256;
    LAS float* tile = (LAS float*)lds;
    int base = 0;
    for (int j = 0; j < NJOB; ++j) {
        const TJob t = get_job(p, j); const int nkt = t.K / 64;
        for (int ti = blockIdx.x - base; ti < t.ntile; ti += G) { if (ti < 0) continue;
            const int kt = ti % nkt, nt_ = ti / nkt, k0 = kt * 64, n0 = nt_ * 64, sc0 = srccol(t.map, n0);
            const int i = tid >> 6, jj = tid & 63;
#pragma unroll
            for (int rr = 0; rr < 8; ++rr) tile[(i * 8 + rr) * 65 + jj] = t.src[(size_t)(k0 + i * 8 + rr) * t.sld + sc0 + jj];
            __syncthreads();
#pragma unroll
            for (int rr = 0; rr < 8; ++rr) { const int n = i * 8 + rr; t.dst[(size_t)(n0 + n) * t.dld + k0 + jj] = (bf16_t)(cvt_pk_bf16(tile[jj * 65 + n], 0.f) & 0xffffu); }
            __syncthreads();
        }
        base += t.ntile; while (base >= G) base -= G;
    }
    { bf16_t* wp = (bf16_t*)(p.out + W_POOL);
      for (int i = blockIdx.x * 512 + tid; i < 512 * 512; i += G * 512) { const int n = i >> 9, k = i & 511; if ((n >> 7) != (k >> 7)) wp[i] = 0; } }
    { LAS float* sc = (LAS float*)lds;
      LAS float* red = (LAS float*)(lds + 9 * 1024 * 4);
      __syncthreads();
      for (int i = tid; i < 9 * 1024; i += 512) { const float v = i < 8192 ? p.in[1][i] : p.in[3][i - 8192]; sc[i] = siluf_(v); }
      __syncthreads();
      float* mods = (float*)(p.out + W_MODS);
      for (int job = blockIdx.x; job < 96; job += G) {
          const int l = job / 48, nb = job % 48, col = nb * 128 + (tid & 127), kq = tid >> 7;
          const float* w = p.in[4] + (size_t)l * 1024 * 6144 + col;
          float a[9];
#pragma unroll
          for (int b = 0; b < 9; ++b) a[b] = 0.f;
#pragma unroll 4
          for (int k = kq * 256; k < kq * 256 + 256; ++k) { const float wv = __builtin_nontemporal_load(w + (size_t)k * 6144);
#pragma unroll
              for (int b = 0; b < 9; ++b) a[b] += sc[b * 1024 + k] * wv; }
#pragma unroll
          for (int b = 0; b < 9; ++b) red[(kq * 9 + b) * 128 + (tid & 127)] = a[b];
          __syncthreads();
          for (int i = tid; i < 9 * 128; i += 512) { const int b = i >> 7, c = i & 127;
              mods[((size_t)l * 9 + b) * 6144 + nb * 128 + c] = red[(0 * 9 + b) * 128 + c] + red[(1 * 9 + b) * 128 + c] + red[(2 * 9 + b) * 128 + c] + red[(3 * 9 + b) * 128 + c] + p.in[5][(size_t)l * 6144 + nb * 128 + c]; }
          __syncthreads();
      } }
    { const int wave = (blockIdx.x * 512 + tid) >> 6, lane = tid & 63, nw = G * 8;
      bf16_t* aqk = (bf16_t*)(p.out + W_AQK); bf16_t* av = (bf16_t*)(p.out + W_AV);
      for (int job = wave; job < 4096; job += nw) {
          const int isv = job >> 11, hc = job & 2047, h = hc >> 9, c = hc & 511;
          float a[16];
#pragma unroll
          for (int g = 0; g < 16; ++g) a[g] = 0.f;
          const int npass = isv ? 1 : 2;
          for (int ps = 0; ps < npass; ++ps) {
              const int which = isv ? 2 : ps;
              const float* wrow = p.in[which == 0 ? 20 : (which == 1 ? 21 : 22)] + ((size_t)h * 512 + c) * 512 + lane * 8;
#pragma unroll
              for (int e = 0; e < 8; ++e) { const float wv = wrow[e]; const int ef = h * 512 + lane * 8 + e;
#pragma unroll
                  for (int z = 0; z < 2; ++z) { const float* gp = p.in[23] + (((size_t)z * 3 + which) * 2048 + ef) * 8;
#pragma unroll
                      for (int jx = 0; jx < 8; ++jx) a[z * 8 + jx] += wv * gp[jx]; } }
          }
#pragma unroll
          for (int g = 0; g < 16; ++g) { const float s = wave_sum(a[g]); if (lane == g) (isv ? av : aqk)[(size_t)g * 2048 + hc] = (bf16_t)(cvt_pk_bf16(s, 0.f) & 0xffffu); }
      } }
}

__device__ void phase_embed(const Params& p) {
    const int tid_ = TIDX; const int wave = (blockIdx.x * 512 + tid_) >> 6, lane = tid_ & 63, nw = 2048;
    const float* mods = (const float*)(p.out + W_MODS); _Float16* hb = (_Float16*)(p.out + O_HB); bf16_t* ub = (bf16_t*)(p.ws + S_UB);
    for (int R = wave; R < NR; R += nw) {
        const float* src = row_src(p, R); const float* mp = mods + (size_t)row_bm(R) * 6144;
#pragma unroll
        for (int i = 0; i < 2; ++i) { const int c = lane * 8 + i * 512;
            const f32x4 x0 = *(const f32x4*)(src + c), x1 = *(const f32x4*)(src + c + 4);
            const f32x4 sh0 = *(const f32x4*)(mp + c), sh1 = *(const f32x4*)(mp + c + 4), sc0 = *(const f32x4*)(mp + 1024 + c), sc1 = *(const f32x4*)(mp + 1024 + c + 4);
            f16x8 hv;
#pragma unroll
            for (int j = 0; j < 4; ++j) { hv[j] = (_Float16)x0[j]; hv[4 + j] = (_Float16)x1[j]; }
            *(f16x8*)(hb + (size_t)R * 1024 + c) = hv;
            *(u32x4*)(ub + (size_t)R * 1024 + c) = pack8(x0 * (sc0 + 1.0f) + sh0, x1 * (sc1 + 1.0f) + sh1); }
    }
}
__device__ void phase_ln(const Params& p, const _Float16* tsrc, int l, int which, int mod_l, int mod_idx, int mode, float probe_b = 0.f, const float* cpa = nullptr, const float* cpb = nullptr) {
    const int tid_ = TIDX; const int wave = (blockIdx.x * 512 + tid_) >> 6, lane = tid_ & 63, nw = 2048;
    const float* mods = (const float*)(p.out + W_MODS) + (size_t)(mod_l < 0 ? 0 : mod_l) * 9 * 6144; _Float16* hb = (_Float16*)(p.out + O_HB); bf16_t* ub = (bf16_t*)(p.ws + S_UB);
    const float* lg = p.in[6] + ((size_t)l * 2 + which) * 1024; const float* lb = p.in[7] + ((size_t)l * 2 + which) * 1024;
    f16x8 n0 = *(const f16x8*)(tsrc + (size_t)wave * 1024 + lane * 8), n1 = *(const f16x8*)(tsrc + (size_t)wave * 1024 + 512 + lane * 8);
    for (int R = wave; R < NR; R += nw) {
        const f16x8 t0 = n0, t1 = n1;
        if (R + nw < NR) { n0 = *(const f16x8*)(tsrc + (size_t)(R + nw) * 1024 + lane * 8); n1 = *(const f16x8*)(tsrc + (size_t)(R + nw) * 1024 + 512 + lane * 8); }
        const int hf = R >= HR ? 1 : 0, r = R - hf * HR; if (mode != 0 && r >= HLAT) continue;
        float x[16]; float s = 0.f;
#pragma unroll
        for (int j = 0; j < 8; ++j) { x[j] = (float)t0[j]; x[8 + j] = (float)t1[j]; }
        if (cpa != nullptr && r >= HLAT) {
            const size_t o = (size_t)(hf * 1024 + (r - HLAT)) * 1024 + lane * 8;
#pragma unroll
            for (int i = 0; i < 2; ++i) { const f32x4 a0 = *(const f32x4*)(cpa + o + i * 512), a1 = *(const f32x4*)(cpa + o + i * 512 + 4), b0 = *(const f32x4*)(cpb + o + i * 512), b1 = *(const f32x4*)(cpb + o + i * 512 + 4);
#pragma unroll
                for (int j = 0; j < 4; ++j) { x[i * 8 + j] = ALPHA * x[i * 8 + j] + (a0[j] + b0[j]); x[i * 8 + 4 + j] = ALPHA * x[i * 8 + 4 + j] + (a1[j] + b1[j]); } } }
#pragma unroll
        for (int j = 0; j < 16; ++j) s += x[j];
        const float mu = wave_sum(s) * (1.0f / 1024.0f); float q = 0.f;
#pragma unroll
        for (int j = 0; j < 16; ++j) { x[j] -= mu; q += x[j] * x[j]; }
        const float rstd = rsqrtf(wave_sum(q) * (1.0f / 1024.0f) + LNEPS);
        const float* mp = mods + (size_t)row_bm(R) * 6144;
#pragma unroll
        for (int i = 0; i < 2; ++i) { const int c = lane * 8 + i * 512;
            const f32x4 g0 = *(const f32x4*)(lg + c), g1 = *(const f32x4*)(lg + c + 4), b0 = *(const f32x4*)(lb + c), b1 = *(const f32x4*)(lb + c + 4);
            f32x4 h0, h1;
#pragma unroll
            for (int j = 0; j < 4; ++j) { h0[j] = x[i * 8 + j] * rstd * g0[j] + b0[j]; h1[j] = x[i * 8 + 4 + j] * rstd * g1[j] + b1[j]; }
            if (mode == 2) {
#ifdef PROBE
                if (hf == 1) { h0 += probe_b; h1 += probe_b; }
#endif
                float* o = (float*)p.out + ((size_t)(hf * 4 + (r >> 12)) * SEQ + (r & 4095)) * DM + c;
                *(f32x4*)o = h0; *(f32x4*)(o + 4) = h1;
            } else {
                f16x8 hv;
#pragma unroll
                for (int j = 0; j < 4; ++j) { hv[j] = (_Float16)h0[j]; hv[4 + j] = (_Float16)h1[j]; }
                *(f16x8*)(hb + (size_t)R * 1024 + c) = hv;
                const f32x4 sh0 = *(const f32x4*)(mp + mod_idx * 1024 + c), sh1 = *(const f32x4*)(mp + mod_idx * 1024 + c + 4);
                const f32x4 sc0 = *(const f32x4*)(mp + (mod_idx + 1) * 1024 + c), sc1 = *(const f32x4*)(mp + (mod_idx + 1) * 1024 + c + 4);
                *(u32x4*)(ub + (size_t)R * 1024 + c) = pack8(h0 * (sc0 + 1.0f) + sh0, h1 * (sc1 + 1.0f) + sh1);
            } }
    }
}

template <int W>
DI void box64(const float (&v)[64], LAS float* dst, int stride) {
#pragma unroll
    for (int t = 0; t < 64; ++t) { const int lo = t - W / 2 < 0 ? 0 : t - W / 2, hi = t + W - W / 2 > 64 ? 64 : t + W - W / 2; float s = 0.f;
#pragma unroll
        for (int j = lo; j < hi; ++j) s += v[j];
        dst[t * stride] = s * (1.0f / (float)(hi - lo)); }
}
template <int W>
DI void pool_lat_item(bf16_t* slab  , LAS float* buf) {
    const int tid = TIDX;
#pragma unroll
    for (int i = 0; i < 8; ++i) { const int t = tid + i * 512; const u32x4 w = *(const u32x4*)(slab + (size_t)t * 8); LAS float* d = buf + t * 8 + (t >> 6) * 8;
        *(LAS f32x4*)d = (f32x4){bflo(w.x), bfhi(w.x), bflo(w.y), bfhi(w.y)}; *(LAS f32x4*)(d + 4) = (f32x4){bflo(w.z), bfhi(w.z), bflo(w.w), bfhi(w.w)}; }
    __syncthreads();
    { const int c = tid >> 3, ch = tid & 7; float v[64];
#pragma unroll
      for (int r = 0; r < 64; ++r) v[r] = buf[r * 520 + c * 8 + ch];
      box64<W>(v, buf + c * 8 + ch, 520); }
    __syncthreads();
    { const int r = tid >> 3, ch = tid & 7; float v[64];
#pragma unroll
      for (int c = 0; c < 64; ++c) v[c] = buf[r * 520 + c * 8 + ch];
      box64<W>(v, buf + r * 520 + ch, 8); }
    __syncthreads();
#pragma unroll
    for (int i = 0; i < 8; ++i) { const int t = tid + i * 512; const u32x4 w = *(const u32x4*)(slab + (size_t)t * 8); const LAS float* d = buf + t * 8 + (t >> 6) * 8;
        const f32x4 p0 = *(const LAS f32x4*)d, p1 = *(const LAS f32x4*)(d + 4);
        const f32x4 s0 = (f32x4){bflo(w.x), bfhi(w.x), bflo(w.y), bfhi(w.y)}, s1 = (f32x4){bflo(w.z), bfhi(w.z), bflo(w.w), bfhi(w.w)};
        *(u32x4*)(slab + (size_t)t * 8) = pack8(p0 - s0, p1 - s1); }
    __syncthreads();
}
__device__ void phase_poolconv(const Params& p, LAS unsigned char* lds) {
    const int tid = TIDX, G = 256;
    bf16_t* aslab = (bf16_t*)(p.ws + S_R1); const bf16_t* glu = (const bf16_t*)(p.ws + S_R1 + 34 * MiB); bf16_t* ycat = (bf16_t*)(p.ws + S_R2);
    const int NPL = 512, NCV = 1088, NPC = 512;
    for (int it = blockIdx.x; it < NPL + NCV + NPC; it += G) {
        if (it < NPL) {
            const int b = it >> 6, sl = it & 63; const int R0 = (b >> 2) * HR + (b & 3) * SEQ;
            bf16_t* slab = aslab + ((size_t)sl * NR + R0) * 8; LAS float* buf = (LAS float*)lds;
            const int gi = sl >> 4;
            if (gi == 0) pool_lat_item<2>(slab, buf); else if (gi == 1) pool_lat_item<4>(slab, buf); else if (gi == 2) pool_lat_item<8>(slab, buf); else pool_lat_item<16>(slab, buf);
        } else if (it < NPL + NCV) {
            const int ci = it - NPL; int R0, len, t0;
            if (ci < 1024) { const int b = ci >> 7; R0 = (b >> 2) * HR + (b & 3) * SEQ; len = SEQ; t0 = (ci & 127) * 32; }
            else { const int cj = ci - 1024, b = cj >> 3; R0 = (b >> 2) * HR + HLAT + (b & 3) * CTXL; len = CTXL; t0 = (cj & 7) * 32; }
            LAS unsigned* gin = (LAS unsigned*)lds;
            LAS float* cout = (LAS float*)(lds + 62 * 1024);
            for (int i = tid; i < 62 * 64; i += 512) { const int rr = i >> 6, cc = i & 63, t = t0 - 15 + rr;
                u32x4 w = (u32x4){0u, 0u, 0u, 0u}; if (t >= 0 && t < len) w = *(const u32x4*)(glu + (size_t)(R0 + t) * 512 + cc * 8);
                *(LAS u32x4*)(gin + rr * 256 + cc * 4) = w; }
            __syncthreads();
            { const float* cw = p.in[12] + tid; float w[31];
#pragma unroll
              for (int j = 0; j < 31; ++j) w[j] = cw[j * 512];
              float a[32]; const float cb0 = p.in[13][tid];
#pragma unroll
              for (int t = 0; t < 32; ++t) a[t] = cb0;
              const LAS unsigned short* gs = (const LAS unsigned short*)gin + tid;
#pragma unroll
              for (int rr = 0; rr < 62; ++rr) { const float x = bf2f(gs[rr * 512]);
#pragma unroll
                  for (int t = 0; t < 32; ++t) { const int j = rr - t; if (j >= 0 && j < 31) a[t] += w[j] * x; } }
#pragma unroll
              for (int t = 0; t < 32; ++t) cout[t * 512 + tid] = a[t]; }
            __syncthreads();
            { const int wv = tid >> 6, lane = tid & 63;
              for (int tt = 0; tt < 4; ++tt) { const int t = wv * 4 + tt; const LAS float* rp = cout + t * 512 + lane * 8;
                  const f32x4 v0 = *(const LAS f32x4*)rp, v1 = *(const LAS f32x4*)(rp + 4);
                  float s = (v0[0] + v0[1]) + (v0[2] + v0[3]) + (v1[0] + v1[1]) + (v1[2] + v1[3]);
                  const float mu = wave_sum(s) * (1.0f / 512.0f); const f32x4 d0 = v0 - mu, d1 = v1 - mu;
                  float q = d0[0] * d0[0] + d0[1] * d0[1] + d0[2] * d0[2] + d0[3] * d0[3] + d1[0] * d1[0] + d1[1] * d1[1] + d1[2] * d1[2] + d1[3] * d1[3];
                  const float rstd = rsqrtf(wave_sum(q) * (1.0f / 512.0f) + LNEPS);
                  const float* ng = p.in[14] + lane * 8; const float* nb = p.in[15] + lane * 8; f32x4 y0, y1;
#pragma unroll
                  for (int j = 0; j < 4; ++j) { y0[j] = siluf_(d0[j] * rstd * ng[j] + nb[j]); y1[j] = siluf_(d1[j] * rstd * ng[4 + j] + nb[4 + j]); }
                  *(u32x4*)(ycat + (size_t)(R0 + t0 + t) * 1024 + 512 + lane * 8) = pack8(y0, y1); } }
            __syncthreads();
        } else {
            const int pi = it - NPL - NCV, b = pi >> 6, sl = pi & 63; const int R0 = (b >> 2) * HR + HLAT + (b & 3) * CTXL; const int W = 2 << (sl >> 4);
            bf16_t* slab = aslab + ((size_t)sl * NR + R0) * 8; LAS float* buf = (LAS float*)lds;
            if (tid < 256) { const u32x4 w = *(const u32x4*)(slab + (size_t)tid * 8);
                *(LAS f32x4*)(buf + tid * 8) = (f32x4){bflo(w.x), bfhi(w.x), bflo(w.y), bfhi(w.y)}; *(LAS f32x4*)(buf + tid * 8 + 4) = (f32x4){bflo(w.z), bfhi(w.z), bflo(w.w), bfhi(w.w)}; }
            __syncthreads();
            f32x4 d = (f32x4){0.f, 0.f, 0.f, 0.f}; const int t = tid >> 1, hc = (tid & 1) * 4;
            { const int lo = t - W / 2 < 0 ? 0 : t - W / 2, hi = t + W - W / 2 > 256 ? 256 : t + W - W / 2; f32x4 s = (f32x4){0.f, 0.f, 0.f, 0.f};
              for (int j = lo; j < hi; ++j) s += *(const LAS f32x4*)(buf + j * 8 + hc);
              d = s * (1.0f / (float)(hi - lo)) - *(const LAS f32x4*)(buf + t * 8 + hc); }
            u32x2 o; o.x = cvt_pk_bf16(d[0], d[1]); o.y = cvt_pk_bf16(d[2], d[3]);
            *(u32x2*)(slab + (size_t)t * 8 + hc) = o;
            __syncthreads();
        }
    }
}

__device__ void phase_mlconv(const Params& p, int hf) {
    const int tid_ = TIDX; const int wave = (blockIdx.x * 512 + tid_) >> 6, lane = tid_ & 63, nw = 2048, tk = lane & 15, g = lane >> 4;
    const bf16_t* xm = (const bf16_t*)(p.ws + S_R1); bf16_t* xc = (bf16_t*)(p.ws + S_R2); float* gates = (float*)(p.ws + S_GATES);
    const bf16_t* aqk = (const bf16_t*)(p.out + W_AQK); const bf16_t* av = (const bf16_t*)(p.out + W_AV);
    const float* cw = p.in[18]; const float* cb = p.in[19];
    (void)wave; (void)nw;
    for (int it = (tid_ >> 6) * 256 + (int)blockIdx.x; it < HR / 16; it += 2048) {
        const int r = it * 16 + tk; const int pos = r < HLAT ? (r & 4095) : ((r - HLAT) & 255), len = r < HLAT ? SEQ : CTXL;
        const bool hasp = pos > 0, hasn = pos < len - 1;
        f32x4 acc = (f32x4){0.f, 0.f, 0.f, 0.f};
#pragma unroll 2
        for (int ks = 0; ks < 64; ++ks) { const int c0 = ks * 32 + g * 8;
            const u32x4 z4 = (u32x4){0u, 0u, 0u, 0u};
            const u32x4 wc_ = *(const u32x4*)(xm + (size_t)r * 2048 + c0);
            const u32x4 wp = hasp ? *(const u32x4*)(xm + (size_t)(r - 1) * 2048 + c0) : z4;
            const u32x4 wn = hasn ? *(const u32x4*)(xm + (size_t)(r + 1) * 2048 + c0) : z4;
            float o[8];
            float w0v[8], w1v[8], w2v[8], bbv[8];
            { const f32x4 a0 = *(const f32x4*)(cw + c0), a1 = *(const f32x4*)(cw + c0 + 4), b0 = *(const f32x4*)(cw + 2048 + c0), b1 = *(const f32x4*)(cw + 2048 + c0 + 4);
              const f32x4 c0v = *(const f32x4*)(cw + 4096 + c0), c1v = *(const f32x4*)(cw + 4096 + c0 + 4), d0 = *(const f32x4*)(cb + c0), d1 = *(const f32x4*)(cb + c0 + 4);
#pragma unroll
              for (int e = 0; e < 4; ++e) { w0v[e] = a0[e]; w0v[4 + e] = a1[e]; w1v[e] = b0[e]; w1v[4 + e] = b1[e]; w2v[e] = c0v[e]; w2v[4 + e] = c1v[e]; bbv[e] = d0[e]; bbv[4 + e] = d1[e]; } }
#pragma unroll
            for (int j = 0; j < 4; ++j) { const unsigned a = wp[j], b = wc_[j], c = wn[j];
                o[2 * j] = siluf_(w0v[2 * j] * bflo(a) + w1v[2 * j] * bflo(b) + w2v[2 * j] * bflo(c) + bbv[2 * j]);
                o[2 * j + 1] = siluf_(w0v[2 * j + 1] * bfhi(a) + w1v[2 * j + 1] * bfhi(b) + w2v[2 * j + 1] * bfhi(c) + bbv[2 * j + 1]); }
            u32x4 xo; xo.x = cvt_pk_bf16(o[0], o[1]); xo.y = cvt_pk_bf16(o[2], o[3]); xo.z = cvt_pk_bf16(o[4], o[5]); xo.w = cvt_pk_bf16(o[6], o[7]);
            *(u32x4*)(xc + (size_t)r * 2048 + c0) = xo;
            const bf16x8 bq = *(const bf16x8*)(aqk + (size_t)tk * 2048 + c0), bv = *(const bf16x8*)(av + (size_t)tk * 2048 + c0);
            acc = __builtin_amdgcn_mfma_f32_16x16x32_bf16(__builtin_bit_cast(bf16x8, xo), bq, acc, 0, 0, 0);
            acc = __builtin_amdgcn_mfma_f32_16x16x32_bf16(__builtin_bit_cast(bf16x8, wc_), bv, acc, 0, 0, 0); }
        const float bg = p.in[24][tk];
#pragma unroll
        for (int i = 0; i < 4; ++i) { float v = acc[i] + bg; if ((tk & 7) >= 4) v = fminf(v, 0.f) - log1pf(__expf(-fabsf(v)));
            gates[((size_t)hf * HR + it * 16 + 4 * g + i) * 16 + tk] = v; }
    }
}

__device__ void phase_mlout(const Params& p) {
    const int tid_ = TIDX; const int wave = (blockIdx.x * 512 + tid_) >> 6, lane = tid_ & 63, nw = 2048;
    const bf16_t* hfw = (const bf16_t*)(p.ws + S_R1); const bf16_t* hbw = (const bf16_t*)(p.ws + S_R6); bf16_t* xc = (bf16_t*)(p.ws + S_R2); const bf16_t* z = (const bf16_t*)(p.ws + S_R3);
    const float* ng = p.in[25]; const float* sk = p.in[26];
    for (int r0 = wave * 4; r0 < HLAT; r0 += nw * 4) {
#pragma unroll 1
        for (int hh = 0; hh < 4; ++hh) { const int c = hh * 512 + lane * 8;
            float st[4][8];
#pragma unroll
            for (int b = 0; b < 4; ++b) { const size_t o = (size_t)(r0 + b) * 2048 + c; const u32x4 av = *(const u32x4*)(hfw + o), bv = *(const u32x4*)(hbw + o);
#pragma unroll
                for (int j = 0; j < 4; ++j) { st[b][2 * j] = bflo(av[j]) + bflo(bv[j]); st[b][2 * j + 1] = bfhi(av[j]) + bfhi(bv[j]); } }
            const f32x4 g0 = *(const f32x4*)(ng + c), g1 = *(const f32x4*)(ng + c + 4), k0 = *(const f32x4*)(sk + c), k1 = *(const f32x4*)(sk + c + 4);
#pragma unroll
            for (int a = 0; a < 4; ++a) { const size_t o = (size_t)(r0 + a) * 2048 + c; const u32x4 xw = *(const u32x4*)(xc + o), zw = *(const u32x4*)(z + o);
                float x[8]; float s = 0.f;
#pragma unroll
                for (int q = 0; q < 2; ++q)
#pragma unroll
                    for (int b = 0; b < 4; ++b) { x[4 * q + b] = st[b][4 * q + a]; s += x[4 * q + b]; }
                const float mu = wave_sum(s) * (1.0f / 512.0f); float qq = 0.f;
#pragma unroll
                for (int j = 0; j < 8; ++j) { x[j] -= mu; qq += x[j] * x[j]; }
                const float rstd = rsqrtf(wave_sum(qq) * (1.0f / 512.0f) + LNEPS);
                float y[8];
#pragma unroll
                for (int j = 0; j < 4; ++j) { const float gA = j < 2 ? g0[2 * j] : g1[2 * j - 4], gB = j < 2 ? g0[2 * j + 1] : g1[2 * j - 3], sA = j < 2 ? k0[2 * j] : k1[2 * j - 4], sB = j < 2 ? k0[2 * j + 1] : k1[2 * j - 3];
                    y[2 * j] = (x[2 * j] * rstd * gA + sA * bflo(xw[j])) * siluf_(bflo(zw[j]));
                    y[2 * j + 1] = (x[2 * j + 1] * rstd * gB + sB * bfhi(xw[j])) * siluf_(bfhi(zw[j])); }
                u32x4 w; w.x = cvt_pk_bf16(y[0], y[1]); w.y = cvt_pk_bf16(y[2], y[3]); w.z = cvt_pk_bf16(y[4], y[5]); w.w = cvt_pk_bf16(y[6], y[7]);
                *(u32x4*)(xc + o) = w; } }
    }
}

constexpr int QS_STRIDE = 1040, KT_STRIDE = 144, PS_STRIDE = 144;
constexpr int L_QS = 0, L_KT = 64 * QS_STRIDE  , L_PS = L_KT + 512 * KT_STRIDE  , PS_HALF = 64 * PS_STRIDE  , L_VEC = L_PS + 2 * PS_HALF  ;
static_assert(L_VEC + 3840 <= LDS_BYTES, "scan LDS");
#define LDS_BAR() asm volatile("s_waitcnt lgkmcnt(0)\n\ts_barrier" ::: "memory")
struct ScanPos { int chunk, rowbase; bool isctx; };
DI ScanPos scan_pos(int step, int dir, int bl) {
    ScanPos sp; sp.isctx = step < 4; const int ci = sp.isctx ? step : step - 4, nchunk = sp.isctx ? 4 : 64;
    const int cn = dir ? nchunk - 1 - ci : ci;
    sp.chunk = sp.isctx ? 256 + bl * 4 + cn : bl * 64 + cn;
    sp.rowbase = sp.isctx ? HLAT + bl * CTXL + cn * 64 : bl * SEQ + cn * 64;
    return sp;
}
__device__ void phase_pre(const Params& p, int hf) {
    const int tid_ = TIDX; const int wave = (blockIdx.x * 512 + tid_) >> 6, lane = tid_ & 63;
    const float* gates = (const float*)(p.ws + S_GATES) + (size_t)hf * HR * 16; float* pre = (float*)(p.ws + S_PRE);
    for (int job = wave; job < 32 * 68; job += 2048) { const int combo = job / 68, c = job - combo * 68, dir = combo & 1, h = (combo >> 1) & 3, bl = combo >> 3;
        const ScanPos sp = scan_pos(c, dir, bl); const int pp = dir ? 63 - lane : lane;
        const float ic = gates[(size_t)(sp.rowbase + pp) * 16 + dir * 8 + h], fc = gates[(size_t)(sp.rowbase + pp) * 16 + dir * 8 + 4 + h];
        float bcs = fc;
#pragma unroll
        for (int o = 1; o < 64; o <<= 1) { const float t = __shfl_up(bcs, o); if (lane >= o) bcs += t; }
        const float blast = __shfl(bcs, 63); const float mw = wave_max(blast - bcs + ic);
        float cm = ic - bcs;
#pragma unroll
        for (int o = 1; o < 64; o <<= 1) { const float t = __shfl_up(cm, o); if (lane >= o) cm = fmaxf(cm, t); }
        *(f32x4*)(pre + ((size_t)job * 64 + lane) * 4) = (f32x4){bcs, cm, ic, 0.f};
        if (lane == 0) { pre[PRE_V + job * 2] = blast; pre[PRE_V + job * 2 + 1] = mw; } }
}
__device__ void phase_intra(const Params& p, LAS unsigned char* lds) {
    const int tid = TIDX, wid = __builtin_amdgcn_readfirstlane(tid >> 6), lane = tid & 63, tk = lane & 15, g = lane >> 4;
    const bf16_t* qc = (const bf16_t*)(p.ws + S_R3); const bf16_t* kc = (const bf16_t*)(p.ws + S_R4); const bf16_t* vtc = (const bf16_t*)(p.ws + S_R5);
    const float* pre = (const float*)(p.ws + S_PRE); float* RS = (float*)(p.ws + S_RS);
    LAS float* V_ = (LAS float*)(lds + 2 * PS_HALF);
    { const int k = wid >> 1, d = wid & 1; const int item = (int)blockIdx.x + 256 * k; const int bl = item >> 8, h = (item >> 6) & 3, cn = item & 63;
      const int combo = d + 2 * h + 8 * bl, kq = d ? 63 - cn : cn;
      const float* sc = pre + PRE_V + (size_t)combo * 68 * 2;
      float m4 = 0.f;
#pragma unroll
      for (int kk = 0; kk < 4; ++kk) m4 = fmaxf(sc[kk * 2] + m4, sc[kk * 2 + 1]);
      float B = sc[(4 + lane) * 2], W = sc[(4 + lane) * 2 + 1];
#pragma unroll
      for (int o = 1; o < 64; o <<= 1) { const float Bp = __shfl_up(B, o), Wp = __shfl_up(W, o); if (lane >= o) { W = fmaxf(Wp + B, W); B = Bp + B; } }
      const float mafter = fmaxf(m4 + B, W); const float mprev = __shfl(mafter, kq > 0 ? kq - 1 : 0); const float mstart = kq > 0 ? mprev : m4;
      const f32x4 pv = *(const f32x4*)(pre + (((size_t)combo * 68 + 4 + kq) * 64 + lane) * 4); const int pp = d ? 63 - lane : lane;
      V_[k * 256 + d * 64 + pp] = pv[2] - pv[0]; V_[k * 256 + 128 + d * 64 + pp] = fmaxf(mstart, pv[1]); }
    __syncthreads();
    for (int ks = 0; ks < 4; ++ks) { const int item = (int)blockIdx.x + 256 * ks;
        const int bl = item >> 8, h = (item >> 6) & 3, cn = item & 63; const int chunk = bl * 64 + cn, rowbase = bl * SEQ + cn * 64;
        const LAS float* A_ = V_ + ks * 256; const LAS float* M_ = A_ + 128;
        {
            const int st = wid >> 1, tt0 = 2 * (wid & 1); f32x4 S0 = (f32x4){0.f, 0.f, 0.f, 0.f}, S1 = S0;
            const bf16_t* ka = kc + ((size_t)chunk * 4 + h) * 64 * 512 + (size_t)(st * 16 + tk) * 512 + g * 8;
            const bf16_t* qa = qc + ((size_t)chunk * 4 + h) * 64 * 512 + (size_t)(tt0 * 16 + tk) * 512 + g * 8;
#pragma unroll 8
            for (int kk = 0; kk < 16; ++kk) { const bf16x8 a = *(const bf16x8*)(ka + kk * 32), b0 = *(const bf16x8*)(qa + kk * 32), b1 = *(const bf16x8*)(qa + 16 * 512 + kk * 32);
                S0 = __builtin_amdgcn_mfma_f32_16x16x32_bf16(a, b0, S0, 0, 0, 0); S1 = __builtin_amdgcn_mfma_f32_16x16x32_bf16(a, b1, S1, 0, 0, 0); }
#pragma unroll
            for (int d = 0; d < 2; ++d)
#pragma unroll
                for (int x = 0; x < 2; ++x) { const int t = (tt0 + x) * 16 + tk; const float Mt = M_[d * 64 + t]; const f32x4 Sv = x ? S1 : S0; float pv[4]; float psum = 0.f;
#pragma unroll
                    for (int i = 0; i < 4; ++i) { const int sx = st * 16 + 4 * g + i; const bool ok = d ? (sx >= t) : (sx <= t);
                        const float dd = ok ? __expf(A_[d * 64 + sx] - Mt) : 0.f; pv[i] = Sv[i] * dd; psum += pv[i]; }
                    u32x2 w; w.x = cvt_pk_bf16(pv[0], pv[1]); w.y = cvt_pk_bf16(pv[2], pv[3]);
                    *(LAS u32x2*)(lds + d * PS_HALF + t * PS_STRIDE + (st * 16 + 4 * g) * 2) = w;
                    (void)psum; } }
        __syncthreads();
        {
            u32x4 va[4][2];
#pragma unroll
            for (int mi = 0; mi < 4; ++mi) { const bf16_t* vg = vtc + (((size_t)chunk * 4 + h) * 512 + wid * 64 + mi * 16 + tk) * 64; va[mi][0] = *(const u32x4*)(vg + g * 8); va[mi][1] = *(const u32x4*)(vg + 32 + g * 8); }
#pragma unroll
            for (int d = 0; d < 2; ++d) { bf16_t* hout = (bf16_t*)(p.ws + (d ? S_R6 : S_R1));
#pragma unroll
                for (int ni = 0; ni < 4; ++ni) { const bf16x8 pb0 = *(const LAS bf16x8*)(lds + d * PS_HALF + (ni * 16 + tk) * PS_STRIDE + (g * 8) * 2), pb1 = *(const LAS bf16x8*)(lds + d * PS_HALF + (ni * 16 + tk) * PS_STRIDE + (32 + g * 8) * 2);
#pragma unroll
                    for (int mi = 0; mi < 4; ++mi) { f32x4 acc = (f32x4){0.f, 0.f, 0.f, 0.f};
                        acc = __builtin_amdgcn_mfma_f32_16x16x32_bf16(pb0, __builtin_bit_cast(bf16x8, va[mi][0]), acc, 0, 0, 0);
                        acc = __builtin_amdgcn_mfma_f32_16x16x32_bf16(pb1, __builtin_bit_cast(bf16x8, va[mi][1]), acc, 0, 0, 0);
                        u32x2 w; w.x = cvt_pk_bf16_mfma(acc[0], acc[1]); w.y = cvt_pk_bf16_mfma(acc[2], acc[3]);
                        *(u32x2*)(hout + (size_t)(rowbase + ni * 16 + 4 * g + (tk & 3)) * 2048 + h * 512 + wid * 64 + mi * 16 + (tk & ~3)) = w; } } } }
        if (tid < 128) { const int d = tid >> 6, t = tid & 63; float sum = 0.f;
#pragma unroll
            for (int i = 0; i < 8; ++i) { const u32x4 w = *(const LAS u32x4*)(lds + d * PS_HALF + t * PS_STRIDE + i * 16); sum += (bflo(w.x) + bfhi(w.x)) + (bflo(w.y) + bfhi(w.y)) + (bflo(w.z) + bfhi(w.z)) + (bflo(w.w) + bfhi(w.w)); }
            RS[((size_t)(rowbase + t) * 2 + d) * 4 + h] = sum; }
        __syncthreads();
    }
}

__device__ void phase_scan(const Params& p, int hf, LAS unsigned char* lds) {
    const int tid0 = TIDX, wid = __builtin_amdgcn_readfirstlane(tid0 >> 6);
    const int wg = blockIdx.x, vs = wg >> 5, dir = wg & 1, h = (wg >> 1) & 3, bl = (wg >> 3) & 3;
    const int dvg = wid & 3, kh = wid >> 2;
    const bf16_t* qc = (const bf16_t*)(p.ws + S_R3); const bf16_t* kc = (const bf16_t*)(p.ws + S_R4); const bf16_t* vtc = (const bf16_t*)(p.ws + S_R5);
    bf16_t* hout = (bf16_t*)(p.ws + (dir ? S_R6 : S_R1));
    (void)hf;
    LAS float* vec = (LAS float*)(lds + L_VEC);
    LAS float* fin4 = vec  , *e_p = vec + 256, *iw_p = vec + 320, *qn = vec + 384;
    LAS unsigned* nbf = (LAS unsigned*)(vec + 448);
    LAS unsigned* ebf = (LAS unsigned*)(vec + 704);
    f32x4 C[16];
#pragma unroll
    for (int i = 0; i < 16; ++i) C[i] = (f32x4){0.f, 0.f, 0.f, 0.f};
    float nreg = 0.f; ((LAS unsigned short*)nbf)[tid0] = 0;
    float mstate = 0.f;
    const int dvw = vs * 64 + dvg * 16;
    const int combo = wg & 31; const float* pre = (const float*)(p.ws + S_PRE) + (size_t)combo * 68 * 256; const float* pres = (const float*)(p.ws + S_PRE) + PRE_V + (size_t)combo * 68 * 2;
    const float* RS = (const float*)(p.ws + S_RS);
    f32x4 pv_n; float bl_n, mw_n, rs_n = 0.f; u32x2 numi_n[2] = {(u32x2){0u, 0u}, (u32x2){0u, 0u}}; u32x4 kr[8];
    { const ScanPos s0 = scan_pos(0, dir, bl); const int lane = tid0 & 63, tk = lane & 15, g = lane >> 4, pp = dir ? 63 - lane : lane;
      (void)pp; pv_n = *(const f32x4*)(pre + (size_t)lane * 4); bl_n = pres[0]; mw_n = pres[1];
      const bf16_t* kg = kc + ((size_t)s0.chunk * 4 + h) * 64 * 512 + (size_t)((wid >> 1) * 16 + tk) * 512 + (wid & 1) * 256 + g * 8;
#pragma unroll
      for (int j = 0; j < 8; ++j) kr[j] = *(const u32x4*)(kg + j * 32); }
    __syncthreads();
    for (int step = 0; step < 68; ++step) {
        int tid = tid0; asm volatile("" : "+v"(tid));
        const int lane = tid & 63, tk = lane & 15, g = lane >> 4;
        const ScanPos cur = scan_pos(step, dir, bl); const bool isctx = cur.isctx; const int rowbase = cur.rowbase;
        const bool has_next = step < 67; const ScanPos nxt = scan_pos(has_next ? step + 1 : step, dir, bl);
        const int pp = dir ? 63 - lane : lane;
        const u32x2 numi_c0 = numi_n[0], numi_c1 = numi_n[1];
        const float bcs = pv_n[0], cm = pv_n[1], ic = pv_n[2], blast = bl_n;
        const float mnew = fmaxf(blast + mstate, mw_n);
        const float decay = __expf(blast + mstate - mnew);
        const float ev = __expf(blast - bcs + ic - mnew);
        const float av = ic - bcs;
        const float Mx = fmaxf(mstate, cm);
        if (wid == 0) { (void)av; const float iwv = __expf(mstate - Mx); e_p[pp] = ev; iw_p[pp] = iwv; fin4[pp * 4] = iwv; fin4[pp * 4 + 2] = __expf(-(bcs + Mx)); fin4[lane * 4 + 1] = rs_n; ((LAS unsigned short*)ebf)[pp] = (unsigned short)(cvt_pk_bf16(ev, 0.f) & 0xffffu); }
        { const int sel = tk & 1, srow = (wid >> 1) * 16 + tk, dk0 = (wid & 1) * 256 + g * 8 + (sel ? 4 : 0);
          LAS unsigned char* kb = lds + L_KT + dk0 * KT_STRIDE + (srow >> 1) * 4;
          const unsigned selLo = sel ? 0x05040100u : 0x01000504u, selHi = sel ? 0x07060302u : 0x03020706u;
#pragma unroll
          for (int j = 0; j < 8; ++j) { const u32x4 d = kr[j];
              const unsigned send0 = sel ? d[0] : d[2], send1 = sel ? d[1] : d[3], keep0 = sel ? d[2] : d[0], keep1 = sel ? d[3] : d[1];
              const unsigned recv0 = (unsigned)__builtin_amdgcn_update_dpp(0, (int)send0, 0xB1, 0xF, 0xF, false), recv1 = (unsigned)__builtin_amdgcn_update_dpp(0, (int)send1, 0xB1, 0xF, 0xF, false);
              LAS unsigned char* kp = kb + j * 32 * KT_STRIDE;
              *(LAS unsigned*)(kp) = __builtin_amdgcn_perm(keep0, recv0, selLo); *(LAS unsigned*)(kp + KT_STRIDE) = __builtin_amdgcn_perm(keep0, recv0, selHi);
              *(LAS unsigned*)(kp + 2 * KT_STRIDE) = __builtin_amdgcn_perm(keep1, recv1, selLo); *(LAS unsigned*)(kp + 3 * KT_STRIDE) = __builtin_amdgcn_perm(keep1, recv1, selHi); } }
        if (step == 4) {
            const bf16_t* qg = qc + ((size_t)cur.chunk * 4 + h) * 64 * 512;
#pragma unroll
            for (int i = 0; i < 8; ++i) { const int t = wid * 8 + i;
                __builtin_amdgcn_global_load_lds((const unsigned*)(qg + (size_t)t * 512 + lane * 8), (LAS unsigned*)(lds + L_QS + t * QS_STRIDE), 16, 0, 0); }
        }
        asm volatile("s_waitcnt vmcnt(0)" ::: "memory");
        LDS_BAR();
        const bf16_t* vg = vtc + (((size_t)cur.chunk * 4 + h) * 512 + dvw + tk) * 64;
        const u32x4 v0 = *(const u32x4*)(vg + g * 8), v1 = *(const u32x4*)(vg + 32 + g * 8);
        if (has_next) { pv_n = *(const f32x4*)(pre + ((size_t)(step + 1) * 64 + lane) * 4); bl_n = pres[(step + 1) * 2]; mw_n = pres[(step + 1) * 2 + 1];
                        if (!nxt.isctx) { rs_n = RS[((size_t)(nxt.rowbase + lane) * 2 + dir) * 4 + h];
#pragma unroll
                            for (int m2 = 0; m2 < 2; ++m2) numi_n[m2] = *(const u32x2*)(hout + (size_t)(nxt.rowbase + (kh * 2 + m2) * 16 + 4 * g + (tk & 3)) * 2048 + h * 512 + dvw + (tk & ~3)); } }
        f32x4 O[4];
        if (!isctx) {
            { const int t = tid >> 3, part = tid & 7; float s = 0.f;
#pragma unroll
              for (int i = 0; i < 8; ++i) { const u32x4 w = *(const LAS u32x4*)(lds + L_QS + t * QS_STRIDE + (i * 64 + part * 8) * 2); const u32x4 nv = *(const LAS u32x4*)(nbf + i * 32 + part * 4);
                  s = dot2bf(w.x, nv.x, s); s = dot2bf(w.y, nv.y, s); s = dot2bf(w.z, nv.z, s); s = dot2bf(w.w, nv.w, s); }
              s += __builtin_bit_cast(float, __builtin_amdgcn_update_dpp(0, __builtin_bit_cast(int, s), 0xB1, 0xF, 0xF, true));
              s += __builtin_bit_cast(float, __builtin_amdgcn_update_dpp(0, __builtin_bit_cast(int, s), 0x4E, 0xF, 0xF, true));
              s += __builtin_bit_cast(float, __builtin_amdgcn_update_dpp(0, __builtin_bit_cast(int, s), 0x104, 0xF, 0xF, true));
              if (part == 0) qn[t] = s; }
#pragma unroll
            for (int mt = 0; mt < 4; ++mt) O[mt] = (f32x4){0.f, 0.f, 0.f, 0.f};
            { u32x4 aw[2][4];
#define QC_LOAD(buf, j_) do { _Pragma("unroll") for (int mt = 0; mt < 4; ++mt) aw[buf][mt] = *(const LAS u32x4*)(lds + L_QS + (mt * 16 + tk) * QS_STRIDE + ((kh * 8 + (j_)) * 32 + 8 * g) * 2); } while (0)
              QC_LOAD(0, 0);
#pragma unroll
              for (int j = 0; j < 8; ++j) {
                  if (j < 7) QC_LOAD((j + 1) & 1, j + 1);
                  u32x4 bw; bw.x = cvt_pk_bf16(C[2 * j][0], C[2 * j][1]); bw.y = cvt_pk_bf16(C[2 * j][2], C[2 * j][3]); bw.z = cvt_pk_bf16(C[2 * j + 1][0], C[2 * j + 1][1]); bw.w = cvt_pk_bf16(C[2 * j + 1][2], C[2 * j + 1][3]);
                  const bf16x8 bb = __builtin_bit_cast(bf16x8, bw);
                  __builtin_amdgcn_sched_barrier(0);
#pragma unroll
                  for (int mt = 0; mt < 4; ++mt) O[mt] = __builtin_amdgcn_mfma_f32_16x16x32_bf16(__builtin_bit_cast(bf16x8, aw[j & 1][mt]), bb, O[mt], 0, 0, 0);
                  __builtin_amdgcn_sched_barrier(0); }
#undef QC_LOAD
            }
        }
        LDS_BAR();
        if (has_next) {
            if (!nxt.isctx) { const bf16_t* qg = qc + ((size_t)nxt.chunk * 4 + h) * 64 * 512;
#pragma unroll
                for (int i = 0; i < 8; ++i) { const int t = wid * 8 + i;
                    __builtin_amdgcn_global_load_lds((const unsigned*)(qg + (size_t)t * 512 + lane * 8), (LAS unsigned*)(lds + L_QS + t * QS_STRIDE), 16, 0, 0); } }
            const bf16_t* kgn = kc + ((size_t)nxt.chunk * 4 + h) * 64 * 512 + (size_t)((wid >> 1) * 16 + tk) * 512 + (wid & 1) * 256 + g * 8;
#pragma unroll
            for (int j = 0; j < 8; ++j) kr[j] = *(const u32x4*)(kgn + j * 32);
        }
        if (!isctx) {
            float numi[8];
            numi[0] = bflo(numi_c0.x); numi[1] = bfhi(numi_c0.x); numi[2] = bflo(numi_c0.y); numi[3] = bfhi(numi_c0.y); numi[4] = bflo(numi_c1.x); numi[5] = bfhi(numi_c1.x); numi[6] = bflo(numi_c1.y); numi[7] = bfhi(numi_c1.y);
#pragma unroll
            for (int mt = 0; mt < 4; ++mt) { const f32x4 iw4 = *(const LAS f32x4*)(iw_p + mt * 16 + 4 * g); O[mt] = O[mt] * iw4; }
            LAS float* xw = (LAS float*)(lds + L_PS) + (dvg * 2 + kh) * 512 + lane * 8;
            const LAS float* xr = (const LAS float*)(lds + L_PS) + (dvg * 2 + (kh ^ 1)) * 512 + lane * 8;
            *(LAS f32x4*)xw = kh ? O[0] : O[2]; *(LAS f32x4*)(xw + 4) = kh ? O[1] : O[3];
            LDS_BAR();
            { const f32x4 xp0 = *(const LAS f32x4*)xr, xp1 = *(const LAS f32x4*)(xr + 4);
#pragma unroll
              for (int m2 = 0; m2 < 2; ++m2) { const int mt = kh * 2 + m2; const f32x4 own = kh ? O[2 + m2] : O[m2]; const f32x4 xp = m2 ? xp1 : xp0; const f32x4 qn4 = *(const LAS f32x4*)(qn + mt * 16 + 4 * g);
                  float hv[4];
#pragma unroll
                  for (int i = 0; i < 4; ++i) { const int t = mt * 16 + 4 * g + i; const f32x4 f = *(const LAS f32x4*)(fin4 + t * 4); const float den = f[0] * qn4[i] + f[1];
                      hv[i] = (own[i] + xp[i] + numi[m2 * 4 + i]) * __builtin_amdgcn_rcpf(fmaxf(fabsf(den), f[2])); }
                  u32x2 hw; hw.x = cvt_pk_bf16(hv[0], hv[1]); hw.y = cvt_pk_bf16(hv[2], hv[3]);
                  *(u32x2*)(hout + (size_t)(rowbase + mt * 16 + 4 * g + (tk & 3)) * 2048 + h * 512 + dvw + (tk & ~3)) = hw; } }
        }
        { u32x4 w0, w1;
          { const f32x4 ea = *(const LAS f32x4*)(e_p + g * 8), eb = *(const LAS f32x4*)(e_p + g * 8 + 4), ec = *(const LAS f32x4*)(e_p + 32 + g * 8), ed = *(const LAS f32x4*)(e_p + 32 + g * 8 + 4);
            w0[0] = cvt_pk_bf16(bflo(v0[0]) * ea[0], bfhi(v0[0]) * ea[1]); w0[1] = cvt_pk_bf16(bflo(v0[1]) * ea[2], bfhi(v0[1]) * ea[3]);
            w0[2] = cvt_pk_bf16(bflo(v0[2]) * eb[0], bfhi(v0[2]) * eb[1]); w0[3] = cvt_pk_bf16(bflo(v0[3]) * eb[2], bfhi(v0[3]) * eb[3]);
            w1[0] = cvt_pk_bf16(bflo(v1[0]) * ec[0], bfhi(v1[0]) * ec[1]); w1[1] = cvt_pk_bf16(bflo(v1[1]) * ec[2], bfhi(v1[1]) * ec[3]);
            w1[2] = cvt_pk_bf16(bflo(v1[2]) * ed[0], bfhi(v1[2]) * ed[1]); w1[3] = cvt_pk_bf16(bflo(v1[3]) * ed[2], bfhi(v1[3]) * ed[3]); }
          const bf16x8 ve0 = __builtin_bit_cast(bf16x8, w0), ve1 = __builtin_bit_cast(bf16x8, w1);
          const LAS unsigned char* kbase = lds + L_KT + (kh * 256 + 8 * (tk >> 2) + (tk & 3)) * KT_STRIDE + g * 16;
          bf16x8 ka[2][2];
          ka[0][0] = *(const LAS bf16x8*)kbase; ka[0][1] = *(const LAS bf16x8*)(kbase + 64);
#pragma unroll
          for (int i = 0; i < 16; ++i) {
              if (i < 15) { const LAS unsigned char* kp = kbase + (32 * ((i + 1) >> 1) + 4 * ((i + 1) & 1)) * KT_STRIDE; ka[(i + 1) & 1][0] = *(const LAS bf16x8*)kp; ka[(i + 1) & 1][1] = *(const LAS bf16x8*)(kp + 64); }
              C[i] = C[i] * decay;
              __builtin_amdgcn_sched_barrier(0);
              C[i] = __builtin_amdgcn_mfma_f32_16x16x32_bf16(ka[i & 1][0], ve0, C[i], 0, 0, 0);
              C[i] = __builtin_amdgcn_mfma_f32_16x16x32_bf16(ka[i & 1][1], ve1, C[i], 0, 0, 0);
              __builtin_amdgcn_sched_barrier(0); } }
        { float sacc = 0.f; const LAS unsigned char* kp = lds + L_KT + tid * KT_STRIDE;
#pragma unroll
          for (int i = 0; i < 8; ++i) { const u32x4 w = *(const LAS u32x4*)(kp + i * 16); const u32x4 e4 = *(const LAS u32x4*)(ebf + i * 4);
              sacc = dot2bf(w.x, e4.x, sacc); sacc = dot2bf(w.y, e4.y, sacc); sacc = dot2bf(w.z, e4.z, sacc); sacc = dot2bf(w.w, e4.w, sacc); }
          nreg = decay * nreg + sacc; ((LAS unsigned short*)nbf)[tid] = (unsigned short)(cvt_pk_bf16(nreg, 0.f) & 0xffffu); }
        mstate = mnew;
        LDS_BAR();
    }
}

DI Sch mk_sch(int nM, int nN, int nsub, const void* A0, const void* B0, size_t a_tile, size_t b_tile, size_t a_sub, size_t b_sub, int a_mod = 0, int b_mod = 0) {
    Sch s; s.nM = nM; s.nN = nN; s.nsub = nsub; s.G = 256; s.c = blockIdx.x; s.A0 = (const char*)A0; s.B0 = (const char*)B0;
    s.a_tile = a_tile; s.b_tile = b_tile; s.a_sub = a_sub; s.b_sub = b_sub; s.a_sub2 = 0; s.a_mod = a_mod; s.b_mod = b_mod; return s;
}

__global__ void __launch_bounds__(512, 2) mega(Params p, int ph_lo, int ph_hi) {
    extern __shared__ __attribute__((aligned(16))) unsigned char smem[];
    LAS unsigned char* lds = (LAS unsigned char*)smem;
    cg::grid_group grid = cg::this_grid();
#ifdef PROBE
    unsigned long long tprev = 0, accA = 0, accB = 0;
#endif
    for (int ph = 0; ph < 30; ++ph) {
        if (ph > 0) { if (p.ws == nullptr) grid.sync();
                      unsigned gen = (unsigned)(ph - 1); grid_bar((unsigned*)(p.ws + S_BAR), gen); }
#ifdef PROBE
        { const unsigned long long tn = __builtin_amdgcn_s_memrealtime(); if (ph > 0) { if ((PROBE_MA >> (ph - 1)) & 1u) accA += tn - tprev; if ((PROBE_MB >> (ph - 1)) & 1u) accB += tn - tprev; } tprev = tn; }
        const float probe_b = (float)accB * 0.01f;
#else
        const float probe_b = 0.f;
#endif
        const float* mods = (const float*)(p.out + W_MODS);
        _Float16* hb = (_Float16*)(p.out + O_HB);
        unsigned char* ub = p.ws + S_UB;
#ifndef ONLY
#define EN(x) 1
#else
#define EN(x) ((x) == ONLY)
#endif
        switch (ph) {
        case 0: if (EN(0)) phase_prep(p, lds); break;
        case 1: if (EN(1)) phase_embed(p); break;
        case 2: if (EN(2)) { GemmCfg g{2048, 16, 2048, 16, 16}; Sch S = mk_sch(136, 6, 1, ub, p.out + W_ABIN, 256 * 2048, 256 * 2048, 0, 0);
                  EpiAbIn E{(bf16_t*)(p.ws + S_R1), (bf16_t*)(p.ws + S_R1 + 34 * MiB)}; gemm_phase(lds, g, S, E); } break;
        case 3: if (EN(3)) phase_poolconv(p, lds); break;
        case 4: if (EN(2)) { GemmCfg g{16, (unsigned)NR * 16u, 1024, 16, 8}; Sch S = mk_sch(136, 2, 1, p.ws + S_R1, p.out + W_POOL, 256 * 16, 256 * 1024, 0, 0);
                  EpiPool E{(bf16_t*)(p.ws + S_R2), p.in[10], p.in[11]}; gemm_phase(lds, g, S, E); } break;
        case 5: if (EN(2)) { GemmCfg g{2048, 16, 2048, 16, 16}; Sch S = mk_sch(136, 4, 1, p.ws + S_R2, p.out + W_ABOUT, 256 * 2048, 256 * 2048, 0, 0);
                  EpiRes E{hb, hb, mods + 2 * 1024, 0, nullptr, nullptr}; gemm_phase(lds, g, S, E); } break;
        case 6: if (EN(1)) phase_ln(p, hb, 0, 0, 0, 3, 0); break;
        case 7: if (EN(2)) { GemmCfg g{2048, 16, 2048, 16, 16}; Sch S = mk_sch(136, 22, 1, ub, p.out + W_FFNIN, 256 * 2048, 256 * 2048, 0, 0);
                  EpiFfnIn E{(bf16_t*)(p.ws + S_R3), 0}; gemm_phase(lds, g, S, E); } break;
        case 8: if (EN(2)) {
                  for (int cpart = 0; cpart < 2; ++cpart) {
                      GemmCfg g{FF * 2, 16, FF * 2, 16, cpart ? 22 : 44};
                      Sch S = mk_sch(cpart ? 4 : 64, 4, cpart ? 4 : 2, p.ws + S_R3 + (cpart ? (size_t)HLAT * FF * 2 : (size_t)0), p.out + W_FFNOUT, (size_t)256 * FF * 2, (size_t)256 * FF * 2,
                                     cpart ? (size_t)1408 * 2 : (size_t)HR * FF * 2, cpart ? (size_t)1408 * 2 : (size_t)0, cpart ? 2 : 0, cpart ? 2 : 0);
                      if (cpart) { S.a_sub2 = (size_t)HR * FF * 2; S.c = 255 - (int)blockIdx.x; }
                      EpiRes E{hb, hb, mods + (cpart ? 8 * 6144 : 0) + 5 * 1024, HR, cpart ? (float*)(p.ws + S_CPA) : (float*)nullptr, (float*)(p.ws + S_CPB)};
                      gemm_phase(lds, g, S, E); } } break;
        case 9: if (EN(1)) phase_ln(p, hb, 0, 1, 1, 0, 0, 0.f, (const float*)(p.ws + S_CPA), (const float*)(p.ws + S_CPB)); break;
        case 10: case 18: if (EN(2)) { const int hf = ph >= 18; GemmCfg g{2048, 16, 2048, 16, 16};
                  Sch S = mk_sch(68, 8, 1, ub + (size_t)hf * HR * 2048, p.out + W_MLIN, 256 * 2048, 256 * 2048, 0, 0);
                  EpiPlain E{(bf16_t*)(p.ws + S_R1), 2048}; gemm_phase(lds, g, S, E); } break;
        case 11: case 19: if (EN(4)) phase_mlconv(p, ph >= 19); break;
        case 12: case 20: if (EN(2)) {
                  phase_pre(p, ph >= 20);
                  { GemmCfg g{4096, 16, 1024, 16, 8}; Sch S = mk_sch(68, 2, 8, p.ws + S_R2, p.out + W_Q, 256 * 4096, 256 * 1024, 1024, 524288, 4, 0);
                    EpiQK E{(bf16_t*)(p.ws + S_R3), (bf16_t*)(p.ws + S_R4)}; gemm_phase(lds, g, S, E); }
                  { GemmCfg g{1024, 16, 4096, 16, 8}; Sch S = mk_sch(2, 68, 4, p.out + W_V, p.ws + S_R1, 256 * 1024, 256 * 4096, 524288, 1024);
                    S.c = 255 - (int)blockIdx.x;
                    EpiVT E{(bf16_t*)(p.ws + S_R5)}; gemm_phase(lds, g, S, E); } } break;
        case 13: case 21: if (EN(5)) phase_intra(p, lds); break;
        case 14: case 22: if (EN(5)) phase_scan(p, ph >= 22, lds); break;
        case 15: case 23: if (EN(2)) { const int hf = ph >= 23; GemmCfg g{2048, 16, 2048, 16, 16};
                  Sch S = mk_sch(64, 8, 1, ub + (size_t)hf * HR * 2048, p.out + W_MLIN + (size_t)2048 * 2048, 256 * 2048, 256 * 2048, 0, 0);
                  EpiPlain E{(bf16_t*)(p.ws + S_R3), 2048}; gemm_phase(lds, g, S, E); } break;
        case 16: case 24: if (EN(1)) phase_mlout(p); break;
        case 17: case 25: if (EN(2)) { const int hf = ph >= 25; GemmCfg g{4096, 16, 4096, 16, 32};
                  Sch S = mk_sch(64, 4, 1, p.ws + S_R2, p.out + W_MLOUT, 256 * 4096, 256 * 4096, 0, 0);
                  EpiRes E{hb + (size_t)hf * HR * 1024, hb + (size_t)hf * HR * 1024, mods + 9 * 6144 + 2 * 1024 + (size_t)hf * 4 * 6144, 0, nullptr, nullptr};
                  gemm_phase(lds, g, S, E); } break;
        case 26: if (EN(1)) phase_ln(p, hb, 1, 0, 1, 3, 1); break;
        case 27: if (EN(2)) { GemmCfg g{2048, 16, 2048, 16, 16}; Sch S = mk_sch(64, 22, 2, ub, p.out + W_FFNIN + 11534336, 256 * 2048, 256 * 2048, (size_t)HR * 2048, 0);
                  EpiFfnIn E{(bf16_t*)(p.ws + S_R1), HR}; gemm_phase(lds, g, S, E); } break;
        case 28: if (EN(2)) { GemmCfg g{FF * 2, 16, FF * 2, 16, 44}; Sch S = mk_sch(64, 4, 2, p.ws + S_R1, p.out + W_FFNOUT + 5767168, (size_t)256 * FF * 2, (size_t)256 * FF * 2, (size_t)HR * FF * 2, 0);
                  EpiRes E{hb, (_Float16*)(p.ws + S_R5), mods + 9 * 6144 + 5 * 1024, HR, nullptr, nullptr}; gemm_phase(lds, g, S, E); } break;
        case 29: if (EN(1)) phase_ln(p, (const _Float16*)(p.ws + S_R5), 1, 1, -1, 0, 2, probe_b); break;
        default: break;
        }
    }
#ifdef PROBE
    { const unsigned long long tn = __builtin_amdgcn_s_memrealtime(); if ((PROBE_MA >> 29) & 1u) accA += tn - tprev;
      __syncthreads(); if (blockIdx.x == 0 && threadIdx.x == 0) ((float*)p.out)[0] = (float)accA * 0.01f; }
#endif
}
constexpr int NPHASE = 30;

extern "C" void kernel_launch(void* const* d_in, const int* in_sizes, int n_in, void* d_out, int out_size, void* d_ws, size_t ws_size, hipStream_t stream) {
    static int grid = 0;
    if (grid == 0) {
        if (n_in != 30 || ws_size < WS_NEED) { fprintf(stderr, "kernel_launch: unexpected n_in %d or ws_size %zu (< %zu)\n", n_in, ws_size, (size_t)WS_NEED); grid = -1; return; }
        int dev = 0, cus = 0, per_cu = 0;
        hipGetDevice(&dev); hipDeviceGetAttribute(&cus, hipDeviceAttributeMultiprocessorCount, dev);
        if (hipFuncSetAttribute((const void*)mega, hipFuncAttributeMaxDynamicSharedMemorySize, LDS_BYTES) != hipSuccess) { fprintf(stderr, "hipFuncSetAttribute failed\n"); grid = -1; return; }
        hipOccupancyMaxActiveBlocksPerMultiprocessor(&per_cu, (const void*)mega, 512, LDS_BYTES);
        (void)hipGetLastError();
        grid = 256; if (cus != 256) fprintf(stderr, "kernel_launch: device reports %d CUs; this kernel is built for a 256-workgroup grid\n", cus);
        if (per_cu < 1) fprintf(stderr, "kernel_launch: occupancy query says %d blocks per CU\n", per_cu);
    }
    if (grid < 0) return;
    hipMemsetAsync((unsigned char*)d_ws + S_BAR, 0, 4096, stream);
    Params p{};
    for (int i = 0; i < 30; ++i) p.in[i] = (const float*)d_in[i];
    p.out = (unsigned char*)d_out; p.ws = (unsigned char*)d_ws;
    int lo = 0, hi = NPHASE;
    void* args[] = {&p, &lo, &hi};
    hipError_t e = hipLaunchCooperativeKernel((const void*)mega, dim3(grid), dim3(512), args, LDS_BYTES, stream);
    if (e != hipSuccess) fprintf(stderr, "cooperative launch failed: %s (grid %d)\n", hipGetErrorString(e), grid);
}
```
